# Optimizing an MI355X kernel written in HIP

```python
import math
import jax, jax.numpy as jnp
from jax import lax
import numpy as np

D_MODEL = 1024
BATCH = 4
SEQ = 8192
DEPTH = 1
DEC_BATCH = 16
DEC_SEQ = 32
PAST_LEN = 2048

CHUNK = 64
Q_BLOCK = 128
H_A = 4
DK_A = 64
DV_A = 2 * DK_A
H_R = 4
DK_R = 128
DV_R = 128
D_MIX = H_A * DV_A + H_R * DV_R
D_FF = -(-8 * D_MODEL // (3 * 256)) * 256
N_BUCKETS = 32
MAX_DISTANCE = 128
ROPE_BASE = 10000.0
EPS = 1e-6
NEG_INF = -1e30
COLS = [H_A * 2 * DK_A, H_A * 2 * DK_A, H_A * DV_A, H_R * DK_R, H_R * DK_R, H_R * DV_R, H_R * DV_R]
D_IN = sum(COLS)
SPLITS = [int(s) for s in np.cumsum(COLS)[:-1]]

kernel_name = 'hybrid_diffattn_retention_stream_step'


def lambda_init_of(layer):
    return 0.8 - 0.6 * math.exp(-0.3 * layer)


def rms_norm(x, g):
    xf = x.astype(jnp.float32)
    y = xf * lax.rsqrt(jnp.mean(xf * xf, axis=-1, keepdims=True) + EPS)
    return (y * g.astype(jnp.float32)).astype(x.dtype)


def rms_unit(x):
    xf = x.astype(jnp.float32)
    return xf * lax.rsqrt(jnp.mean(xf * xf, axis=-1, keepdims=True) + EPS)


def t5_bucket(rel):
    nb = N_BUCKETS // 2
    ret = jnp.where(rel > 0, nb, 0)
    n = jnp.abs(rel)
    max_exact = nb // 2
    large = max_exact + (jnp.log(jnp.maximum(n, 1).astype(jnp.float32) / max_exact)
                         / math.log(MAX_DISTANCE / max_exact) * (nb - max_exact)).astype(jnp.int32)
    large = jnp.minimum(large, nb - 1)
    return ret + jnp.where(n < max_exact, n, large)


def rotate(x, pos):
    d = x.shape[-1]
    inv = 1.0 / (ROPE_BASE ** jnp.linspace(0.0, 1.0, d // 2, dtype=jnp.float32))
    ang = pos.astype(jnp.float32)[:, None] * inv[None, :]
    sin = jnp.sin(ang)[None, :, None, :]
    cos = jnp.cos(ang)[None, :, None, :]
    xf = x.astype(jnp.float32)
    x1 = xf[..., 0::2]
    x2 = xf[..., 1::2]
    out = jnp.stack([x1 * cos - x2 * sin, x1 * sin + x2 * cos], axis=-1).reshape(x.shape)
    return out.astype(x.dtype)


def diff_attention(q, k, v, q_pos, k_pos, rel_bias, lam, g_subln, lam_init):
    rel = k_pos[None, :] - q_pos[:, None]
    bias = jnp.transpose(rel_bias[t5_bucket(rel)], (2, 0, 1)).astype(jnp.float32)
    visible = (k_pos[None, :] // CHUNK) <= (q_pos[:, None] // CHUNK)
    logits = jnp.einsum('bqhmd,bkhmd->bhmqk', q, k, preferred_element_type=jnp.float32) * (DK_A ** -0.5)
    logits = jnp.where(visible, logits + bias[None, :, None], NEG_INF)
    p = jax.nn.softmax(logits, axis=-1)
    attn = p[:, :, 0] - lam.astype(jnp.float32) * p[:, :, 1]
    o = jnp.einsum('bhqk,bkhd->bqhd', attn.astype(v.dtype), v)
    return rms_norm(o, g_subln) * (1.0 - lam_init)


def diff_attention_blocked(q, k, v, pos, rel_bias, lam, g_subln, lam_init):
    B, S = q.shape[0], q.shape[1]
    nb = S // Q_BLOCK
    qb = jnp.moveaxis(q.reshape(B, nb, Q_BLOCK, H_A, 2, DK_A), 1, 0)
    pb = pos.reshape(nb, Q_BLOCK)
    ob = lax.map(lambda a: diff_attention(a[0], k, v, a[1], pos, rel_bias, lam, g_subln, lam_init), (qb, pb))
    return jnp.moveaxis(ob, 0, 1).reshape(B, S, H_A, DV_A)


def retention_chunk(S, q, k, v, log_gamma):
    q = q.astype(jnp.float32)
    k = k.astype(jnp.float32)
    v = v.astype(jnp.float32)
    L = q.shape[1]
    i = jnp.arange(L, dtype=jnp.float32)
    diff = i[:, None] - i[None, :]
    decay = jnp.where(diff >= 0, jnp.exp(jnp.maximum(diff, 0.0)[None] * log_gamma[:, None, None]), 0.0)
    scores = jnp.einsum('blhd,bmhd->bhlm', q, k) * decay[None]
    o_inner = jnp.einsum('bhlm,bmhe->blhe', scores, v)
    q_decay = jnp.exp((i + 1.0)[:, None] * log_gamma[None, :])
    o_cross = jnp.einsum('blhd,bhde->blhe', q * q_decay[None, :, :, None], S)
    k_decay = jnp.exp((L - 1.0 - i)[:, None] * log_gamma[None, :])
    S_new = jnp.exp(L * log_gamma)[None, :, None, None] * S + jnp.einsum('blhd,blhe->bhde', k * k_decay[None, :, :, None], v)
    return S_new, o_inner + o_cross


def retention_scan(S0, q, k, v, log_gamma):
    B, S = q.shape[0], q.shape[1]
    nc = S // CHUNK

    def split(t):
        return jnp.moveaxis(t.reshape(B, nc, CHUNK, t.shape[2], t.shape[3]), 1, 0)

    def step(Sc, xs):
        return retention_chunk(Sc, xs[0], xs[1], xs[2], log_gamma)

    S_fin, o = lax.scan(step, S0, (split(q), split(k), split(v)))
    return S_fin, jnp.moveaxis(o, 0, 1).reshape(B, S, H_R, DV_R)


def trunk_layer(x, c, pos, k_hist, v_hist, s_hist, w_ada, b_ada, g_norm1, g_norm2, w_in, g_q, g_k,
                lam_q1, lam_k1, lam_q2, lam_k2, g_subln, w_out, w_ff_gate, w_ff_up, w_ff_down,
                rel_bias, lam_init):
    B, L, _ = x.shape
    mod = jnp.einsum('bd,de->be', jax.nn.silu(c), w_ada) + b_ada
    shift1, scale1, gate1, shift2, scale2, gate2 = jnp.split(mod[:, None, :], 6, axis=-1)
    h = rms_norm(x, g_norm1) * (1.0 + scale1) + shift1
    z = jnp.einsum('bld,de->ble', h, w_in)
    qa, ka, va, qr, kr, vr, gr = jnp.split(z, SPLITS, axis=-1)
    qa = rms_norm(qa.reshape(B, L, H_A, 2, DK_A), g_q)
    ka = rms_norm(ka.reshape(B, L, H_A, 2, DK_A), g_k)
    va = va.reshape(B, L, H_A, DV_A)
    qr = rotate(qr.reshape(B, L, H_R, DK_R), pos)
    kr = rotate(kr.reshape(B, L, H_R, DK_R), pos) * (DK_R ** -0.5)
    vr = vr.reshape(B, L, H_R, DV_R)
    lam = jnp.exp(jnp.sum(lam_q1 * lam_k1)) - jnp.exp(jnp.sum(lam_q2 * lam_k2)) + lam_init
    log_gamma = jnp.log(1.0 - 2.0 ** (-5.0 - jnp.arange(H_R, dtype=jnp.float32)))
    if k_hist is None:
        oa = diff_attention_blocked(qa, ka, va, pos, rel_bias, lam, g_subln, lam_init)
        S0 = jnp.zeros((B, H_R, DK_R, DV_R), jnp.float32)
        S_new, orr = retention_scan(S0, qr, kr, vr, log_gamma)
    else:
        P = k_hist.shape[1]
        k_all = jnp.concatenate([k_hist.astype(ka.dtype), ka], axis=1)
        v_all = jnp.concatenate([v_hist.astype(va.dtype), va], axis=1)
        k_pos = jnp.arange(P + L, dtype=jnp.int32)
        oa = diff_attention(qa, k_all, v_all, pos, k_pos, rel_bias, lam, g_subln, lam_init)
        S_new, orr = retention_chunk(s_hist.astype(jnp.float32), qr, kr, vr, log_gamma)
    orr = rms_unit(orr).astype(x.dtype).reshape(B, L, H_R * DV_R) * jax.nn.silu(gr)
    o = jnp.concatenate([oa.reshape(B, L, H_A * DV_A), orr], axis=-1)
    x = x + gate1 * jnp.einsum('ble,ed->bld', o, w_out)
    h2 = rms_norm(x, g_norm2) * (1.0 + scale2) + shift2
    ff = jax.nn.silu(jnp.einsum('bld,df->blf', h2, w_ff_gate)) * jnp.einsum('bld,df->blf', h2, w_ff_up)
    x = x + gate2 * jnp.einsum('blf,fd->bld', ff, w_ff_down)
    return x, ka, va, S_new.astype(x.dtype)


def setup_inputs(seed: int = 0) -> dict:
    key = jax.random.key(seed)
    ks = jax.random.split(key, 24)
    f32 = jnp.float32

    def nrm(k, shape, s):
        return s * jax.random.normal(k, shape, f32)

    return {
        'x_prompt': nrm(ks[0], (BATCH, SEQ, D_MODEL), 1.0),
        'x_sample': nrm(ks[1], (DEC_BATCH, DEC_SEQ, D_MODEL), 1.0),
        'c_prompt': nrm(ks[2], (BATCH, D_MODEL), 1.0),
        'c_sample': nrm(ks[3], (DEC_BATCH, D_MODEL), 1.0),
        'cache_k': nrm(ks[4], (DEPTH, DEC_BATCH, PAST_LEN, H_A, 2, DK_A), 1.0),
        'cache_v': nrm(ks[5], (DEPTH, DEC_BATCH, PAST_LEN, H_A, DV_A), 1.0),
        'state_ret': nrm(ks[6], (DEPTH, DEC_BATCH, H_R, DK_R, DV_R), 0.5),
        'w_ada': nrm(ks[7], (DEPTH, D_MODEL, 6 * D_MODEL), 0.5 * D_MODEL ** -0.5),
        'b_ada': nrm(ks[8], (DEPTH, 6 * D_MODEL), 0.01),
        'g_norm1': 1.0 + nrm(ks[9], (DEPTH, D_MODEL), 0.05),
        'g_norm2': 1.0 + nrm(ks[10], (DEPTH, D_MODEL), 0.05),
        'w_in': nrm(ks[11], (DEPTH, D_MODEL, D_IN), D_MODEL ** -0.5),
        'g_q': 1.0 + nrm(ks[12], (DEPTH, DK_A), 0.05),
        'g_k': 1.0 + nrm(ks[13], (DEPTH, DK_A), 0.05),
        'lam_q1': nrm(ks[14], (DEPTH, DK_A), 0.1),
        'lam_k1': nrm(ks[15], (DEPTH, DK_A), 0.1),
        'lam_q2': nrm(ks[16], (DEPTH, DK_A), 0.1),
        'lam_k2': nrm(ks[17], (DEPTH, DK_A), 0.1),
        'g_subln': 1.0 + nrm(ks[18], (DEPTH, DV_A), 0.05),
        'w_out': nrm(ks[19], (DEPTH, D_MIX, D_MODEL), D_MIX ** -0.5),
        'w_ff_gate': nrm(ks[20], (DEPTH, D_MODEL, D_FF), D_MODEL ** -0.5),
        'w_ff_up': nrm(ks[21], (DEPTH, D_MODEL, D_FF), D_MODEL ** -0.5),
        'w_ff_down': nrm(ks[22], (DEPTH, D_FF, D_MODEL), D_FF ** -0.5),
        'rel_bias': nrm(ks[23], (N_BUCKETS, H_A), 0.5),
    }


def reference(x_prompt, x_sample, c_prompt, c_sample, cache_k, cache_v, state_ret, w_ada, b_ada,
              g_norm1, g_norm2, w_in, g_q, g_k, lam_q1, lam_k1, lam_q2, lam_k2, g_subln, w_out,
              w_ff_gate, w_ff_up, w_ff_down, rel_bias):
    S = x_prompt.shape[1]
    L = x_sample.shape[1]
    P = cache_k.shape[2]
    pos_prompt = jnp.arange(S, dtype=jnp.int32)
    pos_sample = P + jnp.arange(L, dtype=jnp.int32)
    xp, xs = x_prompt, x_sample
    kp_l, vp_l, sp_l, ks_l, vs_l, ss_l = [], [], [], [], [], []
    for l in range(DEPTH):
        lam_init = lambda_init_of(l)
        w = (w_ada[l], b_ada[l], g_norm1[l], g_norm2[l], w_in[l], g_q[l], g_k[l], lam_q1[l], lam_k1[l],
             lam_q2[l], lam_k2[l], g_subln[l], w_out[l], w_ff_gate[l], w_ff_up[l], w_ff_down[l], rel_bias)
        xp, kp, vp, sp = trunk_layer(xp, c_prompt, pos_prompt, None, None, None, *w, lam_init)
        xs, ksn, vsn, ssn = trunk_layer(xs, c_sample, pos_sample, cache_k[l], cache_v[l], state_ret[l], *w, lam_init)
        kp_l.append(kp)
        vp_l.append(vp)
        sp_l.append(sp)
        ks_l.append(ksn)
        vs_l.append(vsn)
        ss_l.append(ssn)
    return (xp, xs, jnp.stack(kp_l), jnp.stack(vp_l), jnp.stack(sp_l), jnp.stack(ks_l), jnp.stack(vs_l), jnp.stack(ss_l))
```

```cpp
#include <hip/hip_runtime.h>
#include <hip/hip_bf16.h>
#include <cstdio>
#include <cstdint>
#include <cmath>

constexpr int DM = 1024, NBP = 4, SEQ = 8192, NBS = 16, LS = 32, PAST = 2048;
constexpr int MP = NBP * SEQ, MS = NBS * LS, MT = MP + MS;
constexpr int DIN = 3584, DFF = 2816, NGU = 2 * DFF, NBT = NBP + NBS;
constexpr float EPSN = 1e-6f;
constexpr float LOG2E = 1.4426950408889634f;
constexpr float QSCALE = 0.125f * LOG2E;
constexpr float LAM_INIT = 0.2f;
constexpr size_t OFF_Y = 0, OFF_KP = (size_t)MT * DM, OFF_VP = OFF_KP + (size_t)MP * 512, OFF_RP = OFF_VP + (size_t)MP * 512,
                 OFF_KS = OFF_RP + (size_t)NBP * 4 * 128 * 128, OFF_VS = OFF_KS + (size_t)MS * 512, OFF_RS = OFF_VS + (size_t)MS * 512,
                 OUT_TOTAL = OFF_RS + (size_t)NBS * 4 * 128 * 128;
__device__ __forceinline__ int row_batch(int row) { return row < MP ? (row >> 13) : NBP + ((row - MP) >> 5); }
__device__ __forceinline__ int row_pos(int row) { return row < MP ? (row & 8191) : PAST + ((row - MP) & 31); }

namespace pg8 {
#define PG8_LAS __attribute__((address_space(3)))
typedef unsigned short bf16_t;
typedef short bf16x8 __attribute__((ext_vector_type(8)));
typedef float f32x4 __attribute__((ext_vector_type(4)));
typedef unsigned u32x4 __attribute__((ext_vector_type(4)));
constexpr int BM = 256, BK = 64, HALF = 128, HTB = HALF * BK * 2  , STAGE_BYTES = 8 * HTB, NXCD = 8, WGM = 8;

__host__ __device__ __forceinline__ int lds_byte(int r, int c) { const int st = (r >> 4) * 2 + (c >> 5), rr = r & 15, cc = c & 31, ob = rr * 64 + cc * 2; return st * 1024 + (ob ^ (((ob >> 9) & 1) << 5)); }
__host__ __device__ __forceinline__ void stage_rc(int b, int& R, int& C) { const int st = b / 1024, sb = b % 1024, swz = sb ^ (((sb >> 9) & 1) << 5); R = (st >> 1) * 16 + swz / 64; C = (st & 1) * 32 + (swz % 64) / 2; }
__host__ __device__ __forceinline__ int perm32(int rho) { const int n = rho >> 4, i = rho & 15; return 8 * (i >> 2) + 4 * n + (i & 3); }

struct Unit { int pm, pn; };
struct Gemm { const bf16_t* A; const bf16_t* Bt; int M, N, K; };

struct StaticOrder {
    int nM, nN, nwg, G, c;
    __host__ __device__ void init(int M, int N, int G_, int c_) { nM = M / BM; nN = N / BM; nwg = nM * nN; G = G_; c = c_; }
    __host__ __device__ bool next(int i, Unit& u) const {
        const long L = (long)i * G + c; if (L >= nwg) return false;
        int wgid = (int)L; { const int q = nwg / NXCD, r = nwg % NXCD, xcd = wgid % NXCD, off = wgid / NXCD; wgid = (xcd < r ? xcd * (q + 1) : r * (q + 1) + (xcd - r) * q) + off; }
        const int nig = WGM * nN, gid = wgid / nig, fm = gid * WGM, gsz = (nM - fm) < WGM ? (nM - fm) : WGM;
        u.pm = fm + ((wgid % nig) % gsz); u.pn = (wgid % nig) / gsz; return true;
    }
    __device__ __forceinline__ void a_ready(const Unit&) const {}
    __device__ __forceinline__ void done(const Unit&) const {}
};

__device__ __forceinline__ unsigned cvt_pk_bf16(float lo, float hi) { unsigned r; asm volatile("v_cvt_pk_bf16_f32 %0, %1, %2" : "=v"(r) : "v"(lo), "v"(hi)); return r; }
typedef float f32x2 __attribute__((ext_vector_type(2)));
typedef unsigned u32x2 __attribute__((ext_vector_type(2)));
__device__ __forceinline__ void st_bf16x4(bf16_t* p, f32x4 v) { u32x2 w; w.x = cvt_pk_bf16(v[0], v[1]); w.y = cvt_pk_bf16(v[2], v[3]); *(u32x2*)p = w; }
__device__ __forceinline__ float silu_f(float z) { return z * __builtin_amdgcn_rcpf(1.f + __expf(-z)); }

struct EpiIn {
    static constexpr bool PERM = false, AFTER_DRAIN = false;
    bf16_t* act; float* out; const float* gq; const float* gk; const float* rot;
    __device__ __forceinline__ void operator()(const f32x4 (&acc)[2][2][4][2], const Unit& u, int wr, int wc, int fr, int fq) const {
        const int type = u.pn >> 1, half = u.pn & 1;
        const int lc0 = half * 256 + wc * 64 + fq * 4;
        bf16_t* dst = act + (size_t)type * ((size_t)MT * 512);
        const int rowb = u.pm * BM + wr * 64 + fr;
        if (type <= 1) {
            const float* g = type == 0 ? gq : gk; const float osc = type == 0 ? QSCALE : 1.f;
            f32x4 gv[2][2];
#pragma unroll
            for (int bj = 0; bj < 2; ++bj)
#pragma unroll
                for (int n = 0; n < 2; ++n) gv[bj][n] = *(const f32x4*)(g + bj * 32 + n * 16 + fq * 4);
#pragma unroll
            for (int ai = 0; ai < 2; ++ai)
#pragma unroll
                for (int m = 0; m < 4; ++m) {
                    const int row = rowb + ai * HALF + m * 16;
                    float ss = 0.f;
#pragma unroll
                    for (int bj = 0; bj < 2; ++bj)
#pragma unroll
                        for (int n = 0; n < 2; ++n) { const f32x4 v = acc[ai][bj][m][n]; ss += (v[0] * v[0] + v[1] * v[1]) + (v[2] * v[2] + v[3] * v[3]); }
                    ss += __shfl_xor(ss, 16); ss += __shfl_xor(ss, 32);
                    const float rinv = rsqrtf(ss * (1.f / 64.f) + EPSN);
                    float* ko = (row < MP ? out + OFF_KP + (size_t)row * 512 : out + OFF_KS + (size_t)(row - MP) * 512) + lc0;
                    bf16_t* bo = dst + (size_t)row * 512 + lc0;
#pragma unroll
                    for (int bj = 0; bj < 2; ++bj)
#pragma unroll
                        for (int n = 0; n < 2; ++n) { const f32x4 y = acc[ai][bj][m][n] * rinv * gv[bj][n];
                            if (type == 1) *(f32x4*)(ko + bj * 32 + n * 16) = y;
                            st_bf16x4(bo + bj * 32 + n * 16, y * osc); }
                }
        } else if (type == 2) {
#pragma unroll
            for (int ai = 0; ai < 2; ++ai)
#pragma unroll
                for (int m = 0; m < 4; ++m) {
                    const int row = rowb + ai * HALF + m * 16;
                    float* vo = (row < MP ? out + OFF_VP + (size_t)row * 512 : out + OFF_VS + (size_t)(row - MP) * 512) + lc0;
                    bf16_t* bo = dst + (size_t)row * 512 + lc0;
#pragma unroll
                    for (int bj = 0; bj < 2; ++bj)
#pragma unroll
                        for (int n = 0; n < 2; ++n) { const f32x4 y = acc[ai][bj][m][n]; *(f32x4*)(vo + bj * 32 + n * 16) = y; st_bf16x4(bo + bj * 32 + n * 16, y); }
                }
        } else if (type == 3 || type == 4) {
            const int h = half * 2 + (wc >> 1);
            const float l2g = __log2f(1.f - exp2f(-5.f - (float)h));
#pragma unroll
            for (int ai = 0; ai < 2; ++ai)
#pragma unroll
                for (int m = 0; m < 4; ++m) {
                    const int row = rowb + ai * HALF + m * 16;
                    const int pos = row_pos(row);
                    float ksc = 1.f;
                    if (type == 4) { const int e = row < MP ? 63 - (row & 63) : 31 - ((row - MP) & 31); ksc = 0.08838834764831845f * exp2f((float)e * l2g); }
                    bf16_t* bo = dst + (size_t)row * 512 + lc0;
                    const float* rp = rot + (size_t)pos * 128;
#pragma unroll
                    for (int bj = 0; bj < 2; ++bj)
#pragma unroll
                        for (int n = 0; n < 2; ++n) { const int lc = lc0 + bj * 32 + n * 16; const f32x4 cs = *(const f32x4*)(rp + (lc & 127));
                            const f32x4 v = acc[ai][bj][m][n]; f32x4 y;
                            y[0] = v[0] * cs[0] - v[1] * cs[1]; y[1] = v[0] * cs[1] + v[1] * cs[0]; y[2] = v[2] * cs[2] - v[3] * cs[3]; y[3] = v[2] * cs[3] + v[3] * cs[2];
                            st_bf16x4(bo + bj * 32 + n * 16, y * ksc); }
                }
        } else {
#pragma unroll
            for (int ai = 0; ai < 2; ++ai)
#pragma unroll
                for (int m = 0; m < 4; ++m) {
                    const int row = rowb + ai * HALF + m * 16;
                    bf16_t* bo = dst + (size_t)row * 512 + lc0;
#pragma unroll
                    for (int bj = 0; bj < 2; ++bj)
#pragma unroll
                        for (int n = 0; n < 2; ++n) { f32x4 y = acc[ai][bj][m][n];
                            if (type == 6) { y[0] = silu_f(y[0]); y[1] = silu_f(y[1]); y[2] = silu_f(y[2]); y[3] = silu_f(y[3]); }
                            st_bf16x4(bo + bj * 32 + n * 16, y); }
                }
        }
    }
};

struct EpiOut {
    static constexpr bool PERM = false, AFTER_DRAIN = false;
    const float* xp; const float* xs; float* y; bf16_t* xn2; const float* mod; const float* g2; float* rowss;
    __device__ __forceinline__ void operator()(const f32x4 (&acc)[2][2][4][2], const Unit& u, int wr, int wc, int fr, int fq) const {
        const int col0 = u.pn * BM + wc * 32 + 4 * fq, rowb = u.pm * BM + wr * 64 + fr;
#pragma unroll
        for (int ai = 0; ai < 2; ++ai)
#pragma unroll
            for (int m = 0; m < 4; ++m) {
                const int row = rowb + ai * HALF + m * 16;
                const float* xr = (row < MP ? xp + (size_t)row * DM : xs + (size_t)(row - MP) * DM) + col0;
                const float* mb = mod + (size_t)row_batch(row) * (6 * DM) + col0;
                float* yo = y + (size_t)row * DM + col0; bf16_t* no = xn2 + (size_t)row * DM + col0;
                float ss = 0.f;
#pragma unroll
                for (int bj = 0; bj < 2; ++bj)
#pragma unroll
                    for (int n = 0; n < 2; ++n) { const int o = bj * HALF + n * 16;
                        const f32x4 xv = *(const f32x4*)(xr + o), gt = *(const f32x4*)(mb + 2 * DM + o), s2 = *(const f32x4*)(mb + 4 * DM + o), gg = *(const f32x4*)(g2 + col0 + o);
                        const f32x4 x1 = xv + gt * acc[ai][bj][m][n];
                        *(f32x4*)(yo + o) = x1; ss += (x1[0] * x1[0] + x1[1] * x1[1]) + (x1[2] * x1[2] + x1[3] * x1[3]);
                        st_bf16x4(no + o, x1 * gg * (s2 + 1.f)); }
                ss += __shfl_xor(ss, 16); ss += __shfl_xor(ss, 32);
                if (fq == 0) atomicAdd(rowss + row, ss);
                asm volatile("" ::: "memory");
            }
    }
};

struct EpiFF1 {
    static constexpr bool PERM = false, AFTER_DRAIN = false;
    const float* rowss; const float* sbg; const float* sbu; bf16_t* H;
    __device__ __forceinline__ void operator()(const f32x4 (&acc)[2][2][4][2], const Unit& u, int wr, int wc, int fr, int fq) const {
        const int f0 = u.pn * 128 + wc * 16 + fq * 4, rowb = u.pm * BM + wr * 64 + fr;
#pragma unroll
        for (int ai = 0; ai < 2; ++ai)
#pragma unroll
            for (int m = 0; m < 4; ++m) {
                const int row = rowb + ai * HALF + m * 16; const int b = row_batch(row);
                const float rstd = rsqrtf(rowss[row] * (1.f / (float)DM) + EPSN);
#pragma unroll
                for (int bj = 0; bj < 2; ++bj) { const int f = f0 + bj * 64;
                    const f32x4 hg = acc[ai][bj][m][0] * rstd + *(const f32x4*)(sbg + (size_t)b * DFF + f);
                    const f32x4 hu = acc[ai][bj][m][1] * rstd + *(const f32x4*)(sbu + (size_t)b * DFF + f);
                    f32x4 o; o[0] = silu_f(hg[0]) * hu[0]; o[1] = silu_f(hg[1]) * hu[1]; o[2] = silu_f(hg[2]) * hu[2]; o[3] = silu_f(hg[3]) * hu[3];
                    st_bf16x4(H + (size_t)row * DFF + f, o); }
            }
    }
};

struct EpiFF2 {
    static constexpr bool PERM = false, AFTER_DRAIN = false;
    float* y; const float* mod;
    __device__ __forceinline__ void operator()(const f32x4 (&acc)[2][2][4][2], const Unit& u, int wr, int wc, int fr, int fq) const {
        const int col0 = u.pn * BM + wc * 32 + 4 * fq, rowb = u.pm * BM + wr * 64 + fr;
#pragma unroll
        for (int ai = 0; ai < 2; ++ai)
#pragma unroll
            for (int m = 0; m < 4; ++m) {
                const int row = rowb + ai * HALF + m * 16;
                const float* mb = mod + (size_t)row_batch(row) * (6 * DM) + 5 * DM + col0;
                float* yo = y + (size_t)row * DM + col0;
#pragma unroll
                for (int bj = 0; bj < 2; ++bj)
#pragma unroll
                    for (int n = 0; n < 2; ++n) { const int o = bj * HALF + n * 16;
                        const f32x4 x1 = *(const f32x4*)(yo + o), gt = *(const f32x4*)(mb + o);
                        *(f32x4*)(yo + o) = x1 + gt * acc[ai][bj][m][n]; }
                asm volatile("" ::: "memory");
            }
    }
};

template <class Epi, class Sched, bool ALIGN_EPI = false, bool SP2 = false>
__device__ __forceinline__ void gemm_phase(PG8_LAS unsigned char* lds, const Gemm g, const Sched& S, const Epi& E) {
    const int tid = threadIdx.x, wid = __builtin_amdgcn_readfirstlane(tid >> 6), lane = tid & 63, wr = wid >> 2, wc = wid & 3, fr = lane & 15, fq = lane >> 4;
    const int K = g.K, nt = K / BK;
    unsigned voffA[2], voffB[2];
#pragma unroll
    for (int i = 0; i < 2; ++i) { int R, C; stage_rc(tid * 16 + i * 8192, R, C); const int Rb = Epi::PERM ? ((R & ~31) + perm32(R & 31)) : R;
        voffA[i] = (unsigned)(R * K + C) * 2u; voffB[i] = (unsigned)(Rb * K + C) * 2u; }
    const size_t kstep = (size_t)(BK * 2);
    const size_t hstep = (size_t)HALF * K * 2;
    const size_t tstep = 2 * hstep;
    const unsigned ldsw = (unsigned)wid * 1024u;
    const int aoff = lds_byte(wr * 64 + fr, fq * 8), boff = lds_byte(wc * 32 + fr, fq * 8);
#define PG8_SA(b, h) (((b) * 2 + (h)) * HTB)
#define PG8_SB(b, h) ((4 + (b) * 2 + (h)) * HTB)
#define PG8_STAGE(bufoff, gbase, voff) do { _Pragma("unroll") for (int _i = 0; _i < 2; ++_i) \
        __builtin_amdgcn_global_load_lds((const unsigned*)((const char*)(gbase) + (voff)[_i]), (PG8_LAS unsigned*)(lds + (bufoff) + ldsw + _i * 8192), 16, 0, 0); } while (0)
#define PG8_LDA(dst, b, h) do { _Pragma("unroll") for (int m = 0; m < 4; ++m) _Pragma("unroll") for (int k = 0; k < 2; ++k) dst[m][k] = *(const PG8_LAS bf16x8*)(lds + PG8_SA(b, h) + aoff + m * 2048 + k * 1024); } while (0)
#define PG8_LDB(dst, b, h) do { _Pragma("unroll") for (int n = 0; n < 2; ++n) _Pragma("unroll") for (int k = 0; k < 2; ++k) dst[n][k] = *(const PG8_LAS bf16x8*)(lds + PG8_SB(b, h) + boff + n * 2048 + k * 1024); } while (0)
#define PG8_MMA(ai, bj, At, Bt) do { __builtin_amdgcn_s_setprio(1); _Pragma("unroll") for (int m = 0; m < 4; ++m) _Pragma("unroll") for (int n = 0; n < 2; ++n) _Pragma("unroll") for (int k = 0; k < 2; ++k) \
        acc[ai][bj][m][n] = __builtin_amdgcn_mfma_f32_16x16x32_bf16(Bt[n][k], At[m][k], acc[ai][bj][m][n], 0, 0, 0); __builtin_amdgcn_s_setprio(0); } while (0)
#define PG8_WAIT_V(n) asm volatile("s_waitcnt vmcnt(" #n ")" ::: "memory")
#define PG8_WAIT_L(n) asm volatile("s_waitcnt lgkmcnt(" #n ")" ::: "memory")
#define PG8_BAR __builtin_amdgcn_s_barrier()
#define PG8_SCHED __builtin_amdgcn_sched_barrier(0)
    Unit cur, nxt; int ui = 0;
    if (!S.next(0, cur)) return;
    f32x4 acc[2][2][4][2];
#pragma unroll
    for (int a = 0; a < 2; ++a)
#pragma unroll
        for (int b = 0; b < 2; ++b)
#pragma unroll
            for (int m = 0; m < 4; ++m)
#pragma unroll
                for (int n = 0; n < 2; ++n) acc[a][b][m][n] = (f32x4){0.f, 0.f, 0.f, 0.f};
    bf16x8 At[4][2], B0[2][2], B1[2][2];
    const char* cA = (const char*)g.A + (size_t)cur.pm * tstep; const char* cB = (const char*)g.Bt + (size_t)cur.pn * tstep;
    S.a_ready(cur);
    if constexpr (SP2) {
        PG8_STAGE(PG8_SB(0, 0), cB, voffB); PG8_STAGE(PG8_SB(0, 1), cB + hstep, voffB); PG8_STAGE(PG8_SA(0, 0), cA, voffA); PG8_STAGE(PG8_SA(0, 1), cA + hstep, voffA);
        if (wr == 1) PG8_BAR;
        PG8_WAIT_V(2); PG8_BAR;
        PG8_STAGE(PG8_SB(1, 0), cB + kstep, voffB); PG8_STAGE(PG8_SA(1, 0), cA + kstep, voffA); PG8_STAGE(PG8_SB(1, 1), cB + hstep + kstep, voffB);
        PG8_WAIT_V(6); PG8_BAR;
    } else {
        PG8_STAGE(PG8_SB(0, 0), cB, voffB); PG8_STAGE(PG8_SA(0, 0), cA, voffA); PG8_STAGE(PG8_SB(0, 1), cB + hstep, voffB); PG8_STAGE(PG8_SA(0, 1), cA + hstep, voffA);
        if (wr == 1) PG8_BAR;
        PG8_WAIT_V(4); PG8_BAR;
        PG8_STAGE(PG8_SB(1, 0), cB + kstep, voffB); PG8_STAGE(PG8_SA(1, 0), cA + kstep, voffA); PG8_STAGE(PG8_SB(1, 1), cB + hstep + kstep, voffB);
        PG8_WAIT_V(6); PG8_BAR;
    }
    for (;;) {
        const bool has_next = S.next(ui + 1, nxt);
        const char* nA = has_next ? (const char*)g.A + (size_t)nxt.pm * tstep : cA; const char* nB = has_next ? (const char*)g.Bt + (size_t)nxt.pn * tstep : cB;
        for (int t = 0; t < nt; t += 2) {
            const bool last = (t == nt - 2);
            const char* a1 = cA + (size_t)(t + 1) * kstep;
            const char* a2 = last ? nA : cA + (size_t)(t + 2) * kstep; const char* b2 = last ? nB : cB + (size_t)(t + 2) * kstep;
            const char* a3 = a2 + kstep; const char* b3 = b2 + kstep;
            if (last && has_next) S.a_ready(nxt);
            if constexpr (SP2) {
            PG8_LDB(B0, 0, 0); PG8_LDB(B1, 0, 1); PG8_SCHED; PG8_LDA(At, 0, 0); PG8_STAGE(PG8_SA(1, 1), a1 + hstep, voffA);
            PG8_WAIT_V(8); PG8_WAIT_L(0); PG8_BAR; PG8_MMA(0, 0, At, B0); PG8_MMA(0, 1, At, B1); PG8_BAR; PG8_SCHED;
            PG8_LDA(At, 0, 1); PG8_STAGE(PG8_SB(0, 0), b2, voffB); PG8_STAGE(PG8_SB(0, 1), b2 + hstep, voffB); PG8_STAGE(PG8_SA(0, 0), a2, voffA);
            PG8_WAIT_V(8); PG8_WAIT_L(0); PG8_BAR; PG8_MMA(1, 0, At, B0); PG8_MMA(1, 1, At, B1); PG8_BAR; PG8_SCHED;
            PG8_LDB(B0, 1, 0); PG8_LDB(B1, 1, 1); PG8_SCHED; PG8_LDA(At, 1, 0); PG8_STAGE(PG8_SA(0, 1), a2 + hstep, voffA);
            PG8_WAIT_V(8); PG8_WAIT_L(0); PG8_BAR; PG8_MMA(0, 0, At, B0); PG8_MMA(0, 1, At, B1); PG8_BAR; PG8_SCHED;
            PG8_LDA(At, 1, 1); PG8_STAGE(PG8_SB(1, 0), b3, voffB); PG8_STAGE(PG8_SB(1, 1), b3 + hstep, voffB); PG8_STAGE(PG8_SA(1, 0), a3, voffA);
            PG8_WAIT_V(8); PG8_WAIT_L(0); PG8_BAR; PG8_MMA(1, 0, At, B0); PG8_MMA(1, 1, At, B1); PG8_BAR; PG8_SCHED;
            } else {
            PG8_LDB(B0, 0, 0); PG8_SCHED; PG8_LDA(At, 0, 0); PG8_STAGE(PG8_SA(1, 1), a1 + hstep, voffA);
            PG8_WAIT_L(8); PG8_BAR; PG8_WAIT_L(0); PG8_MMA(0, 0, At, B0); PG8_BAR; PG8_SCHED;
            PG8_LDB(B1, 0, 1); PG8_STAGE(PG8_SB(0, 0), b2, voffB);
            PG8_BAR; PG8_WAIT_L(0); PG8_MMA(0, 1, At, B1); PG8_BAR;
            PG8_LDA(At, 0, 1); PG8_STAGE(PG8_SA(0, 0), a2, voffA);
            PG8_BAR; PG8_WAIT_L(0); PG8_MMA(1, 0, At, B0); PG8_BAR; PG8_SCHED;
            PG8_STAGE(PG8_SB(0, 1), b2 + hstep, voffB);
            PG8_WAIT_V(6); PG8_BAR; PG8_MMA(1, 1, At, B1); PG8_BAR;
            PG8_LDB(B0, 1, 0); PG8_SCHED; PG8_LDA(At, 1, 0); PG8_STAGE(PG8_SA(0, 1), a2 + hstep, voffA);
            PG8_WAIT_L(8); PG8_BAR; PG8_WAIT_L(0); PG8_MMA(0, 0, At, B0); PG8_BAR; PG8_SCHED;
            PG8_LDB(B1, 1, 1); PG8_STAGE(PG8_SB(1, 0), b3, voffB);
            PG8_BAR; PG8_WAIT_L(0); PG8_MMA(0, 1, At, B1); PG8_BAR;
            PG8_LDA(At, 1, 1); PG8_STAGE(PG8_SA(1, 0), a3, voffA);
            PG8_BAR; PG8_WAIT_L(0); PG8_MMA(1, 0, At, B0); PG8_BAR; PG8_SCHED;
            PG8_STAGE(PG8_SB(1, 1), b3 + hstep, voffB);
            PG8_WAIT_V(6); PG8_BAR; PG8_MMA(1, 1, At, B1); PG8_BAR;
            }
        }
        if constexpr (ALIGN_EPI) { if (wr == 0) PG8_BAR; }
        if constexpr (!Epi::AFTER_DRAIN) { E(acc, cur, wr, wc, fr, fq); S.done(cur); }
        if (!has_next) break;
#pragma unroll
        for (int a = 0; a < 2; ++a)
#pragma unroll
            for (int b = 0; b < 2; ++b)
#pragma unroll
                for (int m = 0; m < 4; ++m)
#pragma unroll
                    for (int n = 0; n < 2; ++n) acc[a][b][m][n] = (f32x4){0.f, 0.f, 0.f, 0.f};
        cur = nxt; cA = nA; cB = nB; ++ui;
        if constexpr (ALIGN_EPI) { if (wr == 1) PG8_BAR; }
    }
    PG8_WAIT_V(0);
    if constexpr (!ALIGN_EPI) { if (wr == 0) PG8_BAR; }
    PG8_BAR;
    if constexpr (Epi::AFTER_DRAIN) { E.fused(acc, cur, wr, wc, fr, fq, lds, wid, lane); S.done(cur); }
#undef PG8_SA
#undef PG8_SB
#undef PG8_STAGE
#undef PG8_LDA
#undef PG8_LDB
#undef PG8_MMA
#undef PG8_WAIT_V
#undef PG8_WAIT_L
#undef PG8_BAR
#undef PG8_SCHED
}
}
#define GAS __attribute__((address_space(1)))
#define LAS __attribute__((address_space(3)))
typedef unsigned short bf16;
typedef unsigned v4u __attribute__((ext_vector_type(4)));
typedef float f32x4 __attribute__((ext_vector_type(4)));
typedef short bf16x8 __attribute__((ext_vector_type(8)));
typedef GAS unsigned gu32;
typedef GAS unsigned long long gu64;
#define RLX_AGENT __ATOMIC_RELAXED, __HIP_MEMORY_SCOPE_AGENT
#define LDS_WAIT() asm volatile("s_waitcnt lgkmcnt(0)" ::: "memory")
#define VM_WAIT() asm volatile("s_waitcnt vmcnt(0)" ::: "memory")
__device__ __forceinline__ unsigned long long rt() { return __builtin_amdgcn_s_memrealtime(); }
__device__ __forceinline__ unsigned f2bf(float f) { unsigned u = __builtin_bit_cast(unsigned, f); return (u + 0x7fffu + ((u >> 16) & 1u)) >> 16; }
__device__ __forceinline__ unsigned pk2(float lo, float hi) { return f2bf(lo) | (f2bf(hi) << 16); }

#define XB_TMO      128
#define XB_XCNT(j)  (256  + 64 * (j))
#define XB_XSUB(j)  (1280 + 64 * (j))
#define XB_XGEN(j)  (2304 + 64 * (j))
#define XB_TOP      3328
#define XB_TOPGEN   3392
#define XCD_BAR_WORDS 3456
#define XB_SPIN_CAP (1u << 18)

__device__ __forceinline__ unsigned xb_ld(unsigned* p)              { return __hip_atomic_load(p, __ATOMIC_RELAXED, __HIP_MEMORY_SCOPE_AGENT); }
__device__ __forceinline__ unsigned xb_add(unsigned* p, unsigned v) { return __hip_atomic_fetch_add(p, v, __ATOMIC_RELAXED, __HIP_MEMORY_SCOPE_AGENT); }
__device__ __forceinline__ unsigned xb_xcc_id() { return (unsigned)__builtin_amdgcn_s_getreg((3 << 11) | 20) & 0xFu; }
#define XB_SPIN(cond, bar) do { unsigned _sp = 0; while (cond) { __builtin_amdgcn_s_sleep(1); \
    if ((++_sp & 255u) == 0u) { if (xb_ld(&(bar)[XB_TMO])) break; if (_sp > XB_SPIN_CAP) { atomicAdd(&(bar)[XB_TMO], 1u); break; } } } } while (0)

struct XcdBarrier {
    unsigned* bar; unsigned x;
    volatile LAS unsigned* st;
};

__device__ __forceinline__ XcdBarrier xcd_barrier_post(unsigned* bar, volatile LAS unsigned* st) {
    XcdBarrier b; b.bar = bar; b.x = xb_xcc_id(); b.st = st;
    if (threadIdx.x == 0) (void)xb_add(&bar[XB_XCNT(b.x)], 1u);
    return b;
}
__device__ __forceinline__ void xcd_barrier_complete(unsigned* bar, unsigned x, unsigned& nloc, unsigned& nx) {
    const unsigned G = gridDim.x * gridDim.y * gridDim.z;
    unsigned sum, cnt, mine, sp = 0u;
    for (;;) {
        sum = 0u; cnt = 0u; mine = 0u;
#pragma unroll
        for (unsigned j = 0; j < 16; ++j) { const unsigned c = xb_ld(&bar[XB_XCNT(j)]); sum += c; cnt += (c > 0u) ? 1u : 0u; mine = (j == x) ? c : mine; }
        if (sum == G) break;
        __builtin_amdgcn_s_sleep(1);
        if ((++sp & 255u) == 0u) { if (xb_ld(&bar[XB_TMO])) break; if (sp > XB_SPIN_CAP) { atomicAdd(&bar[XB_TMO], 1u); break; } }
    }
    nloc = mine > 0u ? mine : 1u; nx = cnt > 0u ? cnt : 1u;
}

__device__ __forceinline__ void xcd_barrier(const XcdBarrier& b) {
    asm volatile("s_waitcnt vmcnt(0)" ::: "memory");
    __syncthreads();
    if (threadIdx.x == 0) {
        unsigned* bar = b.bar;
        __builtin_amdgcn_s_waitcnt(0);
        unsigned nloc = b.st[0], nx = b.st[1];
        if (nloc == 0u) { xcd_barrier_complete(bar, b.x, nloc, nx); b.st[0] = nloc; b.st[1] = nx; }
        const unsigned old = xb_add(&bar[XB_XSUB(b.x)], 1u);
        const unsigned gen = old / nloc;
        if (old + 1u == (gen + 1u) * nloc) {
            __builtin_amdgcn_fence(__ATOMIC_RELEASE, "agent");
            asm volatile("s_waitcnt vmcnt(0)" ::: "memory");
            const unsigned og = xb_add(&bar[XB_TOP], 1u);
            const unsigned tg = og / nx;
            if (og + 1u == (tg + 1u) * nx) xb_add(&bar[XB_TOPGEN], 1u);
            else XB_SPIN(xb_ld(&bar[XB_TOPGEN]) == tg, bar);
            __builtin_amdgcn_fence(__ATOMIC_ACQUIRE, "agent");
            xb_add(&bar[XB_XGEN(b.x)], 1u);
            asm volatile("s_waitcnt vmcnt(0)" ::: "memory");
        } else {
            XB_SPIN(xb_ld(&bar[XB_XGEN(b.x)]) == gen, bar);
            __builtin_amdgcn_fence(__ATOMIC_ACQUIRE, "agent");
            asm volatile("s_waitcnt vmcnt(0)" ::: "memory");
        }
    }
    __syncthreads();
}

constexpr size_t MiB = 1u << 20;
constexpr size_t WS_CTL = 0, CTL_ZERO_BYTES = 2 * MiB;
constexpr size_t WS_ROWSS = 256 * 1024, WS_MOD = 512 * 1024, WS_SB2 = 1 * MiB;
constexpr size_t WS_ROT = 2 * MiB, WS_WIN = 6 * MiB, WS_WOUT = 13 * MiB, WS_WGU = 15 * MiB, WS_WDN = 26 * MiB;
constexpr size_t WS_XN = 32 * MiB, WS_OB = 97 * MiB, WS_ACT = 162 * MiB, WS_H = WS_ACT, WS_END = 390 * MiB;
constexpr size_t ACT_STRIDE = (size_t)MT * 512;
static_assert(WS_ROWSS + (size_t)MT * 4 <= WS_MOD && WS_MOD + (size_t)NBT * 6 * DM * 4 <= WS_SB2 && WS_SB2 + (size_t)2 * NBT * DFF * 4 <= CTL_ZERO_BYTES, "ctl map");
static_assert(WS_WIN + (size_t)DIN * DM * 2 <= WS_WOUT && WS_WGU + (size_t)NGU * DM * 2 <= WS_WDN && WS_WDN + (size_t)DM * DFF * 2 <= WS_XN, "weights map");
static_assert(WS_XN + (size_t)MT * DM * 2 <= WS_OB && WS_OB + (size_t)MT * DM * 2 <= WS_ACT && WS_ACT + 7 * ACT_STRIDE * 2 <= WS_END && WS_H + (size_t)MT * DFF * 2 <= WS_END, "act map");
constexpr int CW_BAR = 4096;
constexpr int CW_QUEUE = 16384;
constexpr int RING_BYTES = 131072, LDSCTL_OFF = RING_BYTES, MISC_OFF = LDSCTL_OFF + 320;
constexpr int TAB_OFF = 132096, CB_OFF = TAB_OFF + 4096, WSC_OFF = CB_OFF + 64, QSLOT_OFF = WSC_OFF + 8 * 256, LDS_BYTES = 147456;
static_assert(QSLOT_OFF + 64 <= LDS_BYTES && MISC_OFF + 128 <= TAB_OFF, "LDS map");
constexpr int NWAVES = 8;

struct Frame {
    LAS unsigned char* lds; volatile LAS unsigned* MISC; gu32* ctl; int tid, lane, wave, G;
    const float* in[24]; float* out; unsigned char* ws;
};

__device__ __forceinline__ int dst_row(int mode, int n) {
    if (mode == 0) return n;
    if (mode == 1) { const int l = n & 255; return (n & ~255) + 128 * ((l >> 5) & 1) + 32 * (l >> 6) + (l & 31); }
    const int fl = n & 127; return (n >> 7) * 256 + 128 * (fl >> 6) + 32 * ((fl >> 4) & 3) + 16 * (mode - 2) + 4 * ((fl >> 2) & 3) + (fl & 3);
}
__device__ __forceinline__ void p0_transpose_item(const float* W, int K, int N, bf16* WT, int mode, LAS float* scr, int item, int lane) {
    const int nblk = N / 32, kb = item / nblk, nb = item % nblk, k0 = 64 * kb, n0 = 32 * nb;
#pragma unroll 8
    for (int i = 0; i < 32; ++i) { const int kk = 2 * i + (lane >> 5); scr[kk * 33 + (lane & 31)] = W[(size_t)(k0 + kk) * N + n0 + (lane & 31)]; }
    LDS_WAIT(); asm volatile("" ::: "memory");
    const int c = lane & 7;
#pragma unroll
    for (int j = 0; j < 4; ++j) { const int n = (lane >> 3) + 8 * j; const LAS float* s = scr + (8 * c) * 33 + n;
        v4u o; o.x = pk2(s[0 * 33], s[1 * 33]); o.y = pk2(s[2 * 33], s[3 * 33]); o.z = pk2(s[4 * 33], s[5 * 33]); o.w = pk2(s[6 * 33], s[7 * 33]);
        *(GAS v4u*)(WT + (size_t)dst_row(mode, n0 + n) * K + k0 + 8 * c) = o; }
    LDS_WAIT(); asm volatile("" ::: "memory");
}
__device__ __forceinline__ float wave_sum(float v) {
#pragma unroll
    for (int o = 1; o < 64; o <<= 1) v += __shfl_xor(v, o);
    return v;
}
__device__ __forceinline__ void gemv20_item(Frame& F, const float* W, int N, int e, bool valid, int kc, float* outp, int ostride, const float* bias) {
    LAS const float* sc = (LAS const float*)F.lds;
    float acc[NBT];
#pragma unroll
    for (int b = 0; b < NBT; ++b) acc[b] = 0.f;
    if (valid) {
#pragma unroll 4
        for (int d = 0; d < 64; ++d) { const float w = W[(size_t)(kc * 64 + d) * N + e];
#pragma unroll
            for (int b = 0; b < NBT; ++b) acc[b] += sc[b * 64 + d] * w; }
        const float bb = (bias && kc == 0) ? bias[e] : 0.f;
#pragma unroll
        for (int b = 0; b < NBT; ++b) atomicAdd(outp + (size_t)b * ostride + e, acc[b] + bb);
    }
}
__device__ __forceinline__ void p0a(Frame& F) {
    const float* cp = F.in[2]; const float* cs = F.in[3]; const float* w_ada = F.in[7]; const float* b_ada = F.in[8];
    float* mod = (float*)(F.ws + WS_MOD);
    const int it = blockIdx.x;
    if (it < 192) {
        const int cg = it % 12, kc = it / 12;
        LAS float* sc = (LAS float*)F.lds;
        for (int idx = F.tid; idx < NBT * 64; idx += 512) { const int b = idx >> 6, d = idx & 63;
            const float c = b < NBP ? cp[b * DM + kc * 64 + d] : cs[(b - NBP) * DM + kc * 64 + d]; sc[idx] = c / (1.f + __expf(-c)); }
        __syncthreads();
        gemv20_item(F, w_ada, 6 * DM, cg * 512 + F.tid, true, kc, mod, 6 * DM, b_ada);
        __syncthreads();
    }
    LAS float* scr = (LAS float*)(F.lds + F.wave * 16384);
    const int gw = blockIdx.x * NWAVES + F.wave, NGW = F.G * NWAVES;
    constexpr int I_IN = (DM / 64) * (DIN / 32), I_O = (DM / 64) * (DM / 32), I_G = (DM / 64) * (DFF / 32), I_D = (DFF / 64) * (DM / 32);
    constexpr int NITEMS = I_IN + I_O + 2 * I_G + I_D;
    bf16* win = (bf16*)(F.ws + WS_WIN); bf16* wout = (bf16*)(F.ws + WS_WOUT); bf16* wgu = (bf16*)(F.ws + WS_WGU); bf16* wdn = (bf16*)(F.ws + WS_WDN);
    for (int i = gw; i < NITEMS; i += NGW) {
        int r = i;
        if (r < I_IN) { p0_transpose_item(F.in[11], DM, DIN, win, 1, scr, r, F.lane); continue; } r -= I_IN;
        if (r < I_O) { p0_transpose_item(F.in[19], DM, DM, wout, 0, scr, r, F.lane); continue; } r -= I_O;
        if (r < I_G) { p0_transpose_item(F.in[20], DM, DFF, wgu, 2, scr, r, F.lane); continue; } r -= I_G;
        if (r < I_G) { p0_transpose_item(F.in[21], DM, DFF, wgu, 3, scr, r, F.lane); continue; } r -= I_G;
        p0_transpose_item(F.in[22], DFF, DM, wdn, 0, scr, r, F.lane);
    }
    float* rot = (float*)(F.ws + WS_ROT);
    for (int idx = blockIdx.x * 512 + F.tid; idx < 8192 * 64; idx += F.G * 512) {
        const int pos = idx >> 6, ip = idx & 63;
        const float inv = 1.0f / exp2f(((float)ip * (1.0f / 63.0f)) * 13.287712379549449f);
        const float ang = (float)pos * inv;
        const double rev = (double)ang * 0.15915494309189535; const float fr = (float)(rev - __builtin_rint(rev));
        float2 o; o.x = __builtin_amdgcn_cosf(fr); o.y = __builtin_amdgcn_sinf(fr);
        ((float2*)rot)[idx] = o;
    }
}
__device__ __forceinline__ void p0b(Frame& F) {
    const float* mod = (const float*)(F.ws + WS_MOD);
    const int it = blockIdx.x;
    if (it < 192) {
        const int mat = it & 1, rest = it >> 1, cg = rest % 6, kc = rest / 6;
        LAS float* sc = (LAS float*)F.lds;
        for (int idx = F.tid; idx < NBT * 64; idx += 512) { const int b = idx >> 6, d = idx & 63; sc[idx] = mod[(size_t)b * 6 * DM + 3 * DM + kc * 64 + d]; }
        __syncthreads();
        const int f = cg * 512 + F.tid;
        gemv20_item(F, (mat ? F.in[21] : F.in[20]), DFF, f, f < DFF, kc, (float*)(F.ws + WS_SB2) + (size_t)mat * NBT * DFF, DFF, nullptr);
        __syncthreads();
    }
    const float* g1 = F.in[9]; bf16* xn = (bf16*)(F.ws + WS_XN);
    const int gw = blockIdx.x * NWAVES + F.wave, NGW = F.G * NWAVES;
    for (int m = gw; m < MT; m += NGW) {
        const float* xrow = m < MP ? F.in[0] + (size_t)m * DM : F.in[1] + (size_t)(m - MP) * DM;
        const float* mb = mod + (size_t)row_batch(m) * 6 * DM;
        const GAS f32x4* xr = (const GAS f32x4*)xrow + F.lane;
        f32x4 v[4]; float s = 0.f;
#pragma unroll
        for (int j = 0; j < 4; ++j) { v[j] = xr[64 * j]; s += (v[j].x * v[j].x + v[j].y * v[j].y) + (v[j].z * v[j].z + v[j].w * v[j].w); }
        const float rstd = rsqrtf(wave_sum(s) * (1.f / DM) + EPSN);
        GAS unsigned long long* o8 = (GAS unsigned long long*)(xn + (size_t)m * DM) + F.lane;
#pragma unroll
        for (int j = 0; j < 4; ++j) { const int c = 4 * F.lane + 256 * j;
            const f32x4 g = *(const f32x4*)(g1 + c), sc1 = *(const f32x4*)(mb + DM + c), sh1 = *(const f32x4*)(mb + c);
            const f32x4 h = v[j] * rstd * g * (sc1 + 1.f) + sh1;
            o8[64 * j] = (unsigned long long)pk2(h.x, h.y) | ((unsigned long long)pk2(h.z, h.w) << 32); }
    }
}


namespace p2 {
typedef short bf16x8 __attribute__((ext_vector_type(8)));
typedef short s16x4 __attribute__((ext_vector_type(4)));
typedef float f32x16 __attribute__((ext_vector_type(16)));
typedef float f32x4 __attribute__((ext_vector_type(4)));
typedef unsigned u32x4 __attribute__((ext_vector_type(4)));
typedef unsigned u32x2 __attribute__((ext_vector_type(2)));
typedef float f32x2_t __attribute__((ext_vector_type(2))); typedef __bf16 bf16x2_t __attribute__((ext_vector_type(2)));
__device__ __forceinline__ unsigned cvtpk(float lo, float hi) { f32x2_t v = {lo, hi}; bf16x2_t b = __builtin_convertvector(v, bf16x2_t); return __builtin_bit_cast(unsigned, b); }
__device__ __forceinline__ int crow(int r, int hi) { return (r & 3) + 8 * (r >> 2) + 4 * hi; }
__device__ __forceinline__ s16x4 vtr(LAS const unsigned char* p) { return __builtin_bit_cast(s16x4, __builtin_amdgcn_ds_read_tr16_b64_v4i16((LAS s16x4*)p)); }
__device__ __forceinline__ bf16x8 cat8(s16x4 l, s16x4 h) { return (bf16x8){l[0], l[1], l[2], l[3], h[0], h[1], h[2], h[3]}; }
__device__ __forceinline__ bf16x8 pack8(f32x4 a, f32x4 b) { u32x4 w = {cvtpk(a[0], a[1]), cvtpk(a[2], a[3]), cvtpk(b[0], b[1]), cvtpk(b[2], b[3])}; return __builtin_bit_cast(bf16x8, w); }
__device__ __forceinline__ int v_st(int k, int c) { const int kk = (k & ~0xC) | ((k & 4) << 1) | ((k & 8) >> 1); return ((kk >> 3) * 4 + (c >> 5)) * 512 + ((kk & 7) * 32 + (c & 31)) * 2; }
__device__ __forceinline__ int v_rd_base(int lane) { return ((lane & 3) << 3) | (((lane >> 2) & 3) << 6) | (((lane >> 4) & 1) << 5) | (((lane >> 5) & 1) << 8); }
#define PK4(P, BASE, OUT) do { unsigned a0_ = cvtpk(P[BASE + 0], P[BASE + 1]), a1_ = cvtpk(P[BASE + 2], P[BASE + 3]);   \
    unsigned b0_ = cvtpk(P[BASE + 4], P[BASE + 5]), b1_ = cvtpk(P[BASE + 6], P[BASE + 7]);                              \
    auto r0_ = __builtin_amdgcn_permlane32_swap(a0_, b0_, false, false); auto r1_ = __builtin_amdgcn_permlane32_swap(a1_, b1_, false, false); \
    u32x4 w_ = {r0_[0], r1_[0], r0_[1], r1_[1]}; OUT = __builtin_bit_cast(bf16x8, w_); } while (0)

__device__ __forceinline__ int t5_bucket(int rel) {
    const int n = rel < 0 ? -rel : rel; const int ret = rel > 0 ? 16 : 0;
    const int large = n < 12 ? 8 : n < 16 ? 9 : n < 23 ? 10 : n < 32 ? 11 : n < 46 ? 12 : n < 64 ? 13 : n < 91 ? 14 : 15;
    return ret + (n < 8 ? n : large);
}
__device__ __forceinline__ void p2_setup(Frame& F) {
    const float* gq = F.in[12]; const float* gk = F.in[13]; const float* rb = F.in[23];
    float gqm = 0.f, gkm = 0.f, s1 = 0.f, s2 = 0.f;
    for (int d = 0; d < 64; ++d) { gqm = fmaxf(gqm, fabsf(gq[d])); gkm = fmaxf(gkm, fabsf(gk[d])); s1 += F.in[14][d] * F.in[15][d]; s2 += F.in[16][d] * F.in[17][d]; }
    LAS float* tab = (LAS float*)(F.lds + TAB_OFF); LAS float* cb = (LAS float*)(F.lds + CB_OFF);
    if (F.tid < 256) {
        const int rel = F.tid - 192; const int bk = t5_bucket(rel);
        for (int h = 0; h < 4; ++h) { float bm = -1e30f; for (int k = 0; k < 32; ++k) bm = fmaxf(bm, rb[k * 4 + h]);
            const float ch = 8.f * gqm * gkm * 1.02f + bm + 0.25f;
            tab[h * 256 + F.tid] = (rb[bk * 4 + h] - ch) * LOG2E;
            if (F.tid == 0) cb[h] = (rb[15 * 4 + h] - ch) * LOG2E; }
        if (F.tid == 0) cb[4] = __expf(s1) - __expf(s2) + LAM_INIT;
    }
    __syncthreads();
}

__device__ __forceinline__ void attn_finish(LAS unsigned char* lds, f32x16 (&o)[4], const float (&rl)[16], bool active, int mp, int rg, float lam, const float* gs, bf16* orow0, int lane) {
    const int r32 = lane & 31, hi = lane >> 5;
    LAS float* ex = (LAS float*)lds + rg * 4096;
    if (active && mp == 1) {
#pragma unroll
        for (int d0 = 0; d0 < 4; ++d0)
#pragma unroll
            for (int r = 0; r < 16; ++r) ex[(d0 * 16 + r) * 64 + lane] = o[d0][r] * rl[r];
    }
    __syncthreads();
    if (active && mp == 0) {
#pragma unroll
        for (int d0 = 0; d0 < 4; ++d0)
#pragma unroll
            for (int r = 0; r < 16; ++r) o[d0][r] = o[d0][r] * rl[r] - lam * ex[(d0 * 16 + r) * 64 + lane];
        float gsv[4];
#pragma unroll
        for (int d0 = 0; d0 < 4; ++d0) gsv[d0] = gs[32 * d0 + r32] * (1.f - LAM_INIT);
        LAS bf16* st = (LAS bf16*)ex;
#pragma unroll
        for (int r = 0; r < 16; ++r) {
            float s = (o[0][r] * o[0][r] + o[1][r] * o[1][r]) + (o[2][r] * o[2][r] + o[3][r] * o[3][r]);
            s += __shfl_xor(s, 1); s += __shfl_xor(s, 2); s += __shfl_xor(s, 4); s += __shfl_xor(s, 8); s += __shfl_xor(s, 16);
            const float rn = rsqrtf(s * (1.f / 128.f) + EPSN);
#pragma unroll
            for (int d0 = 0; d0 < 4; ++d0) st[crow(r, hi) * 136 + d0 * 32 + r32] = (bf16)f2bf(o[d0][r] * rn * gsv[d0]);
        }
#pragma unroll
        for (int i = 0; i < 8; ++i) { const int pi = i * 64 + lane, row = pi >> 4, ch = pi & 15;
            const u32x4 v = *(LAS const u32x4*)(st + row * 136 + ch * 8); *(u32x4*)(orow0 + (size_t)row * DM + ch * 8) = v; }
    }
    __syncthreads();
}

__device__ __forceinline__ void attn_unit(Frame& F, const bf16* QA, const bf16* KA, const bf16* VA, bf16* OB, int b, int h, int qblk, float lam) {
    LAS unsigned char* lds = F.lds; int tid = F.tid; asm volatile("" : "+v"(tid)); const int wid = F.wave, lane = tid & 63;
    const int r32 = lane & 31, hi = lane >> 5, mp = wid >> 2, rg = wid & 3;
    const int q0 = qblk * 128, qw0 = q0 + rg * 32; const size_t rowbase = (size_t)b * SEQ;
    bf16x8 qr[4];
    { const bf16* qp = QA + (rowbase + qw0 + r32) * 512 + h * 128 + mp * 64 + hi * 8;
#pragma unroll
      for (int d0 = 0; d0 < 4; ++d0) qr[d0] = *(const bf16x8*)(qp + d0 * 16); }
    f32x16 o[4];
#pragma unroll
    for (int d0 = 0; d0 < 4; ++d0)
#pragma unroll
        for (int r = 0; r < 16; ++r) o[d0][r] = 0.f;
    float lsum = 0.f;
    const int NTw = (qw0 >> 6) + 1, NTu = (q0 >> 6) + 2, far_max = qw0 - 154;
    const float cbh = ((LAS const float*)(lds + CB_OFF))[h];
    LAS const float* tab = (LAS const float*)(lds + TAB_OFF) + h * 256;
    const int skey = tid >> 4, sc16 = tid & 15, kc = sc16 & 7;
    const bf16* kg = KA + (rowbase + skey) * 512 + h * 128 + sc16 * 8;
    const bf16* vg = VA + (rowbase + skey) * 512 + h * 128 + sc16 * 8;
    const int koff0 = (sc16 >> 3) * 8192 + kc * 1024 + ((skey & ~7) | ((skey ^ kc) & 7)) * 16, koff1 = koff0 + 512;
    const int voff0 = 16384 + v_st(skey, sc16 * 8), voff1 = 16384 + v_st(skey + 32, sc16 * 8);
    int ka[4];
#pragma unroll
    for (int d0 = 0; d0 < 4; ++d0) { const int c = 2 * d0 + hi; ka[d0] = mp * 8192 + c * 1024 + ((r32 & ~7) | ((r32 ^ c) & 7)) * 16; }
    const int vrb = 16384 + v_rd_base(lane);
    u32x4 s0, s1, s2, s3;
#define LOADT(t) do { const size_t go_ = (size_t)(t) * 64 * 512; s0 = *(const u32x4*)(kg + go_); s1 = *(const u32x4*)(kg + go_ + 32 * 512); s2 = *(const u32x4*)(vg + go_); s3 = *(const u32x4*)(vg + go_ + 32 * 512); } while (0)
#define WRITET(bo) do { *(LAS u32x4*)(lds + (bo) + koff0) = s0; *(LAS u32x4*)(lds + (bo) + koff1) = s1; *(LAS u32x4*)(lds + (bo) + voff0) = s2; *(LAS u32x4*)(lds + (bo) + voff1) = s3; } while (0)
    LOADT(0); WRITET(0); __syncthreads();
    for (int t = 0; t < NTu; ++t) {
        const int cur = (t & 1) * 32768;
        if (t + 1 < NTu) LOADT(t + 1);
        if (t < NTw) {
            const bool far = (64 * t <= far_max);
            const float ci = far ? cbh : 0.f;
            f32x16 p0, p1;
#pragma unroll
            for (int r = 0; r < 16; ++r) { p0[r] = ci; p1[r] = ci; }
#pragma unroll
            for (int d0 = 0; d0 < 4; ++d0) {
                const bf16x8 b0 = *(LAS const bf16x8*)(lds + cur + ka[d0]), b1 = *(LAS const bf16x8*)(lds + cur + ka[d0] + 512);
                p0 = __builtin_amdgcn_mfma_f32_32x32x16_bf16(b0, qr[d0], p0, 0, 0, 0);
                p1 = __builtin_amdgcn_mfma_f32_32x32x16_bf16(b1, qr[d0], p1, 0, 0, 0);
            }
            if (!far) {
                const int bi = 64 * t - qw0 - r32 + 4 * hi + 192;
#pragma unroll
                for (int r = 0; r < 16; ++r) { p0[r] += tab[bi + (r & 3) + 8 * (r >> 2)]; p1[r] += tab[bi + 32 + (r & 3) + 8 * (r >> 2)]; }
            }
            float ps = 0.f;
#pragma unroll
            for (int r = 0; r < 16; ++r) { p0[r] = __builtin_amdgcn_exp2f(p0[r]); p1[r] = __builtin_amdgcn_exp2f(p1[r]); ps += p0[r] + p1[r]; }
            lsum += ps;
            bf16x8 pa0, pa1, pa2, pa3;
            PK4(p0, 0, pa0); PK4(p0, 8, pa1); PK4(p1, 0, pa2); PK4(p1, 8, pa3);
            LAS const unsigned char* vb = lds + cur + vrb;
#pragma unroll
            for (int d0 = 0; d0 < 4; ++d0) {
                const bf16x8 v0 = cat8(vtr(vb + d0 * 512), vtr(vb + d0 * 512 + 2048));
                const bf16x8 v1 = cat8(vtr(vb + d0 * 512 + 4096), vtr(vb + d0 * 512 + 4096 + 2048));
                const bf16x8 v2 = cat8(vtr(vb + d0 * 512 + 8192), vtr(vb + d0 * 512 + 8192 + 2048));
                const bf16x8 v3 = cat8(vtr(vb + d0 * 512 + 12288), vtr(vb + d0 * 512 + 12288 + 2048));
                o[d0] = __builtin_amdgcn_mfma_f32_32x32x16_bf16(pa0, v0, o[d0], 0, 0, 0);
                o[d0] = __builtin_amdgcn_mfma_f32_32x32x16_bf16(pa1, v1, o[d0], 0, 0, 0);
                o[d0] = __builtin_amdgcn_mfma_f32_32x32x16_bf16(pa2, v2, o[d0], 0, 0, 0);
                o[d0] = __builtin_amdgcn_mfma_f32_32x32x16_bf16(pa3, v3, o[d0], 0, 0, 0);
            }
        }
        if (t + 1 < NTu) WRITET(cur ^ 32768);
        __syncthreads();
    }
#undef LOADT
#undef WRITET
    { auto rr = __builtin_amdgcn_permlane32_swap(__float_as_uint(lsum), __float_as_uint(lsum), false, false); lsum = __uint_as_float(rr[0]) + __uint_as_float(rr[1]); }
    LAS float* wsc = (LAS float*)(lds + WSC_OFF) + wid * 64;
    if (hi == 0) wsc[r32] = lsum;
    float rl[16];
#pragma unroll
    for (int r = 0; r < 16; ++r) rl[r] = 1.f / wsc[crow(r, hi)];
    attn_finish(lds, o, rl, true, mp, rg, lam, F.in[18], OB + (rowbase + qw0) * DM + h * 128, lane);
}

__device__ __forceinline__ void sattn_unit(Frame& F, const bf16* QA, bf16* OB, int bs, int h, float lam) {
    LAS unsigned char* lds = F.lds; int tid = F.tid; asm volatile("" : "+v"(tid)); const int wid = F.wave, lane = tid & 63;
    const int r32 = lane & 31, hi = lane >> 5, mp = wid >> 2, sp = wid & 3;
    const size_t row0 = (size_t)MP + (size_t)bs * LS;
    bf16x8 qr[4];
    { const bf16* qp = QA + (row0 + r32) * 512 + h * 128 + mp * 64 + hi * 8;
#pragma unroll
      for (int d0 = 0; d0 < 4; ++d0) qr[d0] = *(const bf16x8*)(qp + d0 * 16); }
    f32x16 o[4];
#pragma unroll
    for (int d0 = 0; d0 < 4; ++d0)
#pragma unroll
        for (int r = 0; r < 16; ++r) o[d0][r] = 0.f;
    float lsum = 0.f;
    LAS const float* tab = (LAS const float*)(lds + TAB_OFF) + h * 256;
    for (int tt = sp; tt < 65; tt += 4) {
        const float* kp; const float* vp;
        if (tt < 64) { const size_t off = ((size_t)(bs * PAST + tt * 32) * 4 + h) * 128; kp = F.in[4] + off; vp = F.in[5] + off; }
        else { const size_t off = ((size_t)(bs * LS) * 4 + h) * 128; kp = F.out + OFF_KS + off; vp = F.out + OFF_VS + off; }
        f32x16 p;
#pragma unroll
        for (int r = 0; r < 16; ++r) p[r] = 0.f;
#pragma unroll
        for (int d0 = 0; d0 < 4; ++d0) { const float* a = kp + (size_t)r32 * 512 + mp * 64 + d0 * 16 + hi * 8;
            const bf16x8 kf = pack8(*(const f32x4*)a, *(const f32x4*)(a + 4));
            p = __builtin_amdgcn_mfma_f32_32x32x16_bf16(kf, qr[d0], p, 0, 0, 0); }
        const int relb = tt * 32 - PAST - r32 + 4 * hi;
        float ps = 0.f;
#pragma unroll
        for (int r = 0; r < 16; ++r) { int rel = relb + (r & 3) + 8 * (r >> 2); rel = rel < -192 ? -192 : rel; p[r] = __builtin_amdgcn_exp2f(p[r] + tab[rel + 192]); ps += p[r]; }
        lsum += ps;
        bf16x8 pa0, pa1;
        PK4(p, 0, pa0); PK4(p, 8, pa1);
#pragma unroll
        for (int d0 = 0; d0 < 4; ++d0) {
            const float* v0p = vp + (size_t)(8 * hi) * 512 + 32 * d0 + r32;
            f32x4 a, c, e, g;
            a[0] = v0p[0 * 512]; a[1] = v0p[1 * 512]; a[2] = v0p[2 * 512]; a[3] = v0p[3 * 512]; c[0] = v0p[4 * 512]; c[1] = v0p[5 * 512]; c[2] = v0p[6 * 512]; c[3] = v0p[7 * 512];
            e[0] = v0p[16 * 512]; e[1] = v0p[17 * 512]; e[2] = v0p[18 * 512]; e[3] = v0p[19 * 512]; g[0] = v0p[20 * 512]; g[1] = v0p[21 * 512]; g[2] = v0p[22 * 512]; g[3] = v0p[23 * 512];
            o[d0] = __builtin_amdgcn_mfma_f32_32x32x16_bf16(pa0, pack8(a, c), o[d0], 0, 0, 0);
            o[d0] = __builtin_amdgcn_mfma_f32_32x32x16_bf16(pa1, pack8(e, g), o[d0], 0, 0, 0);
        }
    }
    { auto rr = __builtin_amdgcn_permlane32_swap(__float_as_uint(lsum), __float_as_uint(lsum), false, false); lsum = __uint_as_float(rr[0]) + __uint_as_float(rr[1]); }
    LAS float* exb = (LAS float*)lds; LAS float* wsc = (LAS float*)(lds + WSC_OFF);
    if (hi == 0) wsc[wid * 64 + r32] = lsum;
    if (sp > 0) { LAS float* e = exb + (mp * 3 + sp - 1) * 4096;
#pragma unroll
        for (int d0 = 0; d0 < 4; ++d0)
#pragma unroll
            for (int r = 0; r < 16; ++r) e[(d0 * 16 + r) * 64 + lane] = o[d0][r]; }
    __syncthreads();
    float rl[16];
    if (sp == 0) {
#pragma unroll
        for (int k = 0; k < 3; ++k) { LAS const float* e = exb + (mp * 3 + k) * 4096;
#pragma unroll
            for (int d0 = 0; d0 < 4; ++d0)
#pragma unroll
                for (int r = 0; r < 16; ++r) o[d0][r] += e[(d0 * 16 + r) * 64 + lane]; }
#pragma unroll
        for (int r = 0; r < 16; ++r) { const int q = crow(r, hi); rl[r] = 1.f / ((wsc[(mp * 4 + 0) * 64 + q] + wsc[(mp * 4 + 1) * 64 + q]) + (wsc[(mp * 4 + 2) * 64 + q] + wsc[(mp * 4 + 3) * 64 + q])); }
    } else {
#pragma unroll
        for (int r = 0; r < 16; ++r) rl[r] = 0.f;
    }
    __syncthreads();
    attn_finish(lds, o, rl, sp == 0, mp, 0, lam, F.in[18], OB + row0 * DM + h * 128, lane);
}

constexpr int RT_ROW = 288, RT_TILE = 64 * RT_ROW, RT_BUF = 3 * RT_TILE, RT_P = 2 * RT_BUF, RT_PROW = 144, RT_RED = RT_P + 64 * RT_PROW;
static_assert(RT_RED + 8 * 64 * 4 <= RING_BYTES, "retention LDS");
__device__ __forceinline__ void ret_prompt(Frame& F, const bf16* QR, const bf16* KR, const bf16* VR, const bf16* GR, bf16* OB, int b, int h) {
    LAS unsigned char* lds = F.lds; int tid = F.tid; asm volatile("" : "+v"(tid)); const int w = F.wave, lane = tid & 63;
    const int fr = lane & 15, g = lane >> 4, q4 = fr >> 2, p4 = fr & 3;
    const float l2g = __log2f(1.f - exp2f(-5.f - (float)h)); const float g64 = exp2f(64.f * l2g);
    float cs[4];
#pragma unroll
    for (int it = 0; it < 4; ++it) { const int i = 16 * it + fr; cs[it] = exp2f((float)(i + 1) * l2g); }
    f32x4 S[8];
#pragma unroll
    for (int kt = 0; kt < 8; ++kt) S[kt] = (f32x4){0.f, 0.f, 0.f, 0.f};
    const size_t rowbase = (size_t)b * SEQ;
    const int srow = tid >> 4, sc16 = tid & 15;
    const size_t gofs = (rowbase + srow) * 512 + h * 128 + sc16 * 8;
    const int lofs = srow * RT_ROW + sc16 * 16;
    u32x4 st[6];
#define RLOAD(c) do { const size_t go_ = gofs + (size_t)(c) * 64 * 512; st[0] = *(const u32x4*)(QR + go_); st[1] = *(const u32x4*)(QR + go_ + 32 * 512); \
        st[2] = *(const u32x4*)(KR + go_); st[3] = *(const u32x4*)(KR + go_ + 32 * 512); st[4] = *(const u32x4*)(VR + go_); st[5] = *(const u32x4*)(VR + go_ + 32 * 512); } while (0)
#define RWRITE(bo) do { _Pragma("unroll") for (int j_ = 0; j_ < 6; ++j_) *(LAS u32x4*)(lds + (bo) + (j_ >> 1) * RT_TILE + (j_ & 1) * 32 * RT_ROW + lofs) = st[j_]; } while (0)
    RLOAD(0); RWRITE(0); __syncthreads();
    LAS float* red = (LAS float*)(lds + RT_RED);
    for (int c = 0; c < SEQ / 64; ++c) {
        const int cur = (c & 1) * RT_BUF;
        LAS const unsigned char* Qt = lds + cur; LAS const unsigned char* Kt = lds + cur + RT_TILE; LAS const unsigned char* Vt = lds + cur + 2 * RT_TILE;
        if (c + 1 < SEQ / 64) RLOAD(c + 1);
        { const int it = w >> 1; const int i = 16 * it + fr; const float ps_ = exp2f((float)(i - 63) * l2g);
#pragma unroll
          for (int jj = 0; jj < 2; ++jj) { const int jt = 2 * (w & 1) + jj;
            f32x4 acc = (f32x4){0.f, 0.f, 0.f, 0.f};
            if (jt <= it) {
#pragma unroll
                for (int ks = 0; ks < 4; ++ks) { const bf16x8 a = *(LAS const bf16x8*)(Kt + (16 * jt + fr) * RT_ROW + (32 * ks + 8 * g) * 2);
                    const bf16x8 bq = *(LAS const bf16x8*)(Qt + (16 * it + fr) * RT_ROW + (32 * ks + 8 * g) * 2);
                    acc = __builtin_amdgcn_mfma_f32_16x16x32_bf16(a, bq, acc, 0, 0, 0); }
            }
            const int j0 = 16 * jt + 4 * g; u32x2 wv;
            wv.x = cvtpk(j0 + 0 <= i ? acc[0] * ps_ : 0.f, j0 + 1 <= i ? acc[1] * ps_ : 0.f); wv.y = cvtpk(j0 + 2 <= i ? acc[2] * ps_ : 0.f, j0 + 3 <= i ? acc[3] * ps_ : 0.f);
            *(LAS u32x2*)(lds + RT_P + i * RT_PROW + j0 * 2) = wv; } }
        f32x4 X[4];
        { bf16x8 af[4];
#pragma unroll
          for (int s = 0; s < 4; ++s) af[s] = pack8(S[2 * s], S[2 * s + 1]);
#pragma unroll
          for (int it = 0; it < 4; ++it) { X[it] = (f32x4){0.f, 0.f, 0.f, 0.f};
#pragma unroll
            for (int s = 0; s < 4; ++s) { LAS const unsigned char* qa = Qt + (16 * it + fr) * RT_ROW + (32 * s + 4 * g) * 2;
                const s16x4 lo = *(LAS const s16x4*)qa, hi4 = *(LAS const s16x4*)(qa + 32);
                X[it] = __builtin_amdgcn_mfma_f32_16x16x32_bf16(af[s], cat8(lo, hi4), X[it], 0, 0, 0); } } }
        __syncthreads();
        bf16x8 vf[2];
#pragma unroll
        for (int ks = 0; ks < 2; ++ks) { LAS const unsigned char* va = Vt + (32 * ks + 8 * g + q4) * RT_ROW + (16 * w + 4 * p4) * 2; vf[ks] = cat8(vtr(va), vtr(va + 4 * RT_ROW)); }
        f32x4 Y[4];
#pragma unroll
        for (int it = 0; it < 4; ++it) { Y[it] = (f32x4){0.f, 0.f, 0.f, 0.f};
#pragma unroll
            for (int ks = 0; ks < 2; ++ks) { const bf16x8 pb = *(LAS const bf16x8*)(lds + RT_P + (16 * it + fr) * RT_PROW + (32 * ks + 8 * g) * 2);
                Y[it] = __builtin_amdgcn_mfma_f32_16x16x32_bf16(vf[ks], pb, Y[it], 0, 0, 0); } }
#pragma unroll
        for (int kt = 0; kt < 8; ++kt) { S[kt] = S[kt] * g64;
#pragma unroll
            for (int ks = 0; ks < 2; ++ks) { LAS const unsigned char* ka_ = Kt + (32 * ks + 8 * g + q4) * RT_ROW + (16 * kt + 4 * p4) * 2;
                S[kt] = __builtin_amdgcn_mfma_f32_16x16x32_bf16(cat8(vtr(ka_), vtr(ka_ + 4 * RT_ROW)), vf[ks], S[kt], 0, 0, 0); } }
        f32x4 ov[4];
#pragma unroll
        for (int it = 0; it < 4; ++it) { ov[it] = Y[it] + X[it] * cs[it];
            float sq = (ov[it][0] * ov[it][0] + ov[it][1] * ov[it][1]) + (ov[it][2] * ov[it][2] + ov[it][3] * ov[it][3]);
            sq += __shfl_xor(sq, 16); sq += __shfl_xor(sq, 32);
            if (g == 0) red[w * 64 + 16 * it + fr] = sq; }
        if (c + 1 < SEQ / 64) RWRITE(cur ^ RT_BUF);
        __syncthreads();
#pragma unroll
        for (int it = 0; it < 4; ++it) { const int i = 16 * it + fr; float tot = 0.f;
#pragma unroll
            for (int ww = 0; ww < 8; ++ww) tot += red[ww * 64 + i];
            const float rstd = rsqrtf(tot * (1.f / 128.f) + EPSN);
            const size_t row = rowbase + (size_t)c * 64 + i;
            const u32x2 gv = *(const u32x2*)(GR + row * 512 + h * 128 + 16 * w + 4 * g);
            const float g0 = __uint_as_float(gv.x << 16), g1 = __uint_as_float(gv.x & 0xffff0000u), g2 = __uint_as_float(gv.y << 16), g3 = __uint_as_float(gv.y & 0xffff0000u);
            u32x2 ow; ow.x = cvtpk(ov[it][0] * rstd * g0, ov[it][1] * rstd * g1); ow.y = cvtpk(ov[it][2] * rstd * g2, ov[it][3] * rstd * g3);
            *(u32x2*)(OB + row * DM + 512 + h * 128 + 16 * w + 4 * g) = ow; }
    }
#undef RLOAD
#undef RWRITE
    float* rp = F.out + OFF_RP + ((size_t)(b * 4 + h) * 128) * 128;
#pragma unroll
    for (int kt = 0; kt < 8; ++kt)
#pragma unroll
        for (int r = 0; r < 4; ++r) rp[(size_t)(16 * kt + 4 * g + r) * 128 + 16 * w + fr] = S[kt][r];
    __syncthreads();
}

__device__ __forceinline__ void ret_sample(Frame& F, const bf16* QR, const bf16* KR, const bf16* VR, const bf16* GR, bf16* OB, int bs, int h) {
    LAS unsigned char* lds = F.lds; int tid = F.tid; asm volatile("" : "+v"(tid));
    constexpr int RS = 132;
    LAS float* q = (LAS float*)lds; LAS float* k = q + 32 * RS; LAS float* v = k + 32 * RS; LAS float* P = v + 32 * RS; LAS float* red = P + 32 * 33;
    const float l2g = __log2f(1.f - exp2f(-5.f - (float)h));
    const size_t row0 = (size_t)MP + (size_t)bs * LS;
    for (int idx = tid; idx < 3 * 32 * 128; idx += 512) { const int t = idx >> 12, i = (idx >> 7) & 31, d = idx & 127;
        const bf16* src = t == 0 ? QR : t == 1 ? KR : VR; const float val = __uint_as_float((unsigned)src[(row0 + i) * 512 + h * 128 + d] << 16);
        (t == 0 ? q : t == 1 ? k : v)[i * RS + d] = val; }
    __syncthreads();
    for (int idx = tid; idx < 1024; idx += 512) { const int i = idx >> 5, j = idx & 31; float s = 0.f;
        if (j <= i) { for (int d = 0; d < 128; ++d) s += q[i * RS + d] * k[j * RS + d]; s *= exp2f((float)(i - 31) * l2g); }
        P[i * 33 + j] = s; }
    __syncthreads();
    const int dv = tid & 127, ig = tid >> 7;
    const float* S0 = F.in[6] + ((size_t)(bs * 4 + h) * 128) * 128;
    float oc[8], oi[8];
#pragma unroll
    for (int a = 0; a < 8; ++a) { oc[a] = 0.f; oi[a] = 0.f; }
    for (int dk = 0; dk < 128; ++dk) { const float s = S0[(size_t)dk * 128 + dv];
#pragma unroll
        for (int a = 0; a < 8; ++a) oc[a] += q[(ig * 8 + a) * RS + dk] * s; }
    for (int j = 0; j < 32; ++j) { const float vv = v[j * RS + dv];
#pragma unroll
        for (int a = 0; a < 8; ++a) oi[a] += P[(ig * 8 + a) * 33 + j] * vv; }
    { const float g32 = exp2f(32.f * l2g); float* rs = F.out + OFF_RS + ((size_t)(bs * 4 + h) * 128) * 128;
      for (int dk = ig * 32; dk < ig * 32 + 32; ++dk) { float s = g32 * S0[(size_t)dk * 128 + dv];
          for (int i = 0; i < 32; ++i) s += k[i * RS + dk] * v[i * RS + dv];
          rs[(size_t)dk * 128 + dv] = s; } }
    float ov[8];
#pragma unroll
    for (int a = 0; a < 8; ++a) { const int i = ig * 8 + a; ov[a] = oi[a] + exp2f((float)(i + 1) * l2g) * oc[a];
        float sq = ov[a] * ov[a];
#pragma unroll
        for (int o_ = 1; o_ < 64; o_ <<= 1) sq += __shfl_xor(sq, o_);
        if ((tid & 63) == 0) red[i * 2 + ((tid >> 6) & 1)] = sq; }
    __syncthreads();
#pragma unroll
    for (int a = 0; a < 8; ++a) { const int i = ig * 8 + a; const float rstd = rsqrtf((red[i * 2] + red[i * 2 + 1]) * (1.f / 128.f) + EPSN);
        const float gt = __uint_as_float((unsigned)GR[(row0 + i) * 512 + h * 128 + dv] << 16);
        OB[(row0 + i) * DM + 512 + h * 128 + dv] = (bf16)f2bf(ov[a] * rstd * gt); }
    __syncthreads();
}

__device__ __forceinline__ int q_next(Frame& F, int q) {
    volatile LAS int* slot = (volatile LAS int*)(F.lds + QSLOT_OFF);
    if (F.tid == 0) *slot = (int)__hip_atomic_fetch_add((unsigned*)(F.ctl + CW_QUEUE + 64 * q), 1u, __ATOMIC_RELAXED, __HIP_MEMORY_SCOPE_AGENT);
    __syncthreads();
    const int v = *slot;
    __syncthreads();
    return v;
}
constexpr int Q_ITEMS = 2 + 128 + 8 + 8;
__device__ __forceinline__ void phase2(Frame& F) {
    p2_setup(F);
    const float lam = ((LAS const float*)(F.lds + CB_OFF))[4];
    bf16* act = (bf16*)(F.ws + WS_ACT);
    const bf16* QA = act, *KA = act + ACT_STRIDE, *VA = act + 2 * ACT_STRIDE, *QR = act + 3 * ACT_STRIDE, *KR = act + 4 * ACT_STRIDE, *VR = act + 5 * ACT_STRIDE, *GR = act + 6 * ACT_STRIDE;
    bf16* OB = (bf16*)(F.ws + WS_OB);
    const int xcc = (int)(xb_xcc_id() & 7u);
    for (int k = 0; k < 8; ++k) {
        const int q = (xcc + k) & 7;
        for (;;) {
            const int i = q_next(F, q);
            if (i >= Q_ITEMS) break;
#ifndef P2M
#define P2M 15
#endif
            if (i < 2) { if (P2M & 1) { const int bh = 2 * q + i; ret_prompt(F, QR, KR, VR, GR, OB, bh >> 2, bh & 3); } }
            else if (i < 130) { if (P2M & 2) { const int j = i - 2, bh = 2 * q + (j & 1); attn_unit(F, QA, KA, VA, OB, bh >> 2, bh & 3, 63 - (j >> 1), lam); } }
            else if (i < 138) { if (P2M & 4) { const int id = 8 * q + (i - 130); sattn_unit(F, QA, OB, id >> 2, id & 3, lam); } }
            else { if (P2M & 8) { const int id = 8 * q + (i - 138); ret_sample(F, QR, KR, VR, GR, OB, id >> 2, id & 3); } }
        }
    }
}
}


struct Args { const float* in[24]; float* out; unsigned char* ws; };
__global__ void __launch_bounds__(NWAVES * 64, 2) fwd_megakernel(Args args) {
    extern __shared__ __attribute__((aligned(16))) unsigned char lds[];
    Frame F;
    F.lds = (LAS unsigned char*)lds; F.MISC = (volatile LAS unsigned*)(F.lds + MISC_OFF);
    F.tid = threadIdx.x; F.lane = F.tid & 63; F.wave = __builtin_amdgcn_readfirstlane(F.tid >> 6); F.G = gridDim.x;
#pragma unroll
    for (int i = 0; i < 24; ++i) F.in[i] = args.in[i];
    F.out = args.out; F.ws = args.ws; F.ctl = (gu32*)(args.ws + WS_CTL);
    for (int u = F.tid; u < (LDS_BYTES - LDSCTL_OFF) / 4; u += NWAVES * 64) ((LAS unsigned*)(F.lds + LDSCTL_OFF))[u] = 0u;
    __syncthreads();
    XcdBarrier bar = xcd_barrier_post((unsigned*)(F.ctl + CW_BAR), F.MISC + 8);

    bf16* act = (bf16*)(F.ws + WS_ACT); bf16* XN = (bf16*)(F.ws + WS_XN); bf16* OB = (bf16*)(F.ws + WS_OB); bf16* HB = (bf16*)(F.ws + WS_H);
    float* mod = (float*)(F.ws + WS_MOD); float* rowss = (float*)(F.ws + WS_ROWSS); float* sb2 = (float*)(F.ws + WS_SB2);

#ifndef PHM
#define PHM 127
#endif
    if (PHM & 1) p0a(F);
    xcd_barrier(bar);
    if (PHM & 2) p0b(F);
    xcd_barrier(bar);
    if (PHM & 4) {
        pg8::Gemm g{XN, (const bf16*)(F.ws + WS_WIN), MT, DIN, DM}; pg8::StaticOrder S; S.init(MT, DIN, F.G, (int)blockIdx.x);
        pg8::EpiIn E{act, F.out, F.in[12], F.in[13], (const float*)(F.ws + WS_ROT)};
        pg8::gemm_phase<pg8::EpiIn, pg8::StaticOrder, true, true>(F.lds, g, S, E);
    }
    xcd_barrier(bar);
    if (PHM & 8) p2::phase2(F);
    xcd_barrier(bar);
    if (PHM & 16) {
        pg8::Gemm g{OB, (const bf16*)(F.ws + WS_WOUT), MT, DM, DM}; pg8::StaticOrder S; S.init(MT, DM, F.G, (int)blockIdx.x);
        pg8::EpiOut E{F.in[0], F.in[1], F.out + OFF_Y, XN, mod, F.in[10], rowss};
        pg8::gemm_phase<pg8::EpiOut, pg8::StaticOrder, true, true>(F.lds, g, S, E);
    }
    xcd_barrier(bar);
    if (PHM & 32) {
        pg8::Gemm g{XN, (const bf16*)(F.ws + WS_WGU), MT, NGU, DM}; pg8::StaticOrder S; S.init(MT, NGU, F.G, (int)blockIdx.x);
        pg8::EpiFF1 E{rowss, sb2, sb2 + (size_t)NBT * DFF, HB};
        pg8::gemm_phase<pg8::EpiFF1, pg8::StaticOrder, true, true>(F.lds, g, S, E);
    }
    xcd_barrier(bar);
    if (PHM & 64) {
        pg8::Gemm g{HB, (const bf16*)(F.ws + WS_WDN), MT, DM, DFF}; pg8::StaticOrder S; S.init(MT, DM, F.G, (int)blockIdx.x);
        pg8::EpiFF2 E{F.out + OFF_Y, mod};
        pg8::gemm_phase<pg8::EpiFF2, pg8::StaticOrder, true, true>(F.lds, g, S, E);
    }
}

extern "C" void kernel_launch(void* const* d_in, const int* in_sizes, int n_in, void* d_out, int out_size, void* d_ws, size_t ws_size, hipStream_t stream) {
    static int grid = 0;
    if (grid == 0) {
        if (n_in != 24 || in_sizes[0] != MP * DM || (size_t)out_size != OUT_TOTAL || ws_size < WS_END) {
            fprintf(stderr, "kernel_launch: unexpected shapes: n_in %d in0 %d out %d ws %zu (need >= %zu)\n", n_in, n_in > 0 ? in_sizes[0] : -1, out_size, ws_size, (size_t)WS_END); grid = -1; return; }
        int dev = 0, cus = 0, per_cu = 0;
        if (hipGetDevice(&dev) != hipSuccess || hipDeviceGetAttribute(&cus, hipDeviceAttributeMultiprocessorCount, dev) != hipSuccess) { fprintf(stderr, "kernel_launch: device query failed\n"); grid = -1; return; }
        if (hipFuncSetAttribute((const void*)fwd_megakernel, hipFuncAttributeMaxDynamicSharedMemorySize, LDS_BYTES) != hipSuccess) { fprintf(stderr, "kernel_launch: hipFuncSetAttribute failed\n"); grid = -1; return; }
        if (hipOccupancyMaxActiveBlocksPerMultiprocessor(&per_cu, (const void*)fwd_megakernel, NWAVES * 64, LDS_BYTES) != hipSuccess || per_cu < 1) { fprintf(stderr, "kernel_launch: occupancy query says %d blocks/CU\n", per_cu); per_cu = 1; }
        (void)hipGetLastError();
        grid = cus;
    }
    if (grid < 0) return;
    if (hipMemsetAsync((char*)d_ws + WS_CTL, 0, CTL_ZERO_BYTES, stream) != hipSuccess) { fprintf(stderr, "kernel_launch: memset failed\n"); return; }
    Args a{};
    for (int i = 0; i < 24; ++i) a.in[i] = (const float*)d_in[i];
    a.out = (float*)d_out; a.ws = (unsigned char*)d_ws;
    void* kargs[] = {&a};
    hipError_t e = hipLaunchCooperativeKernel((const void*)fwd_megakernel, dim3(grid), dim3(NWAVES * 64), kargs, LDS_BYTES, stream);
    if (e != hipSuccess) fprintf(stderr, "kernel_launch: cooperative launch failed: %s (grid %d)\n", hipGetErrorString(e), grid);
}
```

```cpp
#include <hip/hip_runtime.h>
#include <hip/hip_bf16.h>
#include <cstdio>
#include <cstdint>
#include <cmath>

constexpr int DM = 1024, NBP = 4, SEQ = 8192, NBS = 16, LS = 32, PAST = 2048;
constexpr int MP = NBP * SEQ, MS = NBS * LS, MT = MP + MS;
constexpr int DIN = 3584, DFF = 2816, NGU = 2 * DFF, NBT = NBP + NBS;
constexpr float EPSN = 1e-6f;
constexpr float LOG2E = 1.4426950408889634f;
constexpr float QSCALE = 0.125f * LOG2E;
constexpr float LAM_INIT = 0.2f;
constexpr size_t OFF_Y = 0, OFF_KP = (size_t)MT * DM, OFF_VP = OFF_KP + (size_t)MP * 512, OFF_RP = OFF_VP + (size_t)MP * 512,
                 OFF_KS = OFF_RP + (size_t)NBP * 4 * 128 * 128, OFF_VS = OFF_KS + (size_t)MS * 512, OFF_RS = OFF_VS + (size_t)MS * 512,
                 OUT_TOTAL = OFF_RS + (size_t)NBS * 4 * 128 * 128;
__device__ __forceinline__ int row_batch(int row) { return row < MP ? (row >> 13) : NBP + ((row - MP) >> 5); }
__device__ __forceinline__ int row_pos(int row) { return row < MP ? (row & 8191) : PAST + ((row - MP) & 31); }

namespace pg8 {
#define PG8_LAS __attribute__((address_space(3)))
typedef unsigned short bf16_t;
typedef short bf16x8 __attribute__((ext_vector_type(8)));
typedef float f32x4 __attribute__((ext_vector_type(4)));
typedef unsigned u32x4 __attribute__((ext_vector_type(4)));
constexpr int BM = 256, BK = 64, HALF = 128, HTB = HALF * BK * 2  , STAGE_BYTES = 8 * HTB, NXCD = 8, WGM = 8;

__host__ __device__ __forceinline__ int lds_byte(int r, int c) { const int st = (r >> 4) * 2 + (c >> 5), rr = r & 15, cc = c & 31, ob = rr * 64 + cc * 2; return st * 1024 + (ob ^ (((ob >> 9) & 1) << 5)); }
__host__ __device__ __forceinline__ void stage_rc(int b, int& R, int& C) { const int st = b / 1024, sb = b % 1024, swz = sb ^ (((sb >> 9) & 1) << 5); R = (st >> 1) * 16 + swz / 64; C = (st & 1) * 32 + (swz % 64) / 2; }
__host__ __device__ __forceinline__ int perm32(int rho) { const int n = rho >> 4, i = rho & 15; return 8 * (i >> 2) + 4 * n + (i & 3); }

struct Unit { int pm, pn; };
struct Gemm { const bf16_t* A; const bf16_t* Bt; int M, N, K; };

struct StaticOrder {
    int nM, nN, nwg, G, c;
    __host__ __device__ void init(int M, int N, int G_, int c_) { nM = M / BM; nN = N / BM; nwg = nM * nN; G = G_; c = c_; }
    __host__ __device__ bool next(int i, Unit& u) const {
        const long L = (long)i * G + c; if (L >= nwg) return false;
        int wgid = (int)L; { const int q = nwg / NXCD, r = nwg % NXCD, xcd = wgid % NXCD, off = wgid / NXCD; wgid = (xcd < r ? xcd * (q + 1) : r * (q + 1) + (xcd - r) * q) + off; }
        const int nig = WGM * nN, gid = wgid / nig, fm = gid * WGM, gsz = (nM - fm) < WGM ? (nM - fm) : WGM;
        u.pm = fm + ((wgid % nig) % gsz); u.pn = (wgid % nig) / gsz; return true;
    }
    __device__ __forceinline__ void a_ready(const Unit&) const {}
    __device__ __forceinline__ void done(const Unit&) const {}
};

__device__ __forceinline__ unsigned cvt_pk_bf16(float lo, float hi) { unsigned r; asm volatile("v_cvt_pk_bf16_f32 %0, %1, %2" : "=v"(r) : "v"(lo), "v"(hi)); return r; }
typedef float f32x2 __attribute__((ext_vector_type(2)));
typedef unsigned u32x2 __attribute__((ext_vector_type(2)));
__device__ __forceinline__ void st_bf16x4(bf16_t* p, f32x4 v) { u32x2 w; w.x = cvt_pk_bf16(v[0], v[1]); w.y = cvt_pk_bf16(v[2], v[3]); *(u32x2*)p = w; }
__device__ __forceinline__ void st_bf16x8(bf16_t* p, f32x4 a, f32x4 c) { u32x4 w; w.x = cvt_pk_bf16(a[0], a[1]); w.y = cvt_pk_bf16(a[2], a[3]); w.z = cvt_pk_bf16(c[0], c[1]); w.w = cvt_pk_bf16(c[2], c[3]); *(u32x4*)p = w; }
__device__ __forceinline__ float silu_f(float z) { return z * __builtin_amdgcn_rcpf(1.f + __expf(-z)); }

struct EpiIn {
    static constexpr bool PERM = false, AFTER_DRAIN = false;
    bf16_t* act; float* out; const float* gq; const float* gk; const float* rot;
    __device__ __forceinline__ void operator()(const f32x4 (&acc)[2][2][4][2], const Unit& u, int wr, int wc, int fr, int fq) const {
        const int type = u.pn >> 1, half = u.pn & 1;
        const int lc0 = half * 256 + wc * 64 + fq * 8;
        bf16_t* dst = act + (size_t)type * ((size_t)MT * 512);
        const int rowb = u.pm * BM + wr * 64 + fr;
        if (type <= 1) {
            const float* g = type == 0 ? gq : gk; const float osc = type == 0 ? QSCALE : 1.f;
            f32x4 gv[2][2];
#pragma unroll
            for (int bj = 0; bj < 2; ++bj)
#pragma unroll
                for (int n = 0; n < 2; ++n) gv[bj][n] = *(const f32x4*)(g + bj * 32 + fq * 8 + n * 4);
#pragma unroll
            for (int ai = 0; ai < 2; ++ai)
#pragma unroll
                for (int m = 0; m < 4; ++m) {
                    const int row = rowb + ai * HALF + m * 16;
                    float ss = 0.f;
#pragma unroll
                    for (int bj = 0; bj < 2; ++bj)
#pragma unroll
                        for (int n = 0; n < 2; ++n) { const f32x4 v = acc[ai][bj][m][n]; ss += (v[0] * v[0] + v[1] * v[1]) + (v[2] * v[2] + v[3] * v[3]); }
                    ss += __shfl_xor(ss, 16); ss += __shfl_xor(ss, 32);
                    const float rinv = rsqrtf(ss * (1.f / 64.f) + EPSN);
                    float* ko = (row < MP ? out + OFF_KP + (size_t)row * 512 : out + OFF_KS + (size_t)(row - MP) * 512) + lc0;
                    bf16_t* bo = dst + (size_t)row * 512 + lc0;
#pragma unroll
                    for (int bj = 0; bj < 2; ++bj) { const f32x4 y0 = acc[ai][bj][m][0] * rinv * gv[bj][0], y1 = acc[ai][bj][m][1] * rinv * gv[bj][1];
                        if (type == 1) { __builtin_nontemporal_store(y0, (f32x4*)(ko + bj * 32)); __builtin_nontemporal_store(y1, (f32x4*)(ko + bj * 32 + 4));     }
                        st_bf16x8(bo + bj * 32, y0 * osc, y1 * osc); }
                }
        } else if (type == 2) {
#pragma unroll
            for (int ai = 0; ai < 2; ++ai)
#pragma unroll
                for (int m = 0; m < 4; ++m) {
                    const int row = rowb + ai * HALF + m * 16;
                    float* vo = (row < MP ? out + OFF_VP + (size_t)row * 512 : out + OFF_VS + (size_t)(row - MP) * 512) + lc0;
                    bf16_t* bo = dst + (size_t)row * 512 + lc0;
#pragma unroll
                    for (int bj = 0; bj < 2; ++bj) { const f32x4 y0 = acc[ai][bj][m][0], y1 = acc[ai][bj][m][1];
                        __builtin_nontemporal_store(y0, (f32x4*)(vo + bj * 32)); __builtin_nontemporal_store(y1, (f32x4*)(vo + bj * 32 + 4)); st_bf16x8(bo + bj * 32, y0, y1); }
                }
        } else if (type == 3 || type == 4) {
            const int h = half * 2 + (wc >> 1);
            const float l2g = __log2f(1.f - exp2f(-5.f - (float)h));
#pragma unroll
            for (int ai = 0; ai < 2; ++ai) {
                f32x4 cs[4][2][2];
#pragma unroll
                for (int m = 0; m < 4; ++m) { const float* rp = rot + (size_t)row_pos(rowb + ai * HALF + m * 16) * 128;
#pragma unroll
                    for (int bj = 0; bj < 2; ++bj)
#pragma unroll
                        for (int n = 0; n < 2; ++n) cs[m][bj][n] = *(const f32x4*)(rp + ((lc0 + bj * 32 + n * 4) & 127)); }
#pragma unroll
                for (int m = 0; m < 4; ++m) {
                    const int row = rowb + ai * HALF + m * 16;
                    float ksc = 1.f;
                    if (type == 4) { const int e = row < MP ? 63 - (row & 63) : 31 - ((row - MP) & 31); ksc = 0.08838834764831845f * exp2f((float)e * l2g); }
                    bf16_t* bo = dst + (size_t)row * 512 + lc0;
#pragma unroll
                    for (int bj = 0; bj < 2; ++bj) { f32x4 y[2];
#pragma unroll
                        for (int n = 0; n < 2; ++n) { const f32x4 c4 = cs[m][bj][n]; const f32x4 v = acc[ai][bj][m][n];
                            y[n][0] = v[0] * c4[0] - v[1] * c4[1]; y[n][1] = v[0] * c4[1] + v[1] * c4[0]; y[n][2] = v[2] * c4[2] - v[3] * c4[3]; y[n][3] = v[2] * c4[3] + v[3] * c4[2]; }
                        st_bf16x8(bo + bj * 32, y[0] * ksc, y[1] * ksc); }
                }
            }
        } else {
#pragma unroll
            for (int ai = 0; ai < 2; ++ai)
#pragma unroll
                for (int m = 0; m < 4; ++m) {
                    const int row = rowb + ai * HALF + m * 16;
                    bf16_t* bo = dst + (size_t)row * 512 + lc0;
#pragma unroll
                    for (int bj = 0; bj < 2; ++bj) { f32x4 y[2];
#pragma unroll
                        for (int n = 0; n < 2; ++n) { y[n] = acc[ai][bj][m][n];
                            if (type == 6) { y[n][0] = silu_f(y[n][0]); y[n][1] = silu_f(y[n][1]); y[n][2] = silu_f(y[n][2]); y[n][3] = silu_f(y[n][3]); } }
                        st_bf16x8(bo + bj * 32, y[0], y[1]); }
                }
        }
    }
};

struct EpiOut {
    static constexpr bool PERM = false, AFTER_DRAIN = false;
    const float* xp; const float* xs; bf16_t* x1b; bf16_t* xn2; const float* mod; const float* gmod2; float* rowss; float psc;
    __device__ __forceinline__ void operator()(const f32x4 (&acc)[2][2][4][2], const Unit& u, int wr, int wc, int fr, int fq) const {
        const int col0 = u.pn * BM + wc * 32 + 8 * fq, rowb = u.pm * BM + wr * 64 + fr;
        const int b = (u.pm * BM) >> 13;
        const float* mb = mod + (size_t)b * (6 * DM) + 2 * DM + col0; const float* gm = gmod2 + (size_t)b * DM + col0;
        f32x4 gt[2][2], gg[2][2];
#pragma unroll
        for (int bj = 0; bj < 2; ++bj)
#pragma unroll
            for (int n = 0; n < 2; ++n) { gt[bj][n] = *(const f32x4*)(mb + bj * HALF + n * 4); gg[bj][n] = *(const f32x4*)(gm + bj * HALF + n * 4); }
#pragma unroll
        for (int am = 0; am < 4; ++am) { const int ai = am >> 1;
            f32x4 xv[2][2][2];
#pragma unroll
            for (int mm = 0; mm < 2; ++mm) { const float* xr = xp + (size_t)(rowb + ai * HALF + ((am & 1) * 2 + mm) * 16) * DM + col0;
#pragma unroll
                for (int bj = 0; bj < 2; ++bj)
#pragma unroll
                    for (int n = 0; n < 2; ++n) xv[mm][bj][n] = __builtin_nontemporal_load((const f32x4*)(xr + bj * HALF + n * 4)); }
#pragma unroll
            for (int mm = 0; mm < 2; ++mm) { const int m = (am & 1) * 2 + mm;
                const int row = rowb + ai * HALF + m * 16;
                bf16_t* yo = x1b + (size_t)row * DM + col0; bf16_t* no = xn2 + (size_t)row * DM + col0;
                float ss = 0.f;
#pragma unroll
                for (int bj = 0; bj < 2; ++bj) { f32x4 x1[2];
#pragma unroll
                    for (int n = 0; n < 2; ++n) { const int o = bj * HALF + n * 4;
                        x1[n] = xv[mm][bj][n] + gt[bj][n] * acc[ai][bj][m][n];
                        ss += (x1[n][0] * x1[n][0] + x1[n][1] * x1[n][1]) + (x1[n][2] * x1[n][2] + x1[n][3] * x1[n][3]); }
                    { u32x4 w_; w_.x = cvt_pk_bf16(x1[0][0], x1[0][1]); w_.y = cvt_pk_bf16(x1[0][2], x1[0][3]); w_.z = cvt_pk_bf16(x1[1][0], x1[1][1]); w_.w = cvt_pk_bf16(x1[1][2], x1[1][3]); __builtin_nontemporal_store(w_, (u32x4*)(yo + bj * HALF)); }
                    st_bf16x8(no + bj * HALF, x1[0] * gg[bj][0], x1[1] * gg[bj][1]); }
                ss += __shfl_xor(ss, 16); ss += __shfl_xor(ss, 32);
                if (fq == 0) atomicAdd(rowss + row, ss * psc);
            }
            asm volatile("" ::: "memory");
        }
    }
};

struct EpiFF1 {
    static constexpr bool PERM = false, AFTER_DRAIN = false;
    const float* rowss; const float* sbg; const float* sbu; bf16_t* H;
    __device__ __forceinline__ void operator()(const f32x4 (&acc)[2][2][4][2], const Unit& u, int wr, int wc, int fr, int fq) const {
        const int f0 = u.pn * 128 + wc * 32 + fq * 8, rowb = u.pm * BM + wr * 64 + fr;
        const int b = (u.pm * BM) >> 13;
        f32x4 bg[2], bu[2]; float rs[2][4];
#pragma unroll
        for (int n = 0; n < 2; ++n) { bg[n] = *(const f32x4*)(sbg + (size_t)b * DFF + f0 + n * 4); bu[n] = *(const f32x4*)(sbu + (size_t)b * DFF + f0 + n * 4); }
#pragma unroll
        for (int ai = 0; ai < 2; ++ai)
#pragma unroll
            for (int m = 0; m < 4; ++m) rs[ai][m] = rowss[rowb + ai * HALF + m * 16];
#pragma unroll
        for (int ai = 0; ai < 2; ++ai)
#pragma unroll
            for (int m = 0; m < 4; ++m) {
                const int row = rowb + ai * HALF + m * 16;
                const float rstd = rsqrtf(rs[ai][m] * (1.f / (float)DM) + EPSN);
                u32x2 w2[2];
#pragma unroll
                for (int n = 0; n < 2; ++n) {
                    const f32x4 hg = acc[ai][0][m][n] * rstd + bg[n];
                    const f32x4 hu = acc[ai][1][m][n] * rstd + bu[n];
                    w2[n].x = cvt_pk_bf16(silu_f(hg[0]) * hu[0], silu_f(hg[1]) * hu[1]); w2[n].y = cvt_pk_bf16(silu_f(hg[2]) * hu[2], silu_f(hg[3]) * hu[3]); }
                u32x4 w4; w4.x = w2[0].x; w4.y = w2[0].y; w4.z = w2[1].x; w4.w = w2[1].y;
                *(u32x4*)(H + (size_t)row * DFF + f0) = w4;
            }
    }
};

struct EpiFF2 {
    static constexpr bool PERM = false, AFTER_DRAIN = false;
    float* y; const bf16_t* x1b; const float* mod; float psc;
    __device__ __forceinline__ void operator()(const f32x4 (&acc)[2][2][4][2], const Unit& u, int wr, int wc, int fr, int fq) const {
        const int col0 = u.pn * BM + wc * 32 + 8 * fq, rowb = u.pm * BM + wr * 64 + fr;
        const float* mb = mod + (size_t)((u.pm * BM) >> 13) * (6 * DM) + 5 * DM + col0;
        f32x4 gt[2][2];
#pragma unroll
        for (int bj = 0; bj < 2; ++bj)
#pragma unroll
            for (int n = 0; n < 2; ++n) gt[bj][n] = *(const f32x4*)(mb + bj * HALF + n * 4) * psc;
#pragma unroll
        for (int ai = 0; ai < 2; ++ai) {
            u32x4 xv[4][2];
#pragma unroll
            for (int m = 0; m < 4; ++m) { const bf16_t* xr = x1b + (size_t)(rowb + ai * HALF + m * 16) * DM + col0;
#pragma unroll
                for (int bj = 0; bj < 2; ++bj) xv[m][bj] = __builtin_nontemporal_load((const u32x4*)(xr + bj * HALF)); }
#pragma unroll
            for (int m = 0; m < 4; ++m) { float* yo = y + (size_t)(rowb + ai * HALF + m * 16) * DM + col0;
#pragma unroll
                for (int bj = 0; bj < 2; ++bj) { const u32x4 w = xv[m][bj];
                    f32x4 x0, x1;
                    x0[0] = __uint_as_float(w.x << 16); x0[1] = __uint_as_float(w.x & 0xffff0000u); x0[2] = __uint_as_float(w.y << 16); x0[3] = __uint_as_float(w.y & 0xffff0000u);
                    x1[0] = __uint_as_float(w.z << 16); x1[1] = __uint_as_float(w.z & 0xffff0000u); x1[2] = __uint_as_float(w.w << 16); x1[3] = __uint_as_float(w.w & 0xffff0000u);
                    __builtin_nontemporal_store(x0 + gt[bj][0] * acc[ai][bj][m][0], (f32x4*)(yo + bj * HALF));
                    __builtin_nontemporal_store(x1 + gt[bj][1] * acc[ai][bj][m][1], (f32x4*)(yo + bj * HALF + 4)); } }
            asm volatile("" ::: "memory");
        }
    }
};

struct EpiNull {
    static constexpr bool PERM = false, AFTER_DRAIN = false;
    __device__ __forceinline__ void operator()(const f32x4 (&acc)[2][2][4][2], const Unit& u, int wr, int wc, int fr, int fq) const {
#pragma unroll
        for (int ai = 0; ai < 2; ++ai)
#pragma unroll
            for (int bj = 0; bj < 2; ++bj)
#pragma unroll
                for (int m = 0; m < 4; ++m)
#pragma unroll
                    for (int n = 0; n < 2; ++n) asm volatile("" :: "v"(acc[ai][bj][m][n]));
    }
};
template <class Epi, class Sched, bool ALIGN_EPI = false, bool SP2 = false>
__device__ __forceinline__ void gemm_phase(PG8_LAS unsigned char* lds, const Gemm g, const Sched& S, const Epi& E) {
    int tid = threadIdx.x; asm volatile("" : "+v"(tid));
    const int wid = __builtin_amdgcn_readfirstlane(tid >> 6), lane = tid & 63, wr = wid >> 2, wc = wid & 3, fr = lane & 15, fq = lane >> 4;
    const int K = g.K, nt = K / BK;
    unsigned voffA[2], voffB[2];
#pragma unroll
    for (int i = 0; i < 2; ++i) { int R, C; stage_rc(tid * 16 + i * 8192, R, C); const int Rb = Epi::PERM ? ((R & ~31) + perm32(R & 31)) : R;
        voffA[i] = (unsigned)(R * K + C) * 2u; voffB[i] = (unsigned)(Rb * K + C) * 2u; }
    const size_t kstep = (size_t)(BK * 2);
    const size_t hstep = (size_t)HALF * K * 2;
    const size_t tstep = 2 * hstep;
    const unsigned ldsw = (unsigned)wid * 1024u;
    const int aoff = lds_byte(wr * 64 + fr, fq * 8), boff = lds_byte(wc * 32 + fr, fq * 8);
#define PG8_SA(b, h) (((b) * 2 + (h)) * HTB)
#define PG8_SB(b, h) ((4 + (b) * 2 + (h)) * HTB)
#define PG8_STAGE(bufoff, gbase, voff) do { _Pragma("unroll") for (int _i = 0; _i < 2; ++_i) \
        __builtin_amdgcn_global_load_lds((const unsigned*)((const char*)(gbase) + (voff)[_i]), (PG8_LAS unsigned*)(lds + (bufoff) + ldsw + _i * 8192), 16, 0, 0); } while (0)
#define PG8_LDA(dst, b, h) do { _Pragma("unroll") for (int m = 0; m < 4; ++m) _Pragma("unroll") for (int k = 0; k < 2; ++k) dst[m][k] = *(const PG8_LAS bf16x8*)(lds + PG8_SA(b, h) + aoff + m * 2048 + k * 1024); } while (0)
#define PG8_LDB(dst, b, h) do { _Pragma("unroll") for (int n = 0; n < 2; ++n) _Pragma("unroll") for (int k = 0; k < 2; ++k) dst[n][k] = *(const PG8_LAS bf16x8*)(lds + PG8_SB(b, h) + boff + n * 2048 + k * 1024); } while (0)
#define PG8_MMA(ai, bj, At, Bt) do { __builtin_amdgcn_s_setprio(1); _Pragma("unroll") for (int m = 0; m < 4; ++m) _Pragma("unroll") for (int n = 0; n < 2; ++n) _Pragma("unroll") for (int k = 0; k < 2; ++k) \
        acc[ai][bj][m][n] = __builtin_amdgcn_mfma_f32_16x16x32_bf16(Bt[n][k], At[m][k], acc[ai][bj][m][n], 0, 0, 0); __builtin_amdgcn_s_setprio(0); } while (0)
#define PG8_WAIT_V(n) asm volatile("s_waitcnt vmcnt(" #n ")" ::: "memory")
#define PG8_WAIT_L(n) asm volatile("s_waitcnt lgkmcnt(" #n ")" ::: "memory")
#define PG8_BAR __builtin_amdgcn_s_barrier()
#define PG8_SCHED __builtin_amdgcn_sched_barrier(0)
    Unit cur, nxt; int ui = 0;
    if (!S.next(0, cur)) return;
    f32x4 acc[2][2][4][2];
#pragma unroll
    for (int a = 0; a < 2; ++a)
#pragma unroll
        for (int b = 0; b < 2; ++b)
#pragma unroll
            for (int m = 0; m < 4; ++m)
#pragma unroll
                for (int n = 0; n < 2; ++n) acc[a][b][m][n] = (f32x4){0.f, 0.f, 0.f, 0.f};
    bf16x8 At[4][2], B0[2][2], B1[2][2];
    const char* cA = (const char*)g.A + (size_t)cur.pm * tstep; const char* cB = (const char*)g.Bt + (size_t)cur.pn * tstep;
    S.a_ready(cur);
    if constexpr (SP2) {
        PG8_STAGE(PG8_SB(0, 0), cB, voffB); PG8_STAGE(PG8_SB(0, 1), cB + hstep, voffB); PG8_STAGE(PG8_SA(0, 0), cA, voffA); PG8_STAGE(PG8_SA(0, 1), cA + hstep, voffA);
        if (wr == 1) PG8_BAR;
        PG8_WAIT_V(2); PG8_BAR;
        PG8_STAGE(PG8_SB(1, 0), cB + kstep, voffB); PG8_STAGE(PG8_SA(1, 0), cA + kstep, voffA); PG8_STAGE(PG8_SB(1, 1), cB + hstep + kstep, voffB);
        PG8_WAIT_V(6); PG8_BAR;
    } else {
        PG8_STAGE(PG8_SB(0, 0), cB, voffB); PG8_STAGE(PG8_SA(0, 0), cA, voffA); PG8_STAGE(PG8_SB(0, 1), cB + hstep, voffB); PG8_STAGE(PG8_SA(0, 1), cA + hstep, voffA);
        if (wr == 1) PG8_BAR;
        PG8_WAIT_V(4); PG8_BAR;
        PG8_STAGE(PG8_SB(1, 0), cB + kstep, voffB); PG8_STAGE(PG8_SA(1, 0), cA + kstep, voffA); PG8_STAGE(PG8_SB(1, 1), cB + hstep + kstep, voffB);
        PG8_WAIT_V(6); PG8_BAR;
    }
    for (;;) {
        const bool has_next = S.next(ui + 1, nxt);
        const char* nA = has_next ? (const char*)g.A + (size_t)nxt.pm * tstep : cA; const char* nB = has_next ? (const char*)g.Bt + (size_t)nxt.pn * tstep : cB;
        for (int t = 0; t < nt; t += 2) {
            const bool last = (t == nt - 2);
            const char* a1 = cA + (size_t)(t + 1) * kstep;
            const char* a2 = last ? nA : cA + (size_t)(t + 2) * kstep; const char* b2 = last ? nB : cB + (size_t)(t + 2) * kstep;
            const char* a3 = a2 + kstep; const char* b3 = b2 + kstep;
            if (last && has_next) S.a_ready(nxt);
            if constexpr (SP2) {
            PG8_LDB(B0, 0, 0); PG8_LDB(B1, 0, 1); PG8_SCHED; PG8_LDA(At, 0, 0); PG8_STAGE(PG8_SA(1, 1), a1 + hstep, voffA);
            PG8_WAIT_V(8); PG8_WAIT_L(0); PG8_BAR; PG8_MMA(0, 0, At, B0); PG8_MMA(0, 1, At, B1); PG8_BAR; PG8_SCHED;
            PG8_LDA(At, 0, 1); PG8_STAGE(PG8_SB(0, 0), b2, voffB); PG8_STAGE(PG8_SB(0, 1), b2 + hstep, voffB); PG8_STAGE(PG8_SA(0, 0), a2, voffA);
            PG8_WAIT_V(8); PG8_WAIT_L(0); PG8_BAR; PG8_MMA(1, 0, At, B0); PG8_MMA(1, 1, At, B1); PG8_BAR; PG8_SCHED;
            PG8_LDB(B0, 1, 0); PG8_LDB(B1, 1, 1); PG8_SCHED; PG8_LDA(At, 1, 0); PG8_STAGE(PG8_SA(0, 1), a2 + hstep, voffA);
            PG8_WAIT_V(8); PG8_WAIT_L(0); PG8_BAR; PG8_MMA(0, 0, At, B0); PG8_MMA(0, 1, At, B1); PG8_BAR; PG8_SCHED;
            PG8_LDA(At, 1, 1); PG8_STAGE(PG8_SB(1, 0), b3, voffB); PG8_STAGE(PG8_SB(1, 1), b3 + hstep, voffB); PG8_STAGE(PG8_SA(1, 0), a3, voffA);
            PG8_WAIT_V(8); PG8_WAIT_L(0); PG8_BAR; PG8_MMA(1, 0, At, B0); PG8_MMA(1, 1, At, B1); PG8_BAR; PG8_SCHED;
            } else {
            PG8_LDB(B0, 0, 0); PG8_SCHED; PG8_LDA(At, 0, 0); PG8_STAGE(PG8_SA(1, 1), a1 + hstep, voffA);
            PG8_WAIT_L(8); PG8_BAR; PG8_WAIT_L(0); PG8_MMA(0, 0, At, B0); PG8_BAR; PG8_SCHED;
            PG8_LDB(B1, 0, 1); PG8_STAGE(PG8_SB(0, 0), b2, voffB);
            PG8_BAR; PG8_WAIT_L(0); PG8_MMA(0, 1, At, B1); PG8_BAR;
            PG8_LDA(At, 0, 1); PG8_STAGE(PG8_SA(0, 0), a2, voffA);
            PG8_BAR; PG8_WAIT_L(0); PG8_MMA(1, 0, At, B0); PG8_BAR; PG8_SCHED;
            PG8_STAGE(PG8_SB(0, 1), b2 + hstep, voffB);
            PG8_WAIT_V(6); PG8_BAR; PG8_MMA(1, 1, At, B1); PG8_BAR;
            PG8_LDB(B0, 1, 0); PG8_SCHED; PG8_LDA(At, 1, 0); PG8_STAGE(PG8_SA(0, 1), a2 + hstep, voffA);
            PG8_WAIT_L(8); PG8_BAR; PG8_WAIT_L(0); PG8_MMA(0, 0, At, B0); PG8_BAR; PG8_SCHED;
            PG8_LDB(B1, 1, 1); PG8_STAGE(PG8_SB(1, 0), b3, voffB);
            PG8_BAR; PG8_WAIT_L(0); PG8_MMA(0, 1, At, B1); PG8_BAR;
            PG8_LDA(At, 1, 1); PG8_STAGE(PG8_SA(1, 0), a3, voffA);
            PG8_BAR; PG8_WAIT_L(0); PG8_MMA(1, 0, At, B0); PG8_BAR; PG8_SCHED;
            PG8_STAGE(PG8_SB(1, 1), b3 + hstep, voffB);
            PG8_WAIT_V(6); PG8_BAR; PG8_MMA(1, 1, At, B1); PG8_BAR;
            }
        }
        if constexpr (ALIGN_EPI) { if (wr == 0) PG8_BAR; }
        if constexpr (!Epi::AFTER_DRAIN) { E(acc, cur, wr, wc, fr, fq); S.done(cur); }
        if (!has_next) break;
#pragma unroll
        for (int a = 0; a < 2; ++a)
#pragma unroll
            for (int b = 0; b < 2; ++b)
#pragma unroll
                for (int m = 0; m < 4; ++m)
#pragma unroll
                    for (int n = 0; n < 2; ++n) acc[a][b][m][n] = (f32x4){0.f, 0.f, 0.f, 0.f};
        cur = nxt; cA = nA; cB = nB; ++ui;
        if constexpr (ALIGN_EPI) { if (wr == 1) PG8_BAR; }
    }
    PG8_WAIT_V(0);
    if constexpr (!ALIGN_EPI) { if (wr == 0) PG8_BAR; }
    PG8_BAR;
    if constexpr (Epi::AFTER_DRAIN) { E.fused(acc, cur, wr, wc, fr, fq, lds, wid, lane); S.done(cur); }
#undef PG8_SA
#undef PG8_SB
#undef PG8_STAGE
#undef PG8_LDA
#undef PG8_LDB
#undef PG8_MMA
#undef PG8_WAIT_V
#undef PG8_WAIT_L
#undef PG8_BAR
#undef PG8_SCHED
}
}
#define GAS __attribute__((address_space(1)))
#define LAS __attribute__((address_space(3)))
typedef unsigned short bf16;
typedef unsigned v4u __attribute__((ext_vector_type(4)));
typedef float f32x4 __attribute__((ext_vector_type(4)));
typedef short bf16x8 __attribute__((ext_vector_type(8)));
typedef GAS unsigned gu32;
typedef GAS unsigned long long gu64;
#define RLX_AGENT __ATOMIC_RELAXED, __HIP_MEMORY_SCOPE_AGENT
#define LDS_WAIT() asm volatile("s_waitcnt lgkmcnt(0)" ::: "memory")
#define VM_WAIT() asm volatile("s_waitcnt vmcnt(0)" ::: "memory")
__device__ __forceinline__ unsigned long long rt() { return __builtin_amdgcn_s_memrealtime(); }
__device__ __forceinline__ unsigned f2bf(float f) { unsigned u = __builtin_bit_cast(unsigned, f); return (u + 0x7fffu + ((u >> 16) & 1u)) >> 16; }
__device__ __forceinline__ unsigned pk2(float lo, float hi) { return f2bf(lo) | (f2bf(hi) << 16); }

#define XB_TMO      128
#define XB_XCNT(j)  (256  + 64 * (j))
#define XB_XSUB(j)  (1280 + 64 * (j))
#define XB_XGEN(j)  (2304 + 64 * (j))
#define XB_TOP      3328
#define XB_TOPGEN   3392
#define XCD_BAR_WORDS 3456
#define XB_SPIN_CAP (1u << 18)

__device__ __forceinline__ unsigned xb_ld(unsigned* p)              { return __hip_atomic_load(p, __ATOMIC_RELAXED, __HIP_MEMORY_SCOPE_AGENT); }
__device__ __forceinline__ unsigned xb_add(unsigned* p, unsigned v) { return __hip_atomic_fetch_add(p, v, __ATOMIC_RELAXED, __HIP_MEMORY_SCOPE_AGENT); }
__device__ __forceinline__ unsigned xb_xcc_id() { return (unsigned)__builtin_amdgcn_s_getreg((3 << 11) | 20) & 0xFu; }
#define XB_SPIN(cond, bar) do { unsigned _sp = 0; while (cond) { __builtin_amdgcn_s_sleep(1); \
    if ((++_sp & 255u) == 0u) { if (xb_ld(&(bar)[XB_TMO])) break; if (_sp > XB_SPIN_CAP) { atomicAdd(&(bar)[XB_TMO], 1u); break; } } } } while (0)

struct XcdBarrier {
    unsigned* bar; unsigned x;
    volatile LAS unsigned* st;
};

__device__ __forceinline__ XcdBarrier xcd_barrier_post(unsigned* bar, volatile LAS unsigned* st) {
    XcdBarrier b; b.bar = bar; b.x = xb_xcc_id(); b.st = st;
    if (threadIdx.x == 0) (void)xb_add(&bar[XB_XCNT(b.x)], 1u);
    return b;
}
__device__ __forceinline__ void xcd_barrier_complete(unsigned* bar, unsigned x, unsigned& nloc, unsigned& nx) {
    const unsigned G = gridDim.x * gridDim.y * gridDim.z;
    unsigned sum, cnt, mine, sp = 0u;
    for (;;) {
        sum = 0u; cnt = 0u; mine = 0u;
#pragma unroll
        for (unsigned j = 0; j < 16; ++j) { const unsigned c = xb_ld(&bar[XB_XCNT(j)]); sum += c; cnt += (c > 0u) ? 1u : 0u; mine = (j == x) ? c : mine; }
        if (sum == G) break;
        __builtin_amdgcn_s_sleep(1);
        if ((++sp & 255u) == 0u) { if (xb_ld(&bar[XB_TMO])) break; if (sp > XB_SPIN_CAP) { atomicAdd(&bar[XB_TMO], 1u); break; } }
    }
    nloc = mine > 0u ? mine : 1u; nx = cnt > 0u ? cnt : 1u;
}

__device__ __forceinline__ void xcd_barrier(const XcdBarrier& b) {
    asm volatile("s_waitcnt vmcnt(0)" ::: "memory");
    __syncthreads();
    if (threadIdx.x == 0) {
        unsigned* bar = b.bar;
        __builtin_amdgcn_s_waitcnt(0);
        unsigned nloc = b.st[0], nx = b.st[1];
        if (nloc == 0u) { xcd_barrier_complete(bar, b.x, nloc, nx); b.st[0] = nloc; b.st[1] = nx; }
        const unsigned old = xb_add(&bar[XB_XSUB(b.x)], 1u);
        const unsigned gen = old / nloc;
        if (old + 1u == (gen + 1u) * nloc) {
            __builtin_amdgcn_fence(__ATOMIC_RELEASE, "agent");
            asm volatile("s_waitcnt vmcnt(0)" ::: "memory");
            const unsigned og = xb_add(&bar[XB_TOP], 1u);
            const unsigned tg = og / nx;
            if (og + 1u == (tg + 1u) * nx) xb_add(&bar[XB_TOPGEN], 1u);
            else XB_SPIN(xb_ld(&bar[XB_TOPGEN]) == tg, bar);
            __builtin_amdgcn_fence(__ATOMIC_ACQUIRE, "agent");
            xb_add(&bar[XB_XGEN(b.x)], 1u);
            asm volatile("s_waitcnt vmcnt(0)" ::: "memory");
        } else {
            XB_SPIN(xb_ld(&bar[XB_XGEN(b.x)]) == gen, bar);
            __builtin_amdgcn_fence(__ATOMIC_ACQUIRE, "agent");
            asm volatile("s_waitcnt vmcnt(0)" ::: "memory");
        }
    }
    __syncthreads();
}

constexpr size_t MiB = 1u << 20;
constexpr size_t WS_CTL = 0, CTL_ZERO_BYTES = 2 * MiB;
constexpr size_t WS_ROWSS = 256 * 1024, WS_MOD = 512 * 1024, WS_SB2 = 1 * MiB, WS_GMOD2 = 1536 * 1024;
constexpr size_t WS_ROT = 2 * MiB, WS_WIN = 6 * MiB, WS_WOUT = 13 * MiB, WS_WGU = 15 * MiB, WS_WDN = 26 * MiB;
constexpr size_t WS_XN = 32 * MiB, WS_OB = 97 * MiB, WS_ACT = 162 * MiB, WS_H = WS_ACT, WS_E = 390 * MiB, WS_X1B = 398 * MiB, WS_END = 463 * MiB;
constexpr size_t ACT_STRIDE = (size_t)MT * 512;
static_assert(WS_ROWSS + (size_t)MT * 4 <= WS_MOD && WS_MOD + (size_t)NBT * 6 * DM * 4 <= WS_SB2 && WS_SB2 + (size_t)2 * NBT * DFF * 4 <= WS_GMOD2 && WS_GMOD2 + (size_t)NBT * DM * 4 <= CTL_ZERO_BYTES, "ctl map");
static_assert(WS_WIN + (size_t)DIN * DM * 2 <= WS_WOUT && WS_WGU + (size_t)NGU * DM * 2 <= WS_WDN && WS_WDN + (size_t)DM * DFF * 2 <= WS_XN, "weights map");
static_assert(WS_XN + (size_t)MT * DM * 2 <= WS_OB && WS_OB + (size_t)MT * DM * 2 <= WS_ACT && WS_ACT + 7 * ACT_STRIDE * 2 <= WS_E && WS_X1B + (size_t)MP * DM * 2 <= WS_END && WS_H + (size_t)MT * DFF * 2 <= WS_END, "act map");
constexpr int CW_BAR = 4096;
constexpr int CW_QUEUE = 16384;
constexpr int CW_CNTA = 20480;
constexpr int RING_BYTES = 131072, LDSCTL_OFF = RING_BYTES, MISC_OFF = LDSCTL_OFF + 320;
constexpr int TAB_OFF = 132096, CB_OFF = TAB_OFF + 4096, WSC_OFF = CB_OFF + 64, QSLOT_OFF = WSC_OFF + 8 * 256, LDS_BYTES = 147456;
static_assert(QSLOT_OFF + 64 <= LDS_BYTES && MISC_OFF + 128 <= TAB_OFF, "LDS map");
constexpr int NWAVES = 8;
constexpr int WOUT_MODE = 4;

struct Args { const float* in[24]; float* out; unsigned char* ws; };
struct Frame {
    LAS unsigned char* lds; volatile LAS unsigned* MISC; gu32* ctl; int tid, lane, wave, G;
    const Args* A; float* out; unsigned char* ws;
};

__device__ __forceinline__ int dst_row(int mode, int n) {
    if (mode == 0) return n;
    if (mode == 1) { const int l = n & 255;
        return (n & ~255) + 128 * ((l >> 5) & 1) + 32 * (l >> 6) + 16 * ((l >> 2) & 1) + 4 * ((l >> 3) & 3) + (l & 3); }
    if (mode == 4) { const int l = n & 127;
        return (n & ~127) + 32 * (l >> 5) + 16 * ((l >> 2) & 1) + 4 * ((l >> 3) & 3) + (l & 3); }
    const int fl = n & 127;
    return (n >> 7) * 256 + 128 * (mode - 2) + 32 * (fl >> 5) + 16 * ((fl >> 2) & 1) + 4 * ((fl >> 3) & 3) + (fl & 3);
}
__device__ __forceinline__ void p0_transpose_item(const float* W, int K, int N, bf16* WT, int mode, LAS float* scr, int item, int lane) {
    const int nblk = N / 32, kb = item / nblk, nb = item % nblk, k0 = 64 * kb, n0 = 32 * nb;
#pragma unroll
    for (int i = 0; i < 32; ++i) { const int kk = 2 * i + (lane >> 5); scr[kk * 33 + (lane & 31)] = __builtin_nontemporal_load(W + (size_t)(k0 + kk) * N + n0 + (lane & 31)); }
    LDS_WAIT(); asm volatile("" ::: "memory");
    const int c = lane & 7;
#pragma unroll
    for (int j = 0; j < 4; ++j) { const int n = (lane >> 3) + 8 * j; const LAS float* s = scr + (8 * c) * 33 + n;
        v4u o; o.x = pk2(s[0 * 33], s[1 * 33]); o.y = pk2(s[2 * 33], s[3 * 33]); o.z = pk2(s[4 * 33], s[5 * 33]); o.w = pk2(s[6 * 33], s[7 * 33]);
        *(GAS v4u*)(WT + (size_t)dst_row(mode, n0 + n) * K + k0 + 8 * c) = o; }
    LDS_WAIT(); asm volatile("" ::: "memory");
}
__device__ __forceinline__ float wave_sum(float v) {
#pragma unroll
    for (int o = 1; o < 64; o <<= 1) v += __shfl_xor(v, o);
    return v;
}
__device__ __forceinline__ void gemv20_item(Frame& F, const float* W, int N, int e, bool valid, int kc, float* outp, int ostride, const float* bias) {
    LAS const float* sc = (LAS const float*)F.lds;
    float acc[NBT];
#pragma unroll
    for (int b = 0; b < NBT; ++b) acc[b] = 0.f;
    if (valid) {
#pragma unroll 16
        for (int d = 0; d < 64; ++d) { const float w = __builtin_nontemporal_load(W + (size_t)(kc * 64 + d) * N + e);
#pragma unroll
            for (int b = 0; b < NBT; ++b) acc[b] += sc[b * 64 + d] * w; }
        const float bb = (bias && kc == 0) ? bias[e] : 0.f;
#pragma unroll
        for (int b = 0; b < NBT; ++b) atomicAdd(outp + (size_t)b * ostride + e, acc[b] + bb);
    }
}
__device__ __forceinline__ void p0a(Frame& F, bool gemv = true) {
    const float* cp = F.A->in[2]; const float* cs = F.A->in[3]; const float* w_ada = F.A->in[7]; const float* b_ada = F.A->in[8];
    float* mod = (float*)(F.ws + WS_MOD);
    if (gemv) for (int it = blockIdx.x; it < 256; it += F.G) {
        const int cg = it & 15, kc = it >> 4;
        LAS float* sc = (LAS float*)F.lds;
        for (int idx = F.tid; idx < NBT * 64; idx += 512) { const int b = idx >> 6, d = idx & 63;
            const float c = b < NBP ? cp[b * DM + kc * 64 + d] : cs[(b - NBP) * DM + kc * 64 + d]; sc[idx] = c / (1.f + __expf(-c)); }
        __syncthreads();
        gemv20_item(F, w_ada, 6 * DM, cg * 384 + (F.tid < 384 ? F.tid : 0), F.tid < 384, kc, mod, 6 * DM, b_ada);
        __syncthreads();
    }
    LAS float* scr = (LAS float*)(F.lds + F.wave * 16384);
    const int gw = blockIdx.x * NWAVES + F.wave, NGW = F.G * NWAVES;
    constexpr int I_IN = (DM / 64) * (DIN / 32), I_O = (DM / 64) * (DM / 32), I_G = (DM / 64) * (DFF / 32), I_D = (DFF / 64) * (DM / 32);
    constexpr int NITEMS = I_IN + I_O + 2 * I_G + I_D;
    bf16* win = (bf16*)(F.ws + WS_WIN); bf16* wout = (bf16*)(F.ws + WS_WOUT); bf16* wgu = (bf16*)(F.ws + WS_WGU); bf16* wdn = (bf16*)(F.ws + WS_WDN);
    for (int i = gw; i < NITEMS; i += NGW) {
        int r = i;
        if (r < I_IN) { p0_transpose_item(F.A->in[11], DM, DIN, win, 1, scr, r, F.lane); continue; } r -= I_IN;
        if (r < I_O) { p0_transpose_item(F.A->in[19], DM, DM, wout, WOUT_MODE, scr, r, F.lane); continue; } r -= I_O;
        if (r < I_G) { p0_transpose_item(F.A->in[20], DM, DFF, wgu, 2, scr, r, F.lane); continue; } r -= I_G;
        if (r < I_G) { p0_transpose_item(F.A->in[21], DM, DFF, wgu, 3, scr, r, F.lane); continue; } r -= I_G;
        p0_transpose_item(F.A->in[22], DFF, DM, wdn, WOUT_MODE, scr, r, F.lane);
    }
    float* rot = (float*)(F.ws + WS_ROT);
    for (int idx = blockIdx.x * 512 + F.tid; idx < 8192 * 64; idx += F.G * 512) {
        const int pos = idx >> 6, ip = idx & 63;
        const float inv = 1.0f / exp2f(((float)ip * (1.0f / 63.0f)) * 13.287712379549449f);
        const float ang = (float)pos * inv;
        const double rev = (double)ang * 0.15915494309189535; const float fr = (float)(rev - __builtin_rint(rev));
        float2 o; o.x = __builtin_amdgcn_cosf(fr); o.y = __builtin_amdgcn_sinf(fr);
        ((float2*)rot)[idx] = o;
    }
}
__device__ __forceinline__ void p0b(Frame& F, bool gemv = true) {
    const float* mod = (const float*)(F.ws + WS_MOD);
    const int it = blockIdx.x;
    if (it < 192 && gemv) {
        const int mat = it & 1, rest = it >> 1, cg = rest % 6, kc = rest / 6;
        LAS float* sc = (LAS float*)F.lds;
        for (int idx = F.tid; idx < NBT * 64; idx += 512) { const int b = idx >> 6, d = idx & 63; sc[idx] = mod[(size_t)b * 6 * DM + 3 * DM + kc * 64 + d]; }
        __syncthreads();
        const int f = cg * 512 + F.tid;
        gemv20_item(F, (mat ? F.A->in[21] : F.A->in[20]), DFF, f, f < DFF, kc, (float*)(F.ws + WS_SB2) + (size_t)mat * NBT * DFF, DFF, nullptr);
        __syncthreads();
    }
    { float* gm2 = (float*)(F.ws + WS_GMOD2);
      for (int idx = blockIdx.x * 512 + F.tid; idx < NBT * DM; idx += F.G * 512) { const int b = idx >> 10, c = idx & 1023; gm2[idx] = F.A->in[10][c] * (1.f + mod[(size_t)b * 6 * DM + 4 * DM + c]); } }
    const float* g1 = F.A->in[9]; bf16* xn = (bf16*)(F.ws + WS_XN);
    const int gw = blockIdx.x * NWAVES + F.wave, NGW = F.G * NWAVES;
    for (int m0 = gw; m0 < MT; m0 += 4 * NGW) {
        f32x4 v[4][4];
#pragma unroll
        for (int q = 0; q < 4; ++q) { const int m = m0 + q * NGW; if (m < MT) {
            const GAS f32x4* xr = (const GAS f32x4*)(m < MP ? F.A->in[0] + (size_t)m * DM : F.A->in[1] + (size_t)(m - MP) * DM) + F.lane;
#pragma unroll
            for (int j = 0; j < 4; ++j) v[q][j] = __builtin_nontemporal_load((const f32x4*)(xr + 64 * j)); } }
#pragma unroll
        for (int q = 0; q < 4; ++q) { const int m = m0 + q * NGW; if (m < MT) {
            const float* mb = mod + (size_t)row_batch(m) * 6 * DM; float s = 0.f;
#pragma unroll
            for (int j = 0; j < 4; ++j) s += (v[q][j].x * v[q][j].x + v[q][j].y * v[q][j].y) + (v[q][j].z * v[q][j].z + v[q][j].w * v[q][j].w);
            const float rstd = rsqrtf(wave_sum(s) * (1.f / DM) + EPSN);
            GAS unsigned long long* o8 = (GAS unsigned long long*)(xn + (size_t)m * DM) + F.lane;
#pragma unroll
            for (int j = 0; j < 4; ++j) { const int c = 4 * F.lane + 256 * j;
                const f32x4 g = *(const f32x4*)(g1 + c), sc1 = *(const f32x4*)(mb + DM + c), sh1 = *(const f32x4*)(mb + c);
                const f32x4 h = v[q][j] * rstd * g * (sc1 + 1.f) + sh1;
                o8[64 * j] = (unsigned long long)pk2(h.x, h.y) | ((unsigned long long)pk2(h.z, h.w) << 32); } } }
    }
}


namespace p2 {
typedef short bf16x8 __attribute__((ext_vector_type(8)));
typedef short s16x4 __attribute__((ext_vector_type(4)));
typedef float f32x16 __attribute__((ext_vector_type(16)));
typedef float f32x4 __attribute__((ext_vector_type(4)));
typedef unsigned u32x4 __attribute__((ext_vector_type(4)));
typedef unsigned u32x2 __attribute__((ext_vector_type(2)));
typedef float f32x2_t __attribute__((ext_vector_type(2))); typedef __bf16 bf16x2_t __attribute__((ext_vector_type(2)));
__device__ __forceinline__ unsigned cvtpk(float lo, float hi) { f32x2_t v = {lo, hi}; bf16x2_t b = __builtin_convertvector(v, bf16x2_t); return __builtin_bit_cast(unsigned, b); }
__device__ __forceinline__ int crow(int r, int hi) { return (r & 3) + 8 * (r >> 2) + 4 * hi; }
__device__ __forceinline__ s16x4 vtr(LAS const unsigned char* p) { return __builtin_bit_cast(s16x4, __builtin_amdgcn_ds_read_tr16_b64_v4i16((LAS s16x4*)p)); }
__device__ __forceinline__ bf16x8 cat8(s16x4 l, s16x4 h) { return (bf16x8){l[0], l[1], l[2], l[3], h[0], h[1], h[2], h[3]}; }
__device__ __forceinline__ bf16x8 pack8(f32x4 a, f32x4 b) { u32x4 w = {cvtpk(a[0], a[1]), cvtpk(a[2], a[3]), cvtpk(b[0], b[1]), cvtpk(b[2], b[3])}; return __builtin_bit_cast(bf16x8, w); }
__device__ __forceinline__ int v_st(int k, int c) { const int kk = (k & ~0xC) | ((k & 4) << 1) | ((k & 8) >> 1); return ((kk >> 3) * 4 + (c >> 5)) * 512 + ((kk & 7) * 32 + (c & 31)) * 2; }
__device__ __forceinline__ int v_rd_base(int lane) { return ((lane & 3) << 3) | (((lane >> 2) & 3) << 6) | (((lane >> 4) & 1) << 5) | (((lane >> 5) & 1) << 8); }
#define PK4(P, BASE, OUT) do { unsigned a0_ = cvtpk(P[BASE + 0], P[BASE + 1]), a1_ = cvtpk(P[BASE + 2], P[BASE + 3]);   \
    unsigned b0_ = cvtpk(P[BASE + 4], P[BASE + 5]), b1_ = cvtpk(P[BASE + 6], P[BASE + 7]);                              \
    auto r0_ = __builtin_amdgcn_permlane32_swap(a0_, b0_, false, false); auto r1_ = __builtin_amdgcn_permlane32_swap(a1_, b1_, false, false); \
    u32x4 w_ = {r0_[0], r1_[0], r0_[1], r1_[1]}; OUT = __builtin_bit_cast(bf16x8, w_); } while (0)

__device__ __forceinline__ int t5_bucket(int rel) {
    const int n = rel < 0 ? -rel : rel; const int ret = rel > 0 ? 16 : 0;
    const int large = n < 12 ? 8 : n < 16 ? 9 : n < 23 ? 10 : n < 32 ? 11 : n < 46 ? 12 : n < 64 ? 13 : n < 91 ? 14 : 15;
    return ret + (n < 8 ? n : large);
}
__device__ __forceinline__ void p2_setup(Frame& F) {
    const float* gq = F.A->in[12]; const float* gk = F.A->in[13]; const float* rb = F.A->in[23];
    float gqm = 0.f, gkm = 0.f, s1 = 0.f, s2 = 0.f;
    for (int d = 0; d < 64; ++d) { gqm = fmaxf(gqm, fabsf(gq[d])); gkm = fmaxf(gkm, fabsf(gk[d])); s1 += F.A->in[14][d] * F.A->in[15][d]; s2 += F.A->in[16][d] * F.A->in[17][d]; }
    LAS float* tab = (LAS float*)(F.lds + TAB_OFF); LAS float* cb = (LAS float*)(F.lds + CB_OFF);
    if (F.tid < 256) {
        const int rel = F.tid - 192; const int bk = t5_bucket(rel);
        for (int h = 0; h < 4; ++h) { float bm = -1e30f; for (int k = 0; k < 32; ++k) bm = fmaxf(bm, rb[k * 4 + h]);
            float bn = 1e30f; for (int k = 0; k < 32; ++k) bn = fminf(bn, rb[k * 4 + h]);
            const float bound = (8.f * gqm * gkm * 1.02f + (bm - bn)) * LOG2E;
            const float ch = rb[15 * 4 + h] + fmaxf(0.f, bound - 100.f) / LOG2E;
            tab[h * 256 + F.tid] = (rb[bk * 4 + h] - ch) * LOG2E;
            if (F.tid == 0) cb[h] = (rb[15 * 4 + h] - ch) * LOG2E; }
        if (F.tid == 0) cb[4] = __expf(s1) - __expf(s2) + LAM_INIT;
    }
    __syncthreads();
}

template <bool DVP = false>
__device__ __forceinline__ void attn_finish(LAS unsigned char* lds, f32x16 (&o)[4], const float (&rl)[16], bool active, int mp, int rg, float lam, const float* gs, bf16* orow0, int lane) {
    const int r32 = lane & 31, hi = lane >> 5;
    LAS float* ex = (LAS float*)lds + rg * 4096;
    if (active && mp == 1) {
#pragma unroll
        for (int d0 = 0; d0 < 4; ++d0)
#pragma unroll
            for (int r = 0; r < 16; ++r) ex[(d0 * 16 + r) * 64 + lane] = o[d0][r] * rl[r];
    }
    __syncthreads();
    if (active && mp == 0) {
#pragma unroll
        for (int d0 = 0; d0 < 4; ++d0)
#pragma unroll
            for (int r = 0; r < 16; ++r) o[d0][r] = o[d0][r] * rl[r] - lam * ex[(d0 * 16 + r) * 64 + lane];
        float gsv[4];
#pragma unroll
        for (int d0 = 0; d0 < 4; ++d0) gsv[d0] = gs[DVP ? 4 * r32 + d0 : 32 * d0 + r32] * (1.f - LAM_INIT);
        LAS bf16* st = (LAS bf16*)ex;
#pragma unroll
        for (int r = 0; r < 16; ++r) {
            float s = (o[0][r] * o[0][r] + o[1][r] * o[1][r]) + (o[2][r] * o[2][r] + o[3][r] * o[3][r]);
            s += __shfl_xor(s, 1); s += __shfl_xor(s, 2); s += __shfl_xor(s, 4); s += __shfl_xor(s, 8); s += __shfl_xor(s, 16);
            const float rn = rsqrtf(s * (1.f / 128.f) + EPSN);
#pragma unroll
            for (int d0 = 0; d0 < 4; ++d0) st[crow(r, hi) * 136 + (DVP ? 4 * r32 + d0 : d0 * 32 + r32)] = (bf16)f2bf(o[d0][r] * rn * gsv[d0]);
        }
#pragma unroll
        for (int i = 0; i < 8; ++i) { const int pi = i * 64 + lane, row = pi >> 4, ch = pi & 15;
            const u32x4 v = *(LAS const u32x4*)(st + row * 136 + ch * 8); *(u32x4*)(orow0 + (size_t)row * DM + ch * 8) = v; }
    }
    __syncthreads();
}

#ifndef ATT_VAR
#define ATT_VAR 0
#endif
template <int VAR>
__device__ __forceinline__ void attn_unit(Frame& F, const bf16* QA, const bf16* KA, const bf16* VA, bf16* OB, int b, int h, int qblk, float lam) {
    LAS unsigned char* lds = F.lds; int tid = F.tid; asm volatile("" : "+v"(tid)); const int wid = F.wave, lane = tid & 63;
    const int r32 = lane & 31, hi = lane >> 5, mp = wid >> 2, rg = wid & 3;
    const int q0 = qblk * 128, qw0 = q0 + rg * 32; const size_t rowbase = (size_t)b * SEQ;
    bf16x8 qr[4];
    { const bf16* qp = QA + (rowbase + qw0 + r32) * 512 + h * 128 + mp * 64 + hi * 8;
#pragma unroll
      for (int d0 = 0; d0 < 4; ++d0) qr[d0] = __builtin_nontemporal_load((const bf16x8*)(qp + d0 * 16)); }
    f32x16 o[4];
#pragma unroll
    for (int d0 = 0; d0 < 4; ++d0)
#pragma unroll
        for (int r = 0; r < 16; ++r) o[d0][r] = 0.f;
    float lsum = 0.f;
    const int NTw = (qw0 >> 6) + 1, NTu = (q0 >> 6) + 2, far_max = qw0 - 154;
    const float cbh = ((LAS const float*)(lds + CB_OFF))[h];
    LAS const float* tab = (LAS const float*)(lds + TAB_OFF) + h * 256;
    const bf16* kbu = KA + rowbase * 512 + h * 128; const bf16* vbu = VA + rowbase * 512 + h * 128;
    unsigned kofs[2], vofs[2];
#pragma unroll
    for (int i = 0; i < 2; ++i) { const int d = wid + 8 * i;
        const int key = 4 * d + (lane >> 4);
        kofs[i] = (unsigned)(key * 512 + (((lane & 15) ^ (key & 15)) * 8));
        const int kk = (d >> 1) * 8 + ((lane >> 2) & 7), kv = (kk & ~0xC) | ((kk & 4) << 1) | ((kk & 8) >> 1);
        vofs[i] = (unsigned)(kv * 512 + (2 * (d & 1) + (lane >> 5)) * 32 + (lane & 3) * 8); }
    int ka[4];
#pragma unroll
    for (int d0 = 0; d0 < 4; ++d0) ka[d0] = r32 * 256 + (((mp * 8 + 2 * d0 + hi) ^ (r32 & 15)) * 16);
    const int vrb = v_rd_base(lane);
    constexpr int VRING = 49152;
    const unsigned ldsbase = (unsigned)(size_t)lds;
#define DMA16(ldsa, voff, sbase) asm volatile("s_mov_b32 m0, %0\n\ts_nop 0\n\tglobal_load_lds_dwordx4 %1, %2" :: "s"(ldsa), "v"(voff), "s"(sbase) : "memory", "m0")
#define LOADS(t, ksl) do { if (VAR & 1) break; const size_t go_ = (size_t)(t) * 64 * 512; const int ko_ = (ksl) * 16384, vo_ = VRING + ((t) & 3) * 16384; \
        const bf16* kb_ = kbu + go_; const bf16* vb2_ = vbu + go_; const unsigned lb_ = ldsbase + wid * 1024; \
        DMA16(lb_ + ko_, kofs[0] * 2u, kb_); DMA16(lb_ + ko_ + 8192, kofs[1] * 2u, kb_); DMA16(lb_ + vo_, vofs[0] * 2u, vb2_); DMA16(lb_ + vo_ + 8192, vofs[1] * 2u, vb2_); } while (0)
    bf16x8 pa0, pa1, pa2, pa3;
    { const u32x4 z4 = {0u, 0u, 0u, 0u}; pa0 = __builtin_bit_cast(bf16x8, z4); pa1 = pa0; pa2 = pa0; pa3 = pa0; }
    f32x16 p0, p1, lacc;
#pragma unroll
    for (int r = 0; r < 16; ++r) { p0[r] = 0.f; p1[r] = 0.f; lacc[r] = 0.f; }
    const bf16x8 ones = {(short)0x3F80, (short)0x3F80, (short)0x3F80, (short)0x3F80, (short)0x3F80, (short)0x3F80, (short)0x3F80, (short)0x3F80};
#define SBAR() __builtin_amdgcn_sched_barrier(0)
#define QK(ko, t) do { \
        f32x16 z_; _Pragma("unroll") for (int r = 0; r < 16; ++r) z_[r] = 0.f; \
        if (VAR & 8) { p0 = z_; p1 = z_; asm volatile("" : "+v"(p0), "+v"(p1)); } else { \
        _Pragma("unroll") for (int d0 = 0; d0 < 4; ++d0) { \
            const bf16x8 b0 = (VAR & 32) ? pa0 : *(LAS const bf16x8*)(lds + (ko) + ka[d0]), b1 = (VAR & 32) ? pa1 : *(LAS const bf16x8*)(lds + (ko) + ka[d0] + 8192), qf = qr[d0]; \
            p0 = __builtin_amdgcn_mfma_f32_32x32x16_bf16(b0, qf, d0 == 0 ? z_ : p0, 0, 0, 0); \
            p1 = __builtin_amdgcn_mfma_f32_32x32x16_bf16(b1, qf, d0 == 0 ? z_ : p1, 0, 0, 0); } } \
        if (64 * (t) > far_max || cbh != 0.f) {        \
            const int bi_ = 64 * (t) - qw0 - r32 + 4 * hi + 192; \
            _Pragma("unroll") for (int r = 0; r < 16; ++r) { const int i0_ = bi_ + (r & 3) + 8 * (r >> 2), i1_ = i0_ + 32; \
                p0[r] += tab[i0_ < 0 ? 0 : i0_]; p1[r] += tab[i1_ < 0 ? 0 : i1_]; } \
        } } while (0)
#define EX2(P, B) do { if (!(VAR & 2)) { P[B] = __builtin_amdgcn_exp2f(P[B]); P[B + 1] = __builtin_amdgcn_exp2f(P[B + 1]); } asm volatile("" : "+v"(P)); } while (0)
#define EXG(g) do { if ((g) < 8) EX2(p0, 2 * (g)); else EX2(p1, 2 * ((g) - 8)); } while (0)
#define VFR(d0, ks) ((VAR & 32) ? pa0 : cat8(vtr(vb_ + (d0) * 512 + (ks) * 4096), vtr(vb_ + (d0) * 512 + (ks) * 4096 + 2048)))
#define PVX(vo, DOEXP) do { if (VAR & 4) { if (DOEXP) { _Pragma("unroll") for (int g_ = 0; g_ < 16; ++g_) EXG(g_); } break; } \
        LAS const unsigned char* vb_ = lds + (vo) + vrb; \
        bf16x8 vf0 = VFR(0, 0), vf1 = VFR(0, 1), vf2; \
        SBAR(); \
        o[0] = __builtin_amdgcn_mfma_f32_32x32x16_bf16(pa0, vf0, o[0], 0, 0, 0); vf2 = VFR(0, 2); if (DOEXP) EXG(0); SBAR(); \
        o[0] = __builtin_amdgcn_mfma_f32_32x32x16_bf16(pa1, vf1, o[0], 0, 0, 0); vf0 = VFR(0, 3); if (DOEXP) EXG(1); SBAR(); \
        o[0] = __builtin_amdgcn_mfma_f32_32x32x16_bf16(pa2, vf2, o[0], 0, 0, 0); vf1 = VFR(1, 0); if (DOEXP) EXG(2); SBAR(); \
        o[0] = __builtin_amdgcn_mfma_f32_32x32x16_bf16(pa3, vf0, o[0], 0, 0, 0); vf2 = VFR(1, 1); if (DOEXP) EXG(3); SBAR(); \
        o[1] = __builtin_amdgcn_mfma_f32_32x32x16_bf16(pa0, vf1, o[1], 0, 0, 0); vf0 = VFR(1, 2); if (DOEXP) EXG(4); SBAR(); \
        o[1] = __builtin_amdgcn_mfma_f32_32x32x16_bf16(pa1, vf2, o[1], 0, 0, 0); vf1 = VFR(1, 3); if (DOEXP) EXG(5); SBAR(); \
        o[1] = __builtin_amdgcn_mfma_f32_32x32x16_bf16(pa2, vf0, o[1], 0, 0, 0); vf2 = VFR(2, 0); if (DOEXP) EXG(6); SBAR(); \
        o[1] = __builtin_amdgcn_mfma_f32_32x32x16_bf16(pa3, vf1, o[1], 0, 0, 0); vf0 = VFR(2, 1); if (DOEXP) EXG(7); SBAR(); \
        o[2] = __builtin_amdgcn_mfma_f32_32x32x16_bf16(pa0, vf2, o[2], 0, 0, 0); vf1 = VFR(2, 2); if (DOEXP) EXG(8); SBAR(); \
        o[2] = __builtin_amdgcn_mfma_f32_32x32x16_bf16(pa1, vf0, o[2], 0, 0, 0); vf2 = VFR(2, 3); if (DOEXP) EXG(9); SBAR(); \
        o[2] = __builtin_amdgcn_mfma_f32_32x32x16_bf16(pa2, vf1, o[2], 0, 0, 0); vf0 = VFR(3, 0); if (DOEXP) EXG(10); SBAR(); \
        o[2] = __builtin_amdgcn_mfma_f32_32x32x16_bf16(pa3, vf2, o[2], 0, 0, 0); vf1 = VFR(3, 1); if (DOEXP) EXG(11); SBAR(); \
        o[3] = __builtin_amdgcn_mfma_f32_32x32x16_bf16(pa0, vf0, o[3], 0, 0, 0); lacc = __builtin_amdgcn_mfma_f32_32x32x16_bf16(pa0, ones, lacc, 0, 0, 0); vf2 = VFR(3, 2); if (DOEXP) EXG(12); SBAR(); \
        o[3] = __builtin_amdgcn_mfma_f32_32x32x16_bf16(pa1, vf1, o[3], 0, 0, 0); lacc = __builtin_amdgcn_mfma_f32_32x32x16_bf16(pa1, ones, lacc, 0, 0, 0); vf0 = VFR(3, 3); if (DOEXP) EXG(13); SBAR(); \
        o[3] = __builtin_amdgcn_mfma_f32_32x32x16_bf16(pa2, vf2, o[3], 0, 0, 0); lacc = __builtin_amdgcn_mfma_f32_32x32x16_bf16(pa2, ones, lacc, 0, 0, 0); if (DOEXP) EXG(14); SBAR(); \
        o[3] = __builtin_amdgcn_mfma_f32_32x32x16_bf16(pa3, vf0, o[3], 0, 0, 0); lacc = __builtin_amdgcn_mfma_f32_32x32x16_bf16(pa3, ones, lacc, 0, 0, 0); if (DOEXP) EXG(15); SBAR(); } while (0)
    LOADS(0, 0); LOADS(1, 1);
    asm volatile("" :: "v"(qr[0]), "v"(qr[1]), "v"(qr[2]), "v"(qr[3]));
    asm volatile("s_waitcnt vmcnt(4)" ::: "memory");
    __syncthreads();
    const int NSTEP = NTu + 1;
#define PVPART(jt) do { const int j_ = (jt); \
        PVX(VRING + ((j_ > 0 ? j_ : 0) & 3) * 16384, 1); \
        if (j_ + 1 >= 0 && j_ + 1 < NTw) { PK4(p0, 0, pa0); PK4(p0, 8, pa1); PK4(p1, 0, pa2); PK4(p1, 8, pa3); } } while (0)
    int ks = 0;
    for (int t = 0; t < NSTEP; ++t) {
        const int kcur = ks * 16384; const bool more = t + 2 < NTu;
        if (more) LOADS(t + 2, ks == 0 ? 2 : ks - 1);
        if (t < NTw) QK(kcur, t);
        if (t <= NTw) PVPART(t - 1);
        if (more) asm volatile("s_waitcnt vmcnt(4)" ::: "memory"); else asm volatile("s_waitcnt vmcnt(0)" ::: "memory");
        if (!(VAR & 16)) __syncthreads();
        ks = ks == 2 ? 0 : ks + 1;
    }
#undef PVPART
#undef LOADS
#undef DMA16
#undef QK
#undef EX2
#undef EXG
#undef VFR
#undef PVX
#undef SBAR
    float rl[16];
#pragma unroll
    for (int r = 0; r < 16; ++r) rl[r] = 1.f / lacc[r];
    attn_finish(lds, o, rl, true, mp, rg, lam, F.A->in[18], OB + (rowbase + qw0) * DM + h * 128, lane);
}

__device__ __forceinline__ void sattn_unit(Frame& F, const bf16* QA, bf16* OB, int bs, int h, float lam) {
    LAS unsigned char* lds = F.lds; int tid = F.tid; asm volatile("" : "+v"(tid)); const int wid = F.wave, lane = tid & 63;
    const int r32 = lane & 31, hi = lane >> 5, mp = wid >> 2, sp = wid & 3;
    const size_t row0 = (size_t)MP + (size_t)bs * LS;
    bf16x8 qr[4];
    { const bf16* qp = QA + (row0 + r32) * 512 + h * 128 + mp * 64 + hi * 8;
#pragma unroll
      for (int d0 = 0; d0 < 4; ++d0) qr[d0] = *(const bf16x8*)(qp + d0 * 16); }
    f32x16 o[4];
#pragma unroll
    for (int d0 = 0; d0 < 4; ++d0)
#pragma unroll
        for (int r = 0; r < 16; ++r) o[d0][r] = 0.f;
    float lsum = 0.f;
    LAS const float* tab = (LAS const float*)(lds + TAB_OFF) + h * 256;
    f32x4 kl[8], vl[16];
    LAS unsigned char* kst = lds + wid * 8192; const int kkey = lane >> 4, kpc = lane & 15;
#define SA_BASE(tt_, kp_, vp_) const float* kp_; const float* vp_; \
        if ((tt_) < 64) { const size_t off_ = ((size_t)(bs * PAST + (tt_) * 32) * 4 + h) * 128; kp_ = F.A->in[4] + off_; vp_ = F.A->in[5] + off_; } \
        else { const size_t off_ = ((size_t)(bs * LS) * 4 + h) * 128; kp_ = F.out + OFF_KS + off_; vp_ = F.out + OFF_VS + off_; }
#define SA_KLOAD(tt_) do { SA_BASE(tt_, kp_, vp_) (void)vp_; const float* a_ = kp_ + (size_t)kkey * 512 + mp * 64 + kpc * 4; \
        _Pragma("unroll") for (int i_ = 0; i_ < 8; ++i_) kl[i_] = __builtin_nontemporal_load((const f32x4*)(a_ + (size_t)i_ * 4 * 512)); } while (0)
#define SA_VLOAD(tt_) do { SA_BASE(tt_, kp_, vp_) (void)kp_; const float* v0p_ = vp_ + (size_t)(8 * hi) * 512 + 4 * r32; \
        _Pragma("unroll") for (int j = 0; j < 8; ++j) { vl[j] = __builtin_nontemporal_load((const f32x4*)(v0p_ + j * 512)); vl[8 + j] = __builtin_nontemporal_load((const f32x4*)(v0p_ + (16 + j) * 512)); } } while (0)
    SA_KLOAD(sp); SA_VLOAD(sp);
    for (int tt = sp; tt < 65; tt += 4) {
#pragma unroll
        for (int i = 0; i < 8; ++i) { u32x2 wv; wv.x = cvtpk(kl[i][0], kl[i][1]); wv.y = cvtpk(kl[i][2], kl[i][3]); *(LAS u32x2*)(kst + (4 * i + kkey) * 144 + kpc * 8) = wv; }
        if (tt + 4 < 65) SA_KLOAD(tt + 4);
        bf16x8 kf[4];
#pragma unroll
        for (int d0 = 0; d0 < 4; ++d0) kf[d0] = *(LAS const bf16x8*)(kst + r32 * 144 + d0 * 32 + hi * 16);
        f32x16 p;
#pragma unroll
        for (int r = 0; r < 16; ++r) p[r] = 0.f;
#pragma unroll
        for (int d0 = 0; d0 < 4; ++d0) p = __builtin_amdgcn_mfma_f32_32x32x16_bf16(kf[d0], qr[d0], p, 0, 0, 0);
        const int relb = tt * 32 - PAST - r32 + 4 * hi;
        float ps = 0.f;
#pragma unroll
        for (int r = 0; r < 16; ++r) { int rel = relb + (r & 3) + 8 * (r >> 2); rel = rel < -192 ? -192 : rel; p[r] = __builtin_amdgcn_exp2f(p[r] + tab[rel + 192]); ps += p[r]; }
        lsum += ps;
        bf16x8 pa0, pa1;
        PK4(p, 0, pa0); PK4(p, 8, pa1);
#pragma unroll
        for (int d0 = 0; d0 < 4; ++d0) {
            f32x4 a, c, e, g;
            a[0] = vl[0][d0]; a[1] = vl[1][d0]; a[2] = vl[2][d0]; a[3] = vl[3][d0]; c[0] = vl[4][d0]; c[1] = vl[5][d0]; c[2] = vl[6][d0]; c[3] = vl[7][d0];
            e[0] = vl[8][d0]; e[1] = vl[9][d0]; e[2] = vl[10][d0]; e[3] = vl[11][d0]; g[0] = vl[12][d0]; g[1] = vl[13][d0]; g[2] = vl[14][d0]; g[3] = vl[15][d0];
            o[d0] = __builtin_amdgcn_mfma_f32_32x32x16_bf16(pa0, pack8(a, c), o[d0], 0, 0, 0);
            o[d0] = __builtin_amdgcn_mfma_f32_32x32x16_bf16(pa1, pack8(e, g), o[d0], 0, 0, 0);
        }
        if (tt + 4 < 65) SA_VLOAD(tt + 4);
    }
#undef SA_BASE
#undef SA_KLOAD
#undef SA_VLOAD
    __syncthreads();
    { auto rr = __builtin_amdgcn_permlane32_swap(__float_as_uint(lsum), __float_as_uint(lsum), false, false); lsum = __uint_as_float(rr[0]) + __uint_as_float(rr[1]); }
    LAS float* exb = (LAS float*)lds; LAS float* wsc = (LAS float*)(lds + WSC_OFF);
    if (hi == 0) wsc[wid * 64 + r32] = lsum;
    if (sp > 0) { LAS float* e = exb + (mp * 3 + sp - 1) * 4096;
#pragma unroll
        for (int d0 = 0; d0 < 4; ++d0)
#pragma unroll
            for (int r = 0; r < 16; ++r) e[(d0 * 16 + r) * 64 + lane] = o[d0][r]; }
    __syncthreads();
    float rl[16];
    if (sp == 0) {
#pragma unroll
        for (int k = 0; k < 3; ++k) { LAS const float* e = exb + (mp * 3 + k) * 4096;
#pragma unroll
            for (int d0 = 0; d0 < 4; ++d0)
#pragma unroll
                for (int r = 0; r < 16; ++r) o[d0][r] += e[(d0 * 16 + r) * 64 + lane]; }
#pragma unroll
        for (int r = 0; r < 16; ++r) { const int q = crow(r, hi); rl[r] = 1.f / ((wsc[(mp * 4 + 0) * 64 + q] + wsc[(mp * 4 + 1) * 64 + q]) + (wsc[(mp * 4 + 2) * 64 + q] + wsc[(mp * 4 + 3) * 64 + q])); }
    } else {
#pragma unroll
        for (int r = 0; r < 16; ++r) rl[r] = 0.f;
    }
    __syncthreads();
    attn_finish<true>(lds, o, rl, sp == 0, mp, 0, lam, F.A->in[18], OB + row0 * DM + h * 128, lane);
}

constexpr int RT_ROW = 288, RT_TILE = 64 * RT_ROW, RT_BUF = 3 * RT_TILE, RT_P = 2 * RT_BUF, RT_PROW = 144, RT_RED = RT_P + 64 * RT_PROW;
static_assert(RT_RED + 8 * 64 * 4 <= RING_BYTES, "retention LDS");
constexpr int RG_CH = 16, RG_N = (SEQ / 64) / RG_CH;
__device__ __forceinline__ void ret_groupA(Frame& F, const bf16* KR, const bf16* VR, float* E, int b, int h, int grp) {
    LAS unsigned char* lds = F.lds; int tid = F.tid; asm volatile("" : "+v"(tid)); const int w = F.wave, lane = tid & 63;
    const int fr = lane & 15, g = lane >> 4, q4 = fr >> 2, p4 = fr & 3;
    const float l2g = __log2f(1.f - exp2f(-5.f - (float)h)); const float g64 = exp2f(64.f * l2g);
    f32x4 S[8];
#pragma unroll
    for (int kt = 0; kt < 8; ++kt) S[kt] = (f32x4){0.f, 0.f, 0.f, 0.f};
    const size_t rowbase = (size_t)b * SEQ + (size_t)grp * RG_CH * 64;
    const int srow = tid >> 4, sc16 = tid & 15;
    const size_t gofs = (rowbase + srow) * 512 + h * 128 + sc16 * 8;
    const int lofs = srow * RT_ROW + sc16 * 16;
    u32x4 st[4];
#define ALOAD(c) do { const size_t go_ = gofs + (size_t)(c) * 64 * 512; st[0] = *(const u32x4*)(KR + go_); st[1] = *(const u32x4*)(KR + go_ + 32 * 512); st[2] = *(const u32x4*)(VR + go_); st[3] = *(const u32x4*)(VR + go_ + 32 * 512); } while (0)
#define AWRITE(bo) do { _Pragma("unroll") for (int j_ = 0; j_ < 4; ++j_) *(LAS u32x4*)(lds + (bo) + (1 + (j_ >> 1)) * RT_TILE + (j_ & 1) * 32 * RT_ROW + lofs) = st[j_]; } while (0)
    ALOAD(0); AWRITE(0); __syncthreads();
    for (int c = 0; c < RG_CH; ++c) {
        const int cur = (c & 1) * RT_BUF;
        LAS const unsigned char* Kt = lds + cur + RT_TILE; LAS const unsigned char* Vt = lds + cur + 2 * RT_TILE;
        if (c + 1 < RG_CH) ALOAD(c + 1);
        bf16x8 vf[2];
#pragma unroll
        for (int ks = 0; ks < 2; ++ks) { LAS const unsigned char* va = Vt + (32 * ks + 8 * g + q4) * RT_ROW + (16 * w + 4 * p4) * 2; vf[ks] = cat8(vtr(va), vtr(va + 4 * RT_ROW)); }
#pragma unroll
        for (int kt = 0; kt < 8; ++kt) { S[kt] = S[kt] * g64;
#pragma unroll
            for (int ks = 0; ks < 2; ++ks) { LAS const unsigned char* ka_ = Kt + (32 * ks + 8 * g + q4) * RT_ROW + (16 * kt + 4 * p4) * 2;
                S[kt] = __builtin_amdgcn_mfma_f32_16x16x32_bf16(cat8(vtr(ka_), vtr(ka_ + 4 * RT_ROW)), vf[ks], S[kt], 0, 0, 0); } }
        if (c + 1 < RG_CH) AWRITE(cur ^ RT_BUF);
        __syncthreads();
    }
#undef ALOAD
#undef AWRITE
    float* ep = E + ((size_t)((b * 4 + h) * RG_N + grp) * 128) * 128;
#pragma unroll
    for (int kt = 0; kt < 8; ++kt)
#pragma unroll
        for (int r = 0; r < 4; ++r) ep[(size_t)(16 * kt + 4 * g + r) * 128 + 16 * w + fr] = S[kt][r];
    asm volatile("s_waitcnt vmcnt(0)" ::: "memory");
    __syncthreads();
    if (tid == 0) { __builtin_amdgcn_fence(__ATOMIC_RELEASE, "agent"); asm volatile("s_waitcnt vmcnt(0)" ::: "memory");
        __hip_atomic_fetch_add((unsigned*)(F.ctl + CW_CNTA + 64 * (b * 4 + h)), 1u, __ATOMIC_RELAXED, __HIP_MEMORY_SCOPE_AGENT); }
    __syncthreads();
}
__device__ __forceinline__ void ret_groupB(Frame& F, const bf16* QR, const bf16* KR, const bf16* VR, const bf16* GR, bf16* OB, const float* E, int b, int h, int grp) {
    LAS unsigned char* lds = F.lds; int tid = F.tid; asm volatile("" : "+v"(tid)); const int w = F.wave, lane = tid & 63;
    const int fr = lane & 15, g = lane >> 4, q4 = fr >> 2, p4 = fr & 3;
    const float l2g = __log2f(1.f - exp2f(-5.f - (float)h)); const float g64 = exp2f(64.f * l2g);
    float cs[4];
#pragma unroll
    for (int it = 0; it < 4; ++it) { const int i = 16 * it + fr; cs[it] = exp2f((float)(i + 1) * l2g); }
    const size_t rowbase = (size_t)b * SEQ + (size_t)grp * RG_CH * 64;
    const int srow = tid >> 4, sc16 = tid & 15;
    const size_t gofs = (rowbase + srow) * 512 + h * 128 + sc16 * 8;
    const int lofs = srow * RT_ROW + sc16 * 16;
    u32x4 st[6]; u32x2 gpre[4];
    const size_t grow0 = (rowbase + fr) * 512 + h * 128 + 16 * w + 4 * g;
#define NTL_(p) __builtin_nontemporal_load((const u32x4*)(p))
#define RLOAD(c) do { const size_t go_ = gofs + (size_t)(c) * 64 * 512; st[0] = NTL_(QR + go_); st[1] = NTL_(QR + go_ + 32 * 512); \
        st[2] = NTL_(KR + go_); st[3] = NTL_(KR + go_ + 32 * 512); st[4] = NTL_(VR + go_); st[5] = NTL_(VR + go_ + 32 * 512); } while (0)
#define RWRITE(bo) do { _Pragma("unroll") for (int j_ = 0; j_ < 6; ++j_) *(LAS u32x4*)(lds + (bo) + (j_ >> 1) * RT_TILE + (j_ & 1) * 32 * RT_ROW + lofs) = st[j_]; } while (0)
    RLOAD(0);
    if (tid == 0) { unsigned sp_ = 0; gu32* cp = F.ctl + CW_CNTA + 64 * (b * 4 + h);
        while (__hip_atomic_load(cp, __ATOMIC_RELAXED, __HIP_MEMORY_SCOPE_AGENT) < (unsigned)RG_N) { __builtin_amdgcn_s_sleep(4); if (++sp_ > (1u << 22)) break; }
        __builtin_amdgcn_fence(__ATOMIC_ACQUIRE, "agent"); asm volatile("s_waitcnt vmcnt(0)" ::: "memory"); }
    RWRITE(0);
    __syncthreads();
    f32x4 S[8];
#pragma unroll
    for (int kt = 0; kt < 8; ++kt) S[kt] = (f32x4){0.f, 0.f, 0.f, 0.f};
    for (int gp = 0; gp < grp; ++gp) {
        const float wgt = exp2f((float)(1024 * (grp - 1 - gp)) * l2g);
        const float* ep = E + ((size_t)((b * 4 + h) * RG_N + gp) * 128) * 128;
#pragma unroll
        for (int kt = 0; kt < 8; ++kt)
#pragma unroll
            for (int r = 0; r < 4; ++r) S[kt][r] += wgt * ep[(size_t)(16 * kt + 4 * g + r) * 128 + 16 * w + fr];
    }
    LAS float* red = (LAS float*)(lds + RT_RED);
    for (int c = 0; c < RG_CH; ++c) {
        const int cur = (c & 1) * RT_BUF;
        LAS const unsigned char* Qt = lds + cur; LAS const unsigned char* Kt = lds + cur + RT_TILE; LAS const unsigned char* Vt = lds + cur + 2 * RT_TILE;
        if (c + 1 < RG_CH) RLOAD(c + 1);
#pragma unroll
        for (int it = 0; it < 4; ++it) gpre[it] = __builtin_nontemporal_load((const u32x2*)(GR + grow0 + (size_t)(c * 64 + 16 * it) * 512));
        { const int it = w >> 1; const int i = 16 * it + fr; const float ps_ = exp2f((float)(i - 63) * l2g);
#pragma unroll
          for (int jj = 0; jj < 2; ++jj) { const int jt = 2 * (w & 1) + jj;
            f32x4 acc = (f32x4){0.f, 0.f, 0.f, 0.f};
            if (jt <= it) {
#pragma unroll
                for (int ks = 0; ks < 4; ++ks) { const bf16x8 a = *(LAS const bf16x8*)(Kt + (16 * jt + fr) * RT_ROW + (32 * ks + 8 * g) * 2);
                    const bf16x8 bq = *(LAS const bf16x8*)(Qt + (16 * it + fr) * RT_ROW + (32 * ks + 8 * g) * 2);
                    acc = __builtin_amdgcn_mfma_f32_16x16x32_bf16(a, bq, acc, 0, 0, 0); }
            }
            const int j0 = 16 * jt + 4 * g; u32x2 wv;
            wv.x = cvtpk(j0 + 0 <= i ? acc[0] * ps_ : 0.f, j0 + 1 <= i ? acc[1] * ps_ : 0.f); wv.y = cvtpk(j0 + 2 <= i ? acc[2] * ps_ : 0.f, j0 + 3 <= i ? acc[3] * ps_ : 0.f);
            *(LAS u32x2*)(lds + RT_P + i * RT_PROW + j0 * 2) = wv; } }
        f32x4 X[4];
        { bf16x8 af[4];
#pragma unroll
          for (int s = 0; s < 4; ++s) af[s] = pack8(S[2 * s], S[2 * s + 1]);
#pragma unroll
          for (int it = 0; it < 4; ++it) { X[it] = (f32x4){0.f, 0.f, 0.f, 0.f};
#pragma unroll
            for (int s = 0; s < 4; ++s) { LAS const unsigned char* qa = Qt + (16 * it + fr) * RT_ROW + (32 * s + 4 * g) * 2;
                const s16x4 lo = *(LAS const s16x4*)qa, hi4 = *(LAS const s16x4*)(qa + 32);
                X[it] = __builtin_amdgcn_mfma_f32_16x16x32_bf16(af[s], cat8(lo, hi4), X[it], 0, 0, 0); } } }
        __syncthreads();
        bf16x8 vf[2];
#pragma unroll
        for (int ks = 0; ks < 2; ++ks) { LAS const unsigned char* va = Vt + (32 * ks + 8 * g + q4) * RT_ROW + (16 * w + 4 * p4) * 2; vf[ks] = cat8(vtr(va), vtr(va + 4 * RT_ROW)); }
        f32x4 Y[4];
#pragma unroll
        for (int it = 0; it < 4; ++it) { Y[it] = (f32x4){0.f, 0.f, 0.f, 0.f};
#pragma unroll
            for (int ks = 0; ks < 2; ++ks) { const bf16x8 pb = *(LAS const bf16x8*)(lds + RT_P + (16 * it + fr) * RT_PROW + (32 * ks + 8 * g) * 2);
                Y[it] = __builtin_amdgcn_mfma_f32_16x16x32_bf16(vf[ks], pb, Y[it], 0, 0, 0); } }
#pragma unroll
        for (int kt = 0; kt < 8; ++kt) { S[kt] = S[kt] * g64;
#pragma unroll
            for (int ks = 0; ks < 2; ++ks) { LAS const unsigned char* ka_ = Kt + (32 * ks + 8 * g + q4) * RT_ROW + (16 * kt + 4 * p4) * 2;
                S[kt] = __builtin_amdgcn_mfma_f32_16x16x32_bf16(cat8(vtr(ka_), vtr(ka_ + 4 * RT_ROW)), vf[ks], S[kt], 0, 0, 0); } }
        f32x4 ov[4];
#pragma unroll
        for (int it = 0; it < 4; ++it) { ov[it] = Y[it] + X[it] * cs[it];
            float sq = (ov[it][0] * ov[it][0] + ov[it][1] * ov[it][1]) + (ov[it][2] * ov[it][2] + ov[it][3] * ov[it][3]);
            sq += __shfl_xor(sq, 16); sq += __shfl_xor(sq, 32);
            if (g == 0) red[w * 64 + 16 * it + fr] = sq; }
        if (c + 1 < RG_CH) RWRITE(cur ^ RT_BUF);
        __syncthreads();
#pragma unroll
        for (int it = 0; it < 4; ++it) { const int i = 16 * it + fr; float tot = 0.f;
#pragma unroll
            for (int ww = 0; ww < 8; ++ww) tot += red[ww * 64 + i];
            const float rstd = rsqrtf(tot * (1.f / 128.f) + EPSN);
            const size_t row = rowbase + (size_t)c * 64 + i;
            const u32x2 gv = gpre[it];
            const float g0 = __uint_as_float(gv.x << 16), g1 = __uint_as_float(gv.x & 0xffff0000u), g2 = __uint_as_float(gv.y << 16), g3 = __uint_as_float(gv.y & 0xffff0000u);
            u32x2 ow; ow.x = cvtpk(ov[it][0] * rstd * g0, ov[it][1] * rstd * g1); ow.y = cvtpk(ov[it][2] * rstd * g2, ov[it][3] * rstd * g3);
            *(u32x2*)(OB + row * DM + 512 + h * 128 + 16 * w + 4 * g) = ow; }
    }
#undef RLOAD
#undef RWRITE
#undef NTL_
    if (grp == RG_N - 1) {
        float* rp = F.out + OFF_RP + ((size_t)(b * 4 + h) * 128) * 128;
#pragma unroll
        for (int kt = 0; kt < 8; ++kt)
#pragma unroll
            for (int r = 0; r < 4; ++r) rp[(size_t)(16 * kt + 4 * g + r) * 128 + 16 * w + fr] = S[kt][r];
    }
    __syncthreads();
}

__device__ __forceinline__ void ret_sample(Frame& F, const bf16* QR, const bf16* KR, const bf16* VR, const bf16* GR, bf16* OB, int bs, int h) {
    LAS unsigned char* lds = F.lds; int tid = F.tid; asm volatile("" : "+v"(tid)); const int w = F.wave, lane = tid & 63;
    const int fr = lane & 15, g = lane >> 4, q4 = fr >> 2, p4 = fr & 3;
    const float l2g = __log2f(1.f - exp2f(-5.f - (float)h)); const float g32 = exp2f(32.f * l2g);
    const size_t row0 = (size_t)MP + (size_t)bs * LS;
    LAS const unsigned char* Qt = lds; LAS const unsigned char* Kt = lds + RT_TILE; LAS const unsigned char* Vt = lds + 2 * RT_TILE;
    { const int srow = tid >> 4, sc16 = tid & 15; const size_t go_ = (row0 + srow) * 512 + h * 128 + sc16 * 8; const int lofs = srow * RT_ROW + sc16 * 16;
      const u32x4 a = *(const u32x4*)(QR + go_), b = *(const u32x4*)(KR + go_), c = *(const u32x4*)(VR + go_);
      *(LAS u32x4*)(lds + lofs) = a; *(LAS u32x4*)(lds + RT_TILE + lofs) = b; *(LAS u32x4*)(lds + 2 * RT_TILE + lofs) = c; }
    const float* S0 = F.A->in[6] + ((size_t)(bs * 4 + h) * 128) * 128;
    f32x4 S[8];
#pragma unroll
    for (int kt = 0; kt < 8; ++kt)
#pragma unroll
        for (int r = 0; r < 4; ++r) S[kt][r] = __builtin_nontemporal_load(S0 + (size_t)(16 * kt + 4 * g + r) * 128 + 16 * w + fr);
    u32x2 gpre[2];
#pragma unroll
    for (int it = 0; it < 2; ++it) gpre[it] = __builtin_nontemporal_load((const u32x2*)(GR + (row0 + 16 * it + fr) * 512 + h * 128 + 16 * w + 4 * g));
    __syncthreads();
    if (w < 4) { const int it = w >> 1, jt = w & 1; const int i = 16 * it + fr; const float ps_ = exp2f((float)(i - 31) * l2g);
        f32x4 acc = (f32x4){0.f, 0.f, 0.f, 0.f};
        if (jt <= it) {
#pragma unroll
            for (int ks = 0; ks < 4; ++ks) { const bf16x8 a = *(LAS const bf16x8*)(Kt + (16 * jt + fr) * RT_ROW + (32 * ks + 8 * g) * 2);
                const bf16x8 bq = *(LAS const bf16x8*)(Qt + (16 * it + fr) * RT_ROW + (32 * ks + 8 * g) * 2);
                acc = __builtin_amdgcn_mfma_f32_16x16x32_bf16(a, bq, acc, 0, 0, 0); }
        }
        const int j0 = 16 * jt + 4 * g; u32x2 wv;
        wv.x = cvtpk(j0 + 0 <= i ? acc[0] * ps_ : 0.f, j0 + 1 <= i ? acc[1] * ps_ : 0.f); wv.y = cvtpk(j0 + 2 <= i ? acc[2] * ps_ : 0.f, j0 + 3 <= i ? acc[3] * ps_ : 0.f);
        *(LAS u32x2*)(lds + RT_P + i * RT_PROW + j0 * 2) = wv; }
    f32x4 X[2];
    { bf16x8 af[4];
#pragma unroll
      for (int s = 0; s < 4; ++s) af[s] = pack8(S[2 * s], S[2 * s + 1]);
#pragma unroll
      for (int it = 0; it < 2; ++it) { X[it] = (f32x4){0.f, 0.f, 0.f, 0.f};
#pragma unroll
        for (int s = 0; s < 4; ++s) { LAS const unsigned char* qa = Qt + (16 * it + fr) * RT_ROW + (32 * s + 4 * g) * 2;
            const s16x4 lo = *(LAS const s16x4*)qa, hi4 = *(LAS const s16x4*)(qa + 32);
            X[it] = __builtin_amdgcn_mfma_f32_16x16x32_bf16(af[s], cat8(lo, hi4), X[it], 0, 0, 0); } } }
    __syncthreads();
    bf16x8 vf;
    { LAS const unsigned char* va = Vt + (8 * g + q4) * RT_ROW + (16 * w + 4 * p4) * 2; vf = cat8(vtr(va), vtr(va + 4 * RT_ROW)); }
    f32x4 Y[2];
#pragma unroll
    for (int it = 0; it < 2; ++it) { const bf16x8 pb = *(LAS const bf16x8*)(lds + RT_P + (16 * it + fr) * RT_PROW + (8 * g) * 2);
        Y[it] = __builtin_amdgcn_mfma_f32_16x16x32_bf16(vf, pb, (f32x4){0.f, 0.f, 0.f, 0.f}, 0, 0, 0); }
#pragma unroll
    for (int kt = 0; kt < 8; ++kt) { S[kt] = S[kt] * g32;
        LAS const unsigned char* ka_ = Kt + (8 * g + q4) * RT_ROW + (16 * kt + 4 * p4) * 2;
        S[kt] = __builtin_amdgcn_mfma_f32_16x16x32_bf16(cat8(vtr(ka_), vtr(ka_ + 4 * RT_ROW)), vf, S[kt], 0, 0, 0); }
    { float* rp = F.out + OFF_RS + ((size_t)(bs * 4 + h) * 128) * 128;
#pragma unroll
      for (int kt = 0; kt < 8; ++kt)
#pragma unroll
        for (int r = 0; r < 4; ++r) rp[(size_t)(16 * kt + 4 * g + r) * 128 + 16 * w + fr] = S[kt][r]; }
    LAS float* red = (LAS float*)(lds + RT_RED);
    f32x4 ov[2];
#pragma unroll
    for (int it = 0; it < 2; ++it) { const float cs_ = exp2f((float)(16 * it + fr + 1) * l2g); ov[it] = Y[it] + X[it] * cs_;
        float sq = (ov[it][0] * ov[it][0] + ov[it][1] * ov[it][1]) + (ov[it][2] * ov[it][2] + ov[it][3] * ov[it][3]);
        sq += __shfl_xor(sq, 16); sq += __shfl_xor(sq, 32);
        if (g == 0) red[w * 64 + 16 * it + fr] = sq; }
    __syncthreads();
#pragma unroll
    for (int it = 0; it < 2; ++it) { const int i = 16 * it + fr; float tot = 0.f;
#pragma unroll
        for (int ww = 0; ww < 8; ++ww) tot += red[ww * 64 + i];
        const float rstd = rsqrtf(tot * (1.f / 128.f) + EPSN);
        const u32x2 gv = gpre[it];
        const float g0 = __uint_as_float(gv.x << 16), g1 = __uint_as_float(gv.x & 0xffff0000u), g2 = __uint_as_float(gv.y << 16), g3 = __uint_as_float(gv.y & 0xffff0000u);
        u32x2 ow; ow.x = cvtpk(ov[it][0] * rstd * g0, ov[it][1] * rstd * g1); ow.y = cvtpk(ov[it][2] * rstd * g2, ov[it][3] * rstd * g3);
        *(u32x2*)(OB + (row0 + i) * DM + 512 + h * 128 + 16 * w + 4 * g) = ow; }
    __syncthreads();
}

__device__ __forceinline__ int q_next(Frame& F, int q, int rep = 0) {
    volatile LAS int* slot = (volatile LAS int*)(F.lds + QSLOT_OFF);
    if (F.tid == 0) *slot = (int)__hip_atomic_fetch_add((unsigned*)(F.ctl + CW_QUEUE + 64 * (q + 8 * rep)), 1u, __ATOMIC_RELAXED, __HIP_MEMORY_SCOPE_AGENT);
    __syncthreads();
    const int v = *slot;
    __syncthreads();
    return v;
}
#ifndef P2M
#define P2M 31
#endif
constexpr int Q_ITEMS = 16 + 128 + 16 + 8 + 8;
__device__ __forceinline__ void phase2(Frame& F, int rep = 0, int mask = 31) {
    p2_setup(F);
    const float lam = ((LAS const float*)(F.lds + CB_OFF))[4];
    bf16* act = (bf16*)(F.ws + WS_ACT);
    const bf16* QA = act, *KA = act + ACT_STRIDE, *VA = act + 2 * ACT_STRIDE, *QR = act + 3 * ACT_STRIDE, *KR = act + 4 * ACT_STRIDE, *VR = act + 5 * ACT_STRIDE, *GR = act + 6 * ACT_STRIDE;
    bf16* OB = (bf16*)(F.ws + WS_OB); float* E = (float*)(F.ws + WS_E);
    const int xcc = (int)(xb_xcc_id() & 7u);
    for (int k = 0; k < 8; ++k) {
        const int q = (xcc + k) & 7;
        for (;;) {
            const int i = q_next(F, q, rep);
            if (i >= Q_ITEMS) break;
            if (i < 16) { if (mask & P2M & 1) { const int bh = 2 * q + (i >> 3); ret_groupA(F, KR, VR, E, bh >> 2, bh & 3, i & 7); } }
            else if (i >= 48 && i < 64) { if (mask & P2M & 16) { const int bh = 2 * q + ((i - 48) >> 3); ret_groupB(F, QR, KR, VR, GR, OB, E, bh >> 2, bh & 3, (i - 48) & 7); } }
            else if (i >= 64 && i < 72) { if (mask & P2M & 4) { const int id = 8 * q + (i - 64); sattn_unit(F, QA, OB, id >> 2, id & 3, lam); } }
            else if (i >= 72 && i < 80) { if (mask & P2M & 8) { const int id = 8 * q + (i - 72); ret_sample(F, QR, KR, VR, GR, OB, id >> 2, id & 3); } }
            else { if (mask & P2M & 2) { const int j = i < 48 ? i - 16 : i - 48, bh = 2 * q + (j & 1); if (rep == 0) attn_unit<0>(F, QA, KA, VA, OB, bh >> 2, bh & 3, 63 - (j >> 1), lam); else attn_unit<ATT_VAR>(F, QA, KA, VA, (bf16*)(F.ws + WS_XN), bh >> 2, bh & 3, 63 - (j >> 1), lam); } }
        }
    }
}
}


namespace sg {
using p2::bf16x8; using p2::f32x16; using p2::crow;
template <int NB>
__device__ __forceinline__ void wave_mm(f32x16 (&acc)[NB], LAS unsigned char* wl, const bf16* A, int lda, const bf16* Bm, int ldb, const int (&brow)[NB][4], int k0, int k1, int lane) {
#pragma unroll
    for (int nb = 0; nb < NB; ++nb)
#pragma unroll
        for (int r = 0; r < 16; ++r) acc[nb][r] = 0.f;
    const int r32 = lane & 31, hi = lane >> 5, lrow = lane >> 3, lpc = lane & 7;
    p2::u32x4 st[1 + NB][4];
#define SG_LOAD(ks) do { _Pragma("unroll") for (int i = 0; i < 4; ++i) { st[0][i] = *(const p2::u32x4*)(A + (size_t)(8 * i + lrow) * lda + (ks) + lpc * 8); \
        _Pragma("unroll") for (int nb = 0; nb < NB; ++nb) st[1 + nb][i] = *(const p2::u32x4*)(Bm + (size_t)brow[nb][i] * ldb + (ks) + lpc * 8); } } while (0)
    SG_LOAD(k0);
    for (int ks = k0; ks < k1; ks += 64) {
#pragma unroll
        for (int t = 0; t < 1 + NB; ++t)
#pragma unroll
            for (int i = 0; i < 4; ++i) { const int row = 8 * i + lrow; *(LAS p2::u32x4*)(wl + t * 4096 + row * 128 + ((lpc ^ ((row >> 1) & 7)) * 16)) = st[t][i]; }
        if (ks + 64 < k1) SG_LOAD(ks + 64);
#pragma unroll
        for (int u = 0; u < 4; ++u) { const int po = ((2 * u + hi) ^ ((r32 >> 1) & 7)) * 16;
            const bf16x8 a = *(LAS const bf16x8*)(wl + r32 * 128 + po);
#pragma unroll
            for (int nb = 0; nb < NB; ++nb) { const bf16x8 b = *(LAS const bf16x8*)(wl + (1 + nb) * 4096 + r32 * 128 + po); acc[nb] = __builtin_amdgcn_mfma_f32_32x32x16_bf16(a, b, acc[nb], 0, 0, 0); } }
    }
#undef SG_LOAD
}
__device__ __forceinline__ float half_sum(float s) { s += __shfl_xor(s, 1); s += __shfl_xor(s, 2); s += __shfl_xor(s, 4); s += __shfl_xor(s, 8); s += __shfl_xor(s, 16); return s; }
__device__ __forceinline__ float bf2f(bf16 v) { return __uint_as_float((unsigned)v << 16); }

__device__ __forceinline__ void p1_sample(Frame& F, const bf16* XN, const bf16* Win, bf16* act) {
    int tid = F.tid; asm volatile("" : "+v"(tid)); const int lane = tid & 63, r32 = lane & 31, hi = lane >> 5;
    const int gw = blockIdx.x + F.G * F.wave, NGW = F.G * NWAVES;
    const float* rot = (const float*)(F.ws + WS_ROT);
    for (int id = gw; id < 16 * (DIN / 64); id += NGW) {
        const int cg = id >> 4, rt = id & 15, m0 = MP + 32 * rt, n0 = 64 * cg;
        f32x16 acc[2];
        int brow[2][4];
#pragma unroll
        for (int nb = 0; nb < 2; ++nb)
#pragma unroll
            for (int i = 0; i < 4; ++i) brow[nb][i] = dst_row(1, n0 + 32 * nb + 8 * i + (lane >> 3));
        wave_mm<2>(acc, F.lds + F.wave * 12288, XN + (size_t)m0 * DM, DM, Win, DM, brow, 0, DM, lane);
        const int type = n0 >> 9, lc = (n0 & 511) + r32;
        bf16* dst = act + (size_t)type * ACT_STRIDE;
        if (type <= 1) {
            const float* g = type == 0 ? F.A->in[12] : F.A->in[13]; const float g0 = g[r32], g1 = g[32 + r32], osc = type == 0 ? QSCALE : 1.f;
#pragma unroll
            for (int r = 0; r < 16; ++r) { const int m = m0 + crow(r, hi);
                const float rinv = rsqrtf(half_sum(acc[0][r] * acc[0][r] + acc[1][r] * acc[1][r]) * (1.f / 64.f) + EPSN);
                const float y0 = acc[0][r] * rinv * g0, y1 = acc[1][r] * rinv * g1;
                if (type == 1) { float* ko = F.out + OFF_KS + (size_t)(m - MP) * 512 + lc; ko[0] = y0; ko[32] = y1; }
                dst[(size_t)m * 512 + lc] = (bf16)f2bf(y0 * osc); dst[(size_t)m * 512 + lc + 32] = (bf16)f2bf(y1 * osc); }
        } else if (type == 3 || type == 4) {
            const int h = (n0 & 511) >> 7; const float l2g = __log2f(1.f - exp2f(-5.f - (float)h));
            float2 cs[16][2];
#pragma unroll
            for (int r = 0; r < 16; ++r) { const int ts = crow(r, hi);
#pragma unroll
                for (int nb = 0; nb < 2; ++nb) cs[r][nb] = *(const float2*)(rot + (size_t)(PAST + ts) * 128 + (((lc + 32 * nb) & 127) & ~1)); }
#pragma unroll
            for (int r = 0; r < 16; ++r) { const int m = m0 + crow(r, hi), ts = crow(r, hi);
                const float ksc = type == 4 ? 0.08838834764831845f * exp2f((float)(31 - ts) * l2g) : 1.f;
#pragma unroll
                for (int nb = 0; nb < 2; ++nb) { const float v = acc[nb][r], pv = __shfl_xor(v, 1);
                    const float c = cs[r][nb].x, sn = cs[r][nb].y;
                    const float y = (lane & 1) ? (pv * sn + v * c) : (v * c - pv * sn);
                    dst[(size_t)m * 512 + lc + 32 * nb] = (bf16)f2bf(y * ksc); } }
        } else {
#pragma unroll
            for (int r = 0; r < 16; ++r) { const int m = m0 + crow(r, hi);
#pragma unroll
                for (int nb = 0; nb < 2; ++nb) { float y = acc[nb][r];
                    if (type == 2) F.out[OFF_VS + (size_t)(m - MP) * 512 + lc + 32 * nb] = y;
                    if (type == 6) y = pg8::silu_f(y);
                    dst[(size_t)m * 512 + lc + 32 * nb] = (bf16)f2bf(y); } }
        }
    }
}
__device__ __forceinline__ void p3_sample(Frame& F, const bf16* OB, const bf16* Wout, bf16* XN2, const float* mod, float* rowss) {
    int tid = F.tid; asm volatile("" : "+v"(tid)); const int lane = tid & 63, r32 = lane & 31, hi = lane >> 5;
    const int gw = blockIdx.x + F.G * F.wave, NGW = F.G * NWAVES;
    for (int id = gw; id < 16 * (DM / 64); id += NGW) {
        const int cg = id >> 4, rt = id & 15, m0 = MP + 32 * rt, n0 = 64 * cg;
        f32x16 acc[2];
        int brow[2][4];
#pragma unroll
        for (int nb = 0; nb < 2; ++nb)
#pragma unroll
            for (int i = 0; i < 4; ++i) brow[nb][i] = dst_row(WOUT_MODE, n0 + 32 * nb + 8 * i + (lane >> 3));
        wave_mm<2>(acc, F.lds + F.wave * 12288, OB + (size_t)m0 * DM, DM, Wout, DM, brow, 0, DM, lane);
        const float* mb = mod + (size_t)(NBP + rt) * 6 * DM;
        float gt[2], gm[2];
#pragma unroll
        for (int nb = 0; nb < 2; ++nb) { const int col = n0 + 32 * nb + r32; gt[nb] = mb[2 * DM + col]; gm[nb] = F.A->in[10][col] * (1.f + mb[4 * DM + col]); }
        float xin[16][2];
#pragma unroll
        for (int r = 0; r < 16; ++r)
#pragma unroll
            for (int nb = 0; nb < 2; ++nb) xin[r][nb] = F.A->in[1][(size_t)(m0 + crow(r, hi) - MP) * DM + n0 + 32 * nb + r32];
#pragma unroll
        for (int r = 0; r < 16; ++r) { const int m = m0 + crow(r, hi); float ss = 0.f;
#pragma unroll
            for (int nb = 0; nb < 2; ++nb) { const int col = n0 + 32 * nb + r32;
                const float x1 = xin[r][nb] + gt[nb] * acc[nb][r];
                F.out[OFF_Y + (size_t)m * DM + col] = x1; XN2[(size_t)m * DM + col] = (bf16)f2bf(x1 * gm[nb]); ss += x1 * x1; }
            ss = half_sum(ss);
            if (r32 == 0) atomicAdd(rowss + m, ss); }
    }
}
__device__ __forceinline__ void p4_sample(Frame& F, const bf16* XN2, const bf16* Wgu, const float* rowss, const float* sbg, const float* sbu, bf16* H) {
    int tid = F.tid; asm volatile("" : "+v"(tid)); const int lane = tid & 63, r32 = lane & 31, hi = lane >> 5;
    const int gw = blockIdx.x + F.G * F.wave, NGW = F.G * NWAVES;
    for (int id = gw; id < 16 * (DFF / 32); id += NGW) {
        const int fg = id >> 4, rt = id & 15, m0 = MP + 32 * rt, f = 32 * fg + r32;
        f32x16 acc[2];
        int brow[2][4];
#pragma unroll
        for (int nb = 0; nb < 2; ++nb)
#pragma unroll
            for (int i = 0; i < 4; ++i) brow[nb][i] = dst_row(2 + nb, 32 * fg + 8 * i + (lane >> 3));
        wave_mm<2>(acc, F.lds + F.wave * 12288, XN2 + (size_t)m0 * DM, DM, Wgu, DM, brow, 0, DM, lane);
        const float bg = sbg[(size_t)(NBP + rt) * DFF + f], bu = sbu[(size_t)(NBP + rt) * DFF + f];
        float rsv[16];
#pragma unroll
        for (int r = 0; r < 16; ++r) rsv[r] = rowss[m0 + crow(r, hi)];
#pragma unroll
        for (int r = 0; r < 16; ++r) { const int m = m0 + crow(r, hi); const float rstd = rsqrtf(rsv[r] * (1.f / (float)DM) + EPSN);
            H[(size_t)m * DFF + f] = (bf16)f2bf(pg8::silu_f(acc[0][r] * rstd + bg) * (acc[1][r] * rstd + bu)); }
    }
}
__device__ __forceinline__ void p5_sample(Frame& F, const bf16* H, const bf16* Wdn, const float* mod) {
    int tid = F.tid; asm volatile("" : "+v"(tid)); const int lane = tid & 63, r32 = lane & 31, hi = lane >> 5;
    const int gw = blockIdx.x + F.G * F.wave, NGW = F.G * NWAVES;
    for (int id = gw; id < 16 * 4 * (DM / 64); id += NGW) {
        const int rt = id & 15, ksp = (id >> 4) & 3, cg = id >> 6, m0 = MP + 32 * rt, n0 = 64 * cg;
        f32x16 acc[2];
        int brow[2][4];
#pragma unroll
        for (int nb = 0; nb < 2; ++nb)
#pragma unroll
            for (int i = 0; i < 4; ++i) brow[nb][i] = dst_row(WOUT_MODE, n0 + 32 * nb + 8 * i + (lane >> 3));
        wave_mm<2>(acc, F.lds + F.wave * 12288, H + (size_t)m0 * DFF, DFF, Wdn, DFF, brow, ksp * (DFF / 4), (ksp + 1) * (DFF / 4), lane);
        const float* mb = mod + (size_t)(NBP + rt) * 6 * DM + 5 * DM;
#pragma unroll
        for (int nb = 0; nb < 2; ++nb) { const int col = n0 + 32 * nb + r32; const float gt = mb[col];
#pragma unroll
            for (int r = 0; r < 16; ++r) atomicAdd(F.out + OFF_Y + (size_t)(m0 + crow(r, hi)) * DM + col, gt * acc[nb][r]); }
    }
}
}

__global__ void __launch_bounds__(NWAVES * 64, 2) fwd_megakernel(Args args) {
    extern __shared__ __attribute__((aligned(16))) unsigned char lds[];
    Frame F;
    F.lds = (LAS unsigned char*)lds; F.MISC = (volatile LAS unsigned*)(F.lds + MISC_OFF);
    F.tid = threadIdx.x; F.lane = F.tid & 63; F.wave = __builtin_amdgcn_readfirstlane(F.tid >> 6); F.G = gridDim.x;
    F.A = &args;
    F.out = args.out; F.ws = args.ws; F.ctl = (gu32*)(args.ws + WS_CTL);
    for (int u = F.tid; u < (LDS_BYTES - LDSCTL_OFF) / 4; u += NWAVES * 64) ((LAS unsigned*)(F.lds + LDSCTL_OFF))[u] = 0u;
    __syncthreads();
    XcdBarrier bar = xcd_barrier_post((unsigned*)(F.ctl + CW_BAR), F.MISC + 8);

    bf16* act = (bf16*)(F.ws + WS_ACT); bf16* XN = (bf16*)(F.ws + WS_XN); bf16* OB = (bf16*)(F.ws + WS_OB); bf16* HB = (bf16*)(F.ws + WS_H);
    float* mod = (float*)(F.ws + WS_MOD); float* rowss = (float*)(F.ws + WS_ROWSS); float* sb2 = (float*)(F.ws + WS_SB2);

#ifndef PHM
#define PHM 127
#endif
    if (PHM & 1) p0a(F);
#ifdef PROBE_P0A
    xcd_barrier(bar); p0a(F, false);
#endif
    xcd_barrier(bar);
    if (PHM & 2) p0b(F);
#ifdef PROBE_P0B
    xcd_barrier(bar); p0b(F, false);
#endif
    xcd_barrier(bar);
    if (PHM & 4) {
        pg8::Gemm g{XN, (const bf16*)(F.ws + WS_WIN), MP, DIN, DM}; pg8::StaticOrder S; S.init(MP, DIN, F.G, (int)blockIdx.x);
        pg8::EpiIn E{act, F.out, F.A->in[12], F.A->in[13], (const float*)(F.ws + WS_ROT)};
        if (blockIdx.x & 1) { sg::p1_sample(F, XN, (const bf16*)(F.ws + WS_WIN), act); __syncthreads(); }
        pg8::gemm_phase<pg8::EpiIn, pg8::StaticOrder, true, true>(F.lds, g, S, E);
        if (!(blockIdx.x & 1)) sg::p1_sample(F, XN, (const bf16*)(F.ws + WS_WIN), act);
#ifdef PROBE_S
        __syncthreads(); sg::p1_sample(F, XN, (const bf16*)(F.ws + WS_WIN), act);
#endif
#ifdef PROBE_P1
        xcd_barrier(bar);
        pg8::gemm_phase<pg8::EpiIn, pg8::StaticOrder, true, true>(F.lds, g, S, E);
#endif
#ifdef PROBE_P1N
        xcd_barrier(bar);
        { pg8::EpiNull EN; pg8::gemm_phase<pg8::EpiNull, pg8::StaticOrder, true, true>(F.lds, g, S, EN); }
#endif
    }
    xcd_barrier(bar);
    if (PHM & 8) p2::phase2(F);
#ifdef PROBE_P2
    xcd_barrier(bar);
    p2::phase2(F, 1, PROBE_P2);
#endif
    xcd_barrier(bar);
    if (PHM & 16) {
        pg8::Gemm g{OB, (const bf16*)(F.ws + WS_WOUT), MP, DM, DM}; pg8::StaticOrder S; S.init(MP, DM, F.G, (int)blockIdx.x);
        pg8::EpiOut E{F.A->in[0], F.A->in[1], (bf16*)(F.ws + WS_X1B), XN, mod, (const float*)(F.ws + WS_GMOD2), rowss, 1.f};
        if (blockIdx.x & 1) { sg::p3_sample(F, OB, (const bf16*)(F.ws + WS_WOUT), XN, mod, rowss); __syncthreads(); }
        pg8::gemm_phase<pg8::EpiOut, pg8::StaticOrder, false, true>(F.lds, g, S, E);
#ifdef PROBE_P3
        xcd_barrier(bar);
        { pg8::EpiOut E2{F.A->in[0], F.A->in[1], (bf16*)(F.ws + WS_X1B), XN, mod, (const float*)(F.ws + WS_GMOD2), rowss, 0.f}; pg8::gemm_phase<pg8::EpiOut, pg8::StaticOrder, true, true>(F.lds, g, S, E2); }
#endif
        if (!(blockIdx.x & 1)) sg::p3_sample(F, OB, (const bf16*)(F.ws + WS_WOUT), XN, mod, rowss);
    }
    xcd_barrier(bar);
    if (PHM & 32) {
        pg8::Gemm g{XN, (const bf16*)(F.ws + WS_WGU), MP, NGU, DM}; pg8::StaticOrder S; S.init(MP, NGU, F.G, (int)blockIdx.x);
        pg8::EpiFF1 E{rowss, sb2, sb2 + (size_t)NBT * DFF, HB};
        if (blockIdx.x & 1) { sg::p4_sample(F, XN, (const bf16*)(F.ws + WS_WGU), rowss, sb2, sb2 + (size_t)NBT * DFF, HB); __syncthreads(); }
        pg8::gemm_phase<pg8::EpiFF1, pg8::StaticOrder, true, true>(F.lds, g, S, E);
        if (!(blockIdx.x & 1)) sg::p4_sample(F, XN, (const bf16*)(F.ws + WS_WGU), rowss, sb2, sb2 + (size_t)NBT * DFF, HB);
#ifdef PROBE_S
        __syncthreads(); sg::p4_sample(F, XN, (const bf16*)(F.ws + WS_WGU), rowss, sb2, sb2 + (size_t)NBT * DFF, HB);
#endif
#ifdef PROBE_P4
        xcd_barrier(bar);
        pg8::gemm_phase<pg8::EpiFF1, pg8::StaticOrder, true, true>(F.lds, g, S, E);
#endif
    }
    xcd_barrier(bar);
    if (PHM & 64) {
        pg8::Gemm g{HB, (const bf16*)(F.ws + WS_WDN), MP, DM, DFF}; pg8::StaticOrder S; S.init(MP, DM, F.G, (int)blockIdx.x);
        pg8::EpiFF2 E{F.out + OFF_Y, (const bf16*)(F.ws + WS_X1B), mod, 1.f};
        if (blockIdx.x & 1) { sg::p5_sample(F, HB, (const bf16*)(F.ws + WS_WDN), mod); __syncthreads(); }
        pg8::gemm_phase<pg8::EpiFF2, pg8::StaticOrder, false, true>(F.lds, g, S, E);
#ifdef PROBE_P5
        xcd_barrier(bar);
        { pg8::EpiFF2 E2{F.out + OFF_Y, (const bf16*)(F.ws + WS_X1B), mod, 1.f}; pg8::gemm_phase<pg8::EpiFF2, pg8::StaticOrder, true, true>(F.lds, g, S, E2); }
#endif
        if (!(blockIdx.x & 1)) sg::p5_sample(F, HB, (const bf16*)(F.ws + WS_WDN), mod);
    }
}

extern "C" void kernel_launch(void* const* d_in, const int* in_sizes, int n_in, void* d_out, int out_size, void* d_ws, size_t ws_size, hipStream_t stream) {
    static int grid = 0;
    if (grid == 0) {
        if (n_in != 24 || in_sizes[0] != MP * DM || (size_t)out_size != OUT_TOTAL || ws_size < WS_END) {
            fprintf(stderr, "kernel_launch: unexpected shapes: n_in %d in0 %d out %d ws %zu (need >= %zu)\n", n_in, n_in > 0 ? in_sizes[0] : -1, out_size, ws_size, (size_t)WS_END); grid = -1; return; }
        int dev = 0, cus = 0, per_cu = 0;
        if (hipGetDevice(&dev) != hipSuccess || hipDeviceGetAttribute(&cus, hipDeviceAttributeMultiprocessorCount, dev) != hipSuccess) { fprintf(stderr, "kernel_launch: device query failed\n"); grid = -1; return; }
        if (hipFuncSetAttribute((const void*)fwd_megakernel, hipFuncAttributeMaxDynamicSharedMemorySize, LDS_BYTES) != hipSuccess) { fprintf(stderr, "kernel_launch: hipFuncSetAttribute failed\n"); grid = -1; return; }
        if (hipOccupancyMaxActiveBlocksPerMultiprocessor(&per_cu, (const void*)fwd_megakernel, NWAVES * 64, LDS_BYTES) != hipSuccess || per_cu < 1) { fprintf(stderr, "kernel_launch: occupancy query says %d blocks/CU\n", per_cu); per_cu = 1; }
        (void)hipGetLastError();
        grid = cus;
    }
    if (grid < 0) return;
    if (hipMemsetAsync((char*)d_ws + WS_CTL, 0, CTL_ZERO_BYTES, stream) != hipSuccess) { fprintf(stderr, "kernel_launch: memset failed\n"); return; }
    Args a{};
    for (int i = 0; i < 24; ++i) a.in[i] = (const float*)d_in[i];
    a.out = (float*)d_out; a.ws = (unsigned char*)d_ws;
    void* kargs[] = {&a};
    hipError_t e = hipLaunchCooperativeKernel((const void*)fwd_megakernel, dim3(grid), dim3(NWAVES * 64), kargs, LDS_BYTES, stream);
    if (e != hipSuccess) fprintf(stderr, "kernel_launch: cooperative launch failed: %s (grid %d)\n", hipGetErrorString(e), grid);
}
```

```cpp
#include <hip/hip_runtime.h>
#include <hip/hip_bf16.h>
#include <cstdio>
#include <cstdint>
#include <cmath>

constexpr int DM = 1024, NBP = 4, SEQ = 8192, NBS = 16, LS = 32, PAST = 2048;
constexpr int MP = NBP * SEQ, MS = NBS * LS, MT = MP + MS;
constexpr int DIN = 3584, DFF = 2816, NGU = 2 * DFF, NBT = NBP + NBS;
constexpr float EPSN = 1e-6f;
constexpr float LOG2E = 1.4426950408889634f;
constexpr float QSCALE = 0.125f * LOG2E;
constexpr float LAM_INIT = 0.2f;
constexpr size_t OFF_Y = 0, OFF_KP = (size_t)MT * DM, OFF_VP = OFF_KP + (size_t)MP * 512, OFF_RP = OFF_VP + (size_t)MP * 512,
                 OFF_KS = OFF_RP + (size_t)NBP * 4 * 128 * 128, OFF_VS = OFF_KS + (size_t)MS * 512, OFF_RS = OFF_VS + (size_t)MS * 512,
                 OUT_TOTAL = OFF_RS + (size_t)NBS * 4 * 128 * 128;
__device__ __forceinline__ int row_batch(int row) { return row < MP ? (row >> 13) : NBP + ((row - MP) >> 5); }
__device__ __forceinline__ int row_pos(int row) { return row < MP ? (row & 8191) : PAST + ((row - MP) & 31); }

namespace pg8 {
#define PG8_LAS __attribute__((address_space(3)))
typedef unsigned short bf16_t;
typedef short bf16x8 __attribute__((ext_vector_type(8)));
typedef float f32x4 __attribute__((ext_vector_type(4)));
typedef unsigned u32x4 __attribute__((ext_vector_type(4)));
constexpr int BM = 256, BK = 64, HALF = 128, HTB = HALF * BK * 2  , STAGE_BYTES = 8 * HTB, NXCD = 8, WGM = 8;

__host__ __device__ __forceinline__ int lds_byte(int r, int c) { const int st = (r >> 4) * 2 + (c >> 5), rr = r & 15, cc = c & 31, ob = rr * 64 + cc * 2; return st * 1024 + (ob ^ (((ob >> 9) & 1) << 5)); }
__host__ __device__ __forceinline__ void stage_rc(int b, int& R, int& C) { const int st = b / 1024, sb = b % 1024, swz = sb ^ (((sb >> 9) & 1) << 5); R = (st >> 1) * 16 + swz / 64; C = (st & 1) * 32 + (swz % 64) / 2; }
__host__ __device__ __forceinline__ int perm32(int rho) { const int n = rho >> 4, i = rho & 15; return 8 * (i >> 2) + 4 * n + (i & 3); }

struct Unit { int pm, pn; };
struct Gemm { const bf16_t* A; const bf16_t* Bt; int M, N, K; };

struct StaticOrder {
    int nM, nN, nwg, G, c;
    __host__ __device__ void init(int M, int N, int G_, int c_) { nM = M / BM; nN = N / BM; nwg = nM * nN; G = G_; c = c_; }
    __host__ __device__ bool next(int i, Unit& u) const {
        const long L = (long)i * G + c; if (L >= nwg) return false;
        int wgid = (int)L; { const int q = nwg / NXCD, r = nwg % NXCD, xcd = wgid % NXCD, off = wgid / NXCD; wgid = (xcd < r ? xcd * (q + 1) : r * (q + 1) + (xcd - r) * q) + off; }
        const int nig = WGM * nN, gid = wgid / nig, fm = gid * WGM, gsz = (nM - fm) < WGM ? (nM - fm) : WGM;
        u.pm = fm + ((wgid % nig) % gsz); u.pn = (wgid % nig) / gsz; return true;
    }
    __device__ __forceinline__ void a_ready(const Unit&) const {}
    __device__ __forceinline__ void done(const Unit&) const {}
};

__device__ __forceinline__ unsigned cvt_pk_bf16(float lo, float hi) { unsigned r; asm volatile("v_cvt_pk_bf16_f32 %0, %1, %2" : "=v"(r) : "v"(lo), "v"(hi)); return r; }
typedef float f32x2 __attribute__((ext_vector_type(2)));
typedef unsigned u32x2 __attribute__((ext_vector_type(2)));
__device__ __forceinline__ void st_bf16x4(bf16_t* p, f32x4 v) { u32x2 w; w.x = cvt_pk_bf16(v[0], v[1]); w.y = cvt_pk_bf16(v[2], v[3]); *(u32x2*)p = w; }
__device__ __forceinline__ void st_bf16x8(bf16_t* p, f32x4 a, f32x4 c) { u32x4 w; w.x = cvt_pk_bf16(a[0], a[1]); w.y = cvt_pk_bf16(a[2], a[3]); w.z = cvt_pk_bf16(c[0], c[1]); w.w = cvt_pk_bf16(c[2], c[3]); *(u32x4*)p = w; }
__device__ __forceinline__ float silu_f(float z) { return z * __builtin_amdgcn_rcpf(1.f + __expf(-z)); }

struct EpiIn {
    static constexpr bool PERM = false, AFTER_DRAIN = false;
    bf16_t* act; float* out; const float* gq; const float* gk; const float* rot;
    __device__ __forceinline__ void operator()(const f32x4 (&acc)[2][2][4][2], const Unit& u, int wr, int wc, int fr, int fq) const {
        const int type = u.pn >> 1, half = u.pn & 1;
        const int lc0 = half * 256 + wc * 64 + fq * 8;
        bf16_t* dst = act + (size_t)type * ((size_t)MT * 512);
        const int rowb = u.pm * BM + wr * 64 + fr;
        if (type <= 1) {
            const float* g = type == 0 ? gq : gk; const float osc = type == 0 ? QSCALE : 1.f;
            f32x4 gv[2][2];
#pragma unroll
            for (int bj = 0; bj < 2; ++bj)
#pragma unroll
                for (int n = 0; n < 2; ++n) gv[bj][n] = *(const f32x4*)(g + bj * 32 + fq * 8 + n * 4);
#pragma unroll
            for (int ai = 0; ai < 2; ++ai)
#pragma unroll
                for (int m = 0; m < 4; ++m) {
                    const int row = rowb + ai * HALF + m * 16;
                    float ss = 0.f;
#pragma unroll
                    for (int bj = 0; bj < 2; ++bj)
#pragma unroll
                        for (int n = 0; n < 2; ++n) { const f32x4 v = acc[ai][bj][m][n]; ss += (v[0] * v[0] + v[1] * v[1]) + (v[2] * v[2] + v[3] * v[3]); }
                    ss += __shfl_xor(ss, 16); ss += __shfl_xor(ss, 32);
                    const float rinv = rsqrtf(ss * (1.f / 64.f) + EPSN);
                    float* ko = (row < MP ? out + OFF_KP + (size_t)row * 512 : out + OFF_KS + (size_t)(row - MP) * 512) + lc0;
                    bf16_t* bo = dst + (size_t)row * 512 + lc0;
#pragma unroll
                    for (int bj = 0; bj < 2; ++bj) { const f32x4 y0 = acc[ai][bj][m][0] * rinv * gv[bj][0], y1 = acc[ai][bj][m][1] * rinv * gv[bj][1];
                        if (type == 1) { __builtin_nontemporal_store(y0, (f32x4*)(ko + bj * 32)); __builtin_nontemporal_store(y1, (f32x4*)(ko + bj * 32 + 4));     }
                        st_bf16x8(bo + bj * 32, y0 * osc, y1 * osc); }
                }
        } else if (type == 2) {
#pragma unroll
            for (int ai = 0; ai < 2; ++ai)
#pragma unroll
                for (int m = 0; m < 4; ++m) {
                    const int row = rowb + ai * HALF + m * 16;
                    float* vo = (row < MP ? out + OFF_VP + (size_t)row * 512 : out + OFF_VS + (size_t)(row - MP) * 512) + lc0;
                    bf16_t* bo = dst + (size_t)row * 512 + lc0;
#pragma unroll
                    for (int bj = 0; bj < 2; ++bj) { const f32x4 y0 = acc[ai][bj][m][0], y1 = acc[ai][bj][m][1];
                        __builtin_nontemporal_store(y0, (f32x4*)(vo + bj * 32)); __builtin_nontemporal_store(y1, (f32x4*)(vo + bj * 32 + 4)); st_bf16x8(bo + bj * 32, y0, y1); }
                }
        } else if (type == 3 || type == 4) {
            const int h = half * 2 + (wc >> 1);
            const float l2g = __log2f(1.f - exp2f(-5.f - (float)h));
#pragma unroll
            for (int ai = 0; ai < 2; ++ai) {
                f32x4 cs[4][2][2];
#pragma unroll
                for (int m = 0; m < 4; ++m) { const float* rp = rot + (size_t)row_pos(rowb + ai * HALF + m * 16) * 128;
#pragma unroll
                    for (int bj = 0; bj < 2; ++bj)
#pragma unroll
                        for (int n = 0; n < 2; ++n) cs[m][bj][n] = *(const f32x4*)(rp + ((lc0 + bj * 32 + n * 4) & 127)); }
#pragma unroll
                for (int m = 0; m < 4; ++m) {
                    const int row = rowb + ai * HALF + m * 16;
                    float ksc = 1.f;
                    if (type == 4) { const int e = row < MP ? 63 - (row & 63) : 31 - ((row - MP) & 31); ksc = 0.08838834764831845f * exp2f((float)e * l2g); }
                    bf16_t* bo = dst + (size_t)row * 512 + lc0;
#pragma unroll
                    for (int bj = 0; bj < 2; ++bj) { f32x4 y[2];
#pragma unroll
                        for (int n = 0; n < 2; ++n) { const f32x4 c4 = cs[m][bj][n]; const f32x4 v = acc[ai][bj][m][n];
                            y[n][0] = v[0] * c4[0] - v[1] * c4[1]; y[n][1] = v[0] * c4[1] + v[1] * c4[0]; y[n][2] = v[2] * c4[2] - v[3] * c4[3]; y[n][3] = v[2] * c4[3] + v[3] * c4[2]; }
                        st_bf16x8(bo + bj * 32, y[0] * ksc, y[1] * ksc); }
                }
            }
        } else {
#pragma unroll
            for (int ai = 0; ai < 2; ++ai)
#pragma unroll
                for (int m = 0; m < 4; ++m) {
                    const int row = rowb + ai * HALF + m * 16;
                    bf16_t* bo = dst + (size_t)row * 512 + lc0;
#pragma unroll
                    for (int bj = 0; bj < 2; ++bj) { f32x4 y[2];
#pragma unroll
                        for (int n = 0; n < 2; ++n) { y[n] = acc[ai][bj][m][n];
                            if (type == 6) { y[n][0] = silu_f(y[n][0]); y[n][1] = silu_f(y[n][1]); y[n][2] = silu_f(y[n][2]); y[n][3] = silu_f(y[n][3]); } }
                        st_bf16x8(bo + bj * 32, y[0], y[1]); }
                }
        }
    }
};

struct EpiOut {
    static constexpr bool PERM = false, AFTER_DRAIN = false;
    const float* xp; const float* xs; bf16_t* x1b; bf16_t* xn2; const float* mod; const float* gmod2; float* rowss; float psc;
    __device__ __forceinline__ void operator()(const f32x4 (&acc)[2][2][4][2], const Unit& u, int wr, int wc, int fr, int fq) const {
        const int col0 = u.pn * BM + wc * 32 + 8 * fq, rowb = u.pm * BM + wr * 64 + fr;
        const int b = (u.pm * BM) >> 13;
        const float* mb = mod + (size_t)b * (6 * DM) + 2 * DM + col0; const float* gm = gmod2 + (size_t)b * DM + col0;
        f32x4 gt[2][2], gg[2][2];
#pragma unroll
        for (int bj = 0; bj < 2; ++bj)
#pragma unroll
            for (int n = 0; n < 2; ++n) { gt[bj][n] = *(const f32x4*)(mb + bj * HALF + n * 4); gg[bj][n] = *(const f32x4*)(gm + bj * HALF + n * 4); }
#pragma unroll
        for (int am = 0; am < 4; ++am) { const int ai = am >> 1;
            f32x4 xv[2][2][2];
#pragma unroll
            for (int mm = 0; mm < 2; ++mm) { const float* xr = xp + (size_t)(rowb + ai * HALF + ((am & 1) * 2 + mm) * 16) * DM + col0;
#pragma unroll
                for (int bj = 0; bj < 2; ++bj)
#pragma unroll
                    for (int n = 0; n < 2; ++n) xv[mm][bj][n] = __builtin_nontemporal_load((const f32x4*)(xr + bj * HALF + n * 4)); }
#pragma unroll
            for (int mm = 0; mm < 2; ++mm) { const int m = (am & 1) * 2 + mm;
                const int row = rowb + ai * HALF + m * 16;
                bf16_t* yo = x1b + (size_t)row * DM + col0; bf16_t* no = xn2 + (size_t)row * DM + col0;
                float ss = 0.f;
#pragma unroll
                for (int bj = 0; bj < 2; ++bj) { f32x4 x1[2];
#pragma unroll
                    for (int n = 0; n < 2; ++n) { const int o = bj * HALF + n * 4;
                        x1[n] = xv[mm][bj][n] + gt[bj][n] * acc[ai][bj][m][n];
                        ss += (x1[n][0] * x1[n][0] + x1[n][1] * x1[n][1]) + (x1[n][2] * x1[n][2] + x1[n][3] * x1[n][3]); }
                    { u32x4 w_; w_.x = cvt_pk_bf16(x1[0][0], x1[0][1]); w_.y = cvt_pk_bf16(x1[0][2], x1[0][3]); w_.z = cvt_pk_bf16(x1[1][0], x1[1][1]); w_.w = cvt_pk_bf16(x1[1][2], x1[1][3]); __builtin_nontemporal_store(w_, (u32x4*)(yo + bj * HALF)); }
                    st_bf16x8(no + bj * HALF, x1[0] * gg[bj][0], x1[1] * gg[bj][1]); }
                ss += __shfl_xor(ss, 16); ss += __shfl_xor(ss, 32);
                if (fq == 0) atomicAdd(rowss + row, ss * psc);
            }
            asm volatile("" ::: "memory");
        }
    }
};

struct EpiFF1 {
    static constexpr bool PERM = false, AFTER_DRAIN = false;
    const float* rowss; const float* sbg; const float* sbu; bf16_t* H;
    __device__ __forceinline__ void operator()(const f32x4 (&acc)[2][2][4][2], const Unit& u, int wr, int wc, int fr, int fq) const {
        const int f0 = u.pn * 128 + wc * 32 + fq * 8, rowb = u.pm * BM + wr * 64 + fr;
        const int b = (u.pm * BM) >> 13;
        f32x4 bg[2], bu[2]; float rs[2][4];
#pragma unroll
        for (int n = 0; n < 2; ++n) { bg[n] = *(const f32x4*)(sbg + (size_t)b * DFF + f0 + n * 4); bu[n] = *(const f32x4*)(sbu + (size_t)b * DFF + f0 + n * 4); }
#pragma unroll
        for (int ai = 0; ai < 2; ++ai)
#pragma unroll
            for (int m = 0; m < 4; ++m) rs[ai][m] = rowss[rowb + ai * HALF + m * 16];
#pragma unroll
        for (int ai = 0; ai < 2; ++ai)
#pragma unroll
            for (int m = 0; m < 4; ++m) {
                const int row = rowb + ai * HALF + m * 16;
                const float rstd = rsqrtf(rs[ai][m] * (1.f / (float)DM) + EPSN);
                u32x2 w2[2];
#pragma unroll
                for (int n = 0; n < 2; ++n) {
                    const f32x4 hg = acc[ai][0][m][n] * rstd + bg[n];
                    const f32x4 hu = acc[ai][1][m][n] * rstd + bu[n];
                    w2[n].x = cvt_pk_bf16(silu_f(hg[0]) * hu[0], silu_f(hg[1]) * hu[1]); w2[n].y = cvt_pk_bf16(silu_f(hg[2]) * hu[2], silu_f(hg[3]) * hu[3]); }
                u32x4 w4; w4.x = w2[0].x; w4.y = w2[0].y; w4.z = w2[1].x; w4.w = w2[1].y;
                *(u32x4*)(H + (size_t)row * DFF + f0) = w4;
            }
    }
};

struct EpiFF2 {
    static constexpr bool PERM = false, AFTER_DRAIN = false;
    float* y; const bf16_t* x1b; const float* mod; float psc;
    __device__ __forceinline__ void operator()(const f32x4 (&acc)[2][2][4][2], const Unit& u, int wr, int wc, int fr, int fq) const {
        const int col0 = u.pn * BM + wc * 32 + 8 * fq, rowb = u.pm * BM + wr * 64 + fr;
        const float* mb = mod + (size_t)((u.pm * BM) >> 13) * (6 * DM) + 5 * DM + col0;
        f32x4 gt[2][2];
#pragma unroll
        for (int bj = 0; bj < 2; ++bj)
#pragma unroll
            for (int n = 0; n < 2; ++n) gt[bj][n] = *(const f32x4*)(mb + bj * HALF + n * 4) * psc;
#pragma unroll
        for (int ai = 0; ai < 2; ++ai) {
            u32x4 xv[4][2];
#pragma unroll
            for (int m = 0; m < 4; ++m) { const bf16_t* xr = x1b + (size_t)(rowb + ai * HALF + m * 16) * DM + col0;
#pragma unroll
                for (int bj = 0; bj < 2; ++bj) xv[m][bj] = __builtin_nontemporal_load((const u32x4*)(xr + bj * HALF)); }
#pragma unroll
            for (int m = 0; m < 4; ++m) { float* yo = y + (size_t)(rowb + ai * HALF + m * 16) * DM + col0;
#pragma unroll
                for (int bj = 0; bj < 2; ++bj) { const u32x4 w = xv[m][bj];
                    f32x4 x0, x1;
                    x0[0] = __uint_as_float(w.x << 16); x0[1] = __uint_as_float(w.x & 0xffff0000u); x0[2] = __uint_as_float(w.y << 16); x0[3] = __uint_as_float(w.y & 0xffff0000u);
                    x1[0] = __uint_as_float(w.z << 16); x1[1] = __uint_as_float(w.z & 0xffff0000u); x1[2] = __uint_as_float(w.w << 16); x1[3] = __uint_as_float(w.w & 0xffff0000u);
                    __builtin_nontemporal_store(x0 + gt[bj][0] * acc[ai][bj][m][0], (f32x4*)(yo + bj * HALF));
                    __builtin_nontemporal_store(x1 + gt[bj][1] * acc[ai][bj][m][1], (f32x4*)(yo + bj * HALF + 4)); } }
            asm volatile("" ::: "memory");
        }
    }
};

struct EpiNull {
    static constexpr bool PERM = false, AFTER_DRAIN = false;
    __device__ __forceinline__ void operator()(const f32x4 (&acc)[2][2][4][2], const Unit& u, int wr, int wc, int fr, int fq) const {
#pragma unroll
        for (int ai = 0; ai < 2; ++ai)
#pragma unroll
            for (int bj = 0; bj < 2; ++bj)
#pragma unroll
                for (int m = 0; m < 4; ++m)
#pragma unroll
                    for (int n = 0; n < 2; ++n) asm volatile("" :: "v"(acc[ai][bj][m][n]));
    }
};
template <class Epi, class Sched, bool ALIGN_EPI = false, bool SP2 = false>
__device__ __forceinline__ void gemm_phase(PG8_LAS unsigned char* lds, const Gemm g, const Sched& S, const Epi& E) {
    int tid = threadIdx.x; asm volatile("" : "+v"(tid));
    const int wid = __builtin_amdgcn_readfirstlane(tid >> 6), lane = tid & 63, wr = wid >> 2, wc = wid & 3, fr = lane & 15, fq = lane >> 4;
    const int K = g.K, nt = K / BK;
    unsigned voffA[2], voffB[2];
#pragma unroll
    for (int i = 0; i < 2; ++i) { int R, C; stage_rc(tid * 16 + i * 8192, R, C); const int Rb = Epi::PERM ? ((R & ~31) + perm32(R & 31)) : R;
        voffA[i] = (unsigned)(R * K + C) * 2u; voffB[i] = (unsigned)(Rb * K + C) * 2u; }
    const size_t kstep = (size_t)(BK * 2);
    const size_t hstep = (size_t)HALF * K * 2;
    const size_t tstep = 2 * hstep;
    const unsigned ldsw = (unsigned)wid * 1024u;
    const int aoff = lds_byte(wr * 64 + fr, fq * 8), boff = lds_byte(wc * 32 + fr, fq * 8);
#define PG8_SA(b, h) (((b) * 2 + (h)) * HTB)
#define PG8_SB(b, h) ((4 + (b) * 2 + (h)) * HTB)
#define PG8_STAGE(bufoff, gbase, voff) do { _Pragma("unroll") for (int _i = 0; _i < 2; ++_i) \
        __builtin_amdgcn_global_load_lds((const unsigned*)((const char*)(gbase) + (voff)[_i]), (PG8_LAS unsigned*)(lds + (bufoff) + ldsw + _i * 8192), 16, 0, 0); } while (0)
#define PG8_LDA(dst, b, h) do { _Pragma("unroll") for (int m = 0; m < 4; ++m) _Pragma("unroll") for (int k = 0; k < 2; ++k) dst[m][k] = *(const PG8_LAS bf16x8*)(lds + PG8_SA(b, h) + aoff + m * 2048 + k * 1024); } while (0)
#define PG8_LDB(dst, b, h) do { _Pragma("unroll") for (int n = 0; n < 2; ++n) _Pragma("unroll") for (int k = 0; k < 2; ++k) dst[n][k] = *(const PG8_LAS bf16x8*)(lds + PG8_SB(b, h) + boff + n * 2048 + k * 1024); } while (0)
#define PG8_MMA(ai, bj, At, Bt) do { __builtin_amdgcn_s_setprio(1); _Pragma("unroll") for (int m = 0; m < 4; ++m) _Pragma("unroll") for (int n = 0; n < 2; ++n) _Pragma("unroll") for (int k = 0; k < 2; ++k) \
        acc[ai][bj][m][n] = __builtin_amdgcn_mfma_f32_16x16x32_bf16(Bt[n][k], At[m][k], acc[ai][bj][m][n], 0, 0, 0); __builtin_amdgcn_s_setprio(0); } while (0)
#define PG8_WAIT_V(n) asm volatile("s_waitcnt vmcnt(" #n ")" ::: "memory")
#define PG8_WAIT_L(n) asm volatile("s_waitcnt lgkmcnt(" #n ")" ::: "memory")
#define PG8_BAR __builtin_amdgcn_s_barrier()
#define PG8_SCHED __builtin_amdgcn_sched_barrier(0)
    Unit cur, nxt; int ui = 0;
    if (!S.next(0, cur)) return;
    f32x4 acc[2][2][4][2];
#pragma unroll
    for (int a = 0; a < 2; ++a)
#pragma unroll
        for (int b = 0; b < 2; ++b)
#pragma unroll
            for (int m = 0; m < 4; ++m)
#pragma unroll
                for (int n = 0; n < 2; ++n) acc[a][b][m][n] = (f32x4){0.f, 0.f, 0.f, 0.f};
    bf16x8 At[4][2], B0[2][2], B1[2][2];
    const char* cA = (const char*)g.A + (size_t)cur.pm * tstep; const char* cB = (const char*)g.Bt + (size_t)cur.pn * tstep;
    S.a_ready(cur);
    if constexpr (SP2) {
        PG8_STAGE(PG8_SB(0, 0), cB, voffB); PG8_STAGE(PG8_SB(0, 1), cB + hstep, voffB); PG8_STAGE(PG8_SA(0, 0), cA, voffA); PG8_STAGE(PG8_SA(0, 1), cA + hstep, voffA);
        if (wr == 1) PG8_BAR;
        PG8_WAIT_V(2); PG8_BAR;
        PG8_STAGE(PG8_SB(1, 0), cB + kstep, voffB); PG8_STAGE(PG8_SA(1, 0), cA + kstep, voffA); PG8_STAGE(PG8_SB(1, 1), cB + hstep + kstep, voffB);
        PG8_WAIT_V(6); PG8_BAR;
    } else {
        PG8_STAGE(PG8_SB(0, 0), cB, voffB); PG8_STAGE(PG8_SA(0, 0), cA, voffA); PG8_STAGE(PG8_SB(0, 1), cB + hstep, voffB); PG8_STAGE(PG8_SA(0, 1), cA + hstep, voffA);
        if (wr == 1) PG8_BAR;
        PG8_WAIT_V(4); PG8_BAR;
        PG8_STAGE(PG8_SB(1, 0), cB + kstep, voffB); PG8_STAGE(PG8_SA(1, 0), cA + kstep, voffA); PG8_STAGE(PG8_SB(1, 1), cB + hstep + kstep, voffB);
        PG8_WAIT_V(6); PG8_BAR;
    }
    for (;;) {
        const bool has_next = S.next(ui + 1, nxt);
        const char* nA = has_next ? (const char*)g.A + (size_t)nxt.pm * tstep : cA; const char* nB = has_next ? (const char*)g.Bt + (size_t)nxt.pn * tstep : cB;
        for (int t = 0; t < nt; t += 2) {
            const bool last = (t == nt - 2);
            const char* a1 = cA + (size_t)(t + 1) * kstep;
            const char* a2 = last ? nA : cA + (size_t)(t + 2) * kstep; const char* b2 = last ? nB : cB + (size_t)(t + 2) * kstep;
            const char* a3 = a2 + kstep; const char* b3 = b2 + kstep;
            if (last && has_next) S.a_ready(nxt);
            if constexpr (SP2) {
            PG8_LDB(B0, 0, 0); PG8_LDB(B1, 0, 1); PG8_SCHED; PG8_LDA(At, 0, 0); PG8_STAGE(PG8_SA(1, 1), a1 + hstep, voffA);
            PG8_WAIT_V(8); PG8_WAIT_L(0); PG8_BAR; PG8_MMA(0, 0, At, B0); PG8_MMA(0, 1, At, B1); PG8_BAR; PG8_SCHED;
            PG8_LDA(At, 0, 1); PG8_STAGE(PG8_SB(0, 0), b2, voffB); PG8_STAGE(PG8_SB(0, 1), b2 + hstep, voffB); PG8_STAGE(PG8_SA(0, 0), a2, voffA);
            PG8_WAIT_V(8); PG8_WAIT_L(0); PG8_BAR; PG8_MMA(1, 0, At, B0); PG8_MMA(1, 1, At, B1); PG8_BAR; PG8_SCHED;
            PG8_LDB(B0, 1, 0); PG8_LDB(B1, 1, 1); PG8_SCHED; PG8_LDA(At, 1, 0); PG8_STAGE(PG8_SA(0, 1), a2 + hstep, voffA);
            PG8_WAIT_V(8); PG8_WAIT_L(0); PG8_BAR; PG8_MMA(0, 0, At, B0); PG8_MMA(0, 1, At, B1); PG8_BAR; PG8_SCHED;
            PG8_LDA(At, 1, 1); PG8_STAGE(PG8_SB(1, 0), b3, voffB); PG8_STAGE(PG8_SB(1, 1), b3 + hstep, voffB); PG8_STAGE(PG8_SA(1, 0), a3, voffA);
            PG8_WAIT_V(8); PG8_WAIT_L(0); PG8_BAR; PG8_MMA(1, 0, At, B0); PG8_MMA(1, 1, At, B1); PG8_BAR; PG8_SCHED;
            } else {
            PG8_LDB(B0, 0, 0); PG8_SCHED; PG8_LDA(At, 0, 0); PG8_STAGE(PG8_SA(1, 1), a1 + hstep, voffA);
            PG8_WAIT_L(8); PG8_BAR; PG8_WAIT_L(0); PG8_MMA(0, 0, At, B0); PG8_BAR; PG8_SCHED;
            PG8_LDB(B1, 0, 1); PG8_STAGE(PG8_SB(0, 0), b2, voffB);
            PG8_BAR; PG8_WAIT_L(0); PG8_MMA(0, 1, At, B1); PG8_BAR;
            PG8_LDA(At, 0, 1); PG8_STAGE(PG8_SA(0, 0), a2, voffA);
            PG8_BAR; PG8_WAIT_L(0); PG8_MMA(1, 0, At, B0); PG8_BAR; PG8_SCHED;
            PG8_STAGE(PG8_SB(0, 1), b2 + hstep, voffB);
            PG8_WAIT_V(6); PG8_BAR; PG8_MMA(1, 1, At, B1); PG8_BAR;
            PG8_LDB(B0, 1, 0); PG8_SCHED; PG8_LDA(At, 1, 0); PG8_STAGE(PG8_SA(0, 1), a2 + hstep, voffA);
            PG8_WAIT_L(8); PG8_BAR; PG8_WAIT_L(0); PG8_MMA(0, 0, At, B0); PG8_BAR; PG8_SCHED;
            PG8_LDB(B1, 1, 1); PG8_STAGE(PG8_SB(1, 0), b3, voffB);
            PG8_BAR; PG8_WAIT_L(0); PG8_MMA(0, 1, At, B1); PG8_BAR;
            PG8_LDA(At, 1, 1); PG8_STAGE(PG8_SA(1, 0), a3, voffA);
            PG8_BAR; PG8_WAIT_L(0); PG8_MMA(1, 0, At, B0); PG8_BAR; PG8_SCHED;
            PG8_STAGE(PG8_SB(1, 1), b3 + hstep, voffB);
            PG8_WAIT_V(6); PG8_BAR; PG8_MMA(1, 1, At, B1); PG8_BAR;
            }
        }
        if constexpr (ALIGN_EPI) { if (wr == 0) PG8_BAR; }
        if constexpr (!Epi::AFTER_DRAIN) { E(acc, cur, wr, wc, fr, fq); S.done(cur); }
        if (!has_next) break;
#pragma unroll
        for (int a = 0; a < 2; ++a)
#pragma unroll
            for (int b = 0; b < 2; ++b)
#pragma unroll
                for (int m = 0; m < 4; ++m)
#pragma unroll
                    for (int n = 0; n < 2; ++n) acc[a][b][m][n] = (f32x4){0.f, 0.f, 0.f, 0.f};
        cur = nxt; cA = nA; cB = nB; ++ui;
        if constexpr (ALIGN_EPI) { if (wr == 1) PG8_BAR; }
    }
    PG8_WAIT_V(0);
    if constexpr (!ALIGN_EPI) { if (wr == 0) PG8_BAR; }
    PG8_BAR;
    if constexpr (Epi::AFTER_DRAIN) { E.fused(acc, cur, wr, wc, fr, fq, lds, wid, lane); S.done(cur); }
#undef PG8_SA
#undef PG8_SB
#undef PG8_STAGE
#undef PG8_LDA
#undef PG8_LDB
#undef PG8_MMA
#undef PG8_WAIT_V
#undef PG8_WAIT_L
#undef PG8_BAR
#undef PG8_SCHED
}
}
#define GAS __attribute__((address_space(1)))
#define LAS __attribute__((address_space(3)))
typedef unsigned short bf16;
typedef unsigned v4u __attribute__((ext_vector_type(4)));
typedef float f32x4 __attribute__((ext_vector_type(4)));
typedef short bf16x8 __attribute__((ext_vector_type(8)));
typedef GAS unsigned gu32;
typedef GAS unsigned long long gu64;
#define RLX_AGENT __ATOMIC_RELAXED, __HIP_MEMORY_SCOPE_AGENT
#define LDS_WAIT() asm volatile("s_waitcnt lgkmcnt(0)" ::: "memory")
#define VM_WAIT() asm volatile("s_waitcnt vmcnt(0)" ::: "memory")
__device__ __forceinline__ unsigned long long rt() { return __builtin_amdgcn_s_memrealtime(); }
__device__ __forceinline__ unsigned f2bf(float f) { unsigned u = __builtin_bit_cast(unsigned, f); return (u + 0x7fffu + ((u >> 16) & 1u)) >> 16; }
__device__ __forceinline__ unsigned pk2(float lo, float hi) { return f2bf(lo) | (f2bf(hi) << 16); }

#define XB_TMO      128
#define XB_XCNT(j)  (256  + 64 * (j))
#define XB_XSUB(j)  (1280 + 64 * (j))
#define XB_XGEN(j)  (2304 + 64 * (j))
#define XB_TOP      3328
#define XB_TOPGEN   3392
#define XCD_BAR_WORDS 3456
#define XB_SPIN_CAP (1u << 18)

__device__ __forceinline__ unsigned xb_ld(unsigned* p)              { return __hip_atomic_load(p, __ATOMIC_RELAXED, __HIP_MEMORY_SCOPE_AGENT); }
__device__ __forceinline__ unsigned xb_add(unsigned* p, unsigned v) { return __hip_atomic_fetch_add(p, v, __ATOMIC_RELAXED, __HIP_MEMORY_SCOPE_AGENT); }
__device__ __forceinline__ unsigned xb_xcc_id() { return (unsigned)__builtin_amdgcn_s_getreg((3 << 11) | 20) & 0xFu; }
#define XB_SPIN(cond, bar) do { unsigned _sp = 0; while (cond) { __builtin_amdgcn_s_sleep(1); \
    if ((++_sp & 255u) == 0u) { if (xb_ld(&(bar)[XB_TMO])) break; if (_sp > XB_SPIN_CAP) { atomicAdd(&(bar)[XB_TMO], 1u); break; } } } } while (0)

struct XcdBarrier {
    unsigned* bar; unsigned x;
    volatile LAS unsigned* st;
};

__device__ __forceinline__ XcdBarrier xcd_barrier_post(unsigned* bar, volatile LAS unsigned* st) {
    XcdBarrier b; b.bar = bar; b.x = xb_xcc_id(); b.st = st;
    if (threadIdx.x == 0) (void)xb_add(&bar[XB_XCNT(b.x)], 1u);
    return b;
}
__device__ __forceinline__ void xcd_barrier_complete(unsigned* bar, unsigned x, unsigned& nloc, unsigned& nx) {
    const unsigned G = gridDim.x * gridDim.y * gridDim.z;
    unsigned sum, cnt, mine, sp = 0u;
    for (;;) {
        sum = 0u; cnt = 0u; mine = 0u;
#pragma unroll
        for (unsigned j = 0; j < 16; ++j) { const unsigned c = xb_ld(&bar[XB_XCNT(j)]); sum += c; cnt += (c > 0u) ? 1u : 0u; mine = (j == x) ? c : mine; }
        if (sum == G) break;
        __builtin_amdgcn_s_sleep(1);
        if ((++sp & 255u) == 0u) { if (xb_ld(&bar[XB_TMO])) break; if (sp > XB_SPIN_CAP) { atomicAdd(&bar[XB_TMO], 1u); break; } }
    }
    nloc = mine > 0u ? mine : 1u; nx = cnt > 0u ? cnt : 1u;
}

__device__ __forceinline__ void xcd_barrier(const XcdBarrier& b) {
    asm volatile("s_waitcnt vmcnt(0)" ::: "memory");
    __syncthreads();
    if (threadIdx.x == 0) {
        unsigned* bar = b.bar;
        __builtin_amdgcn_s_waitcnt(0);
        unsigned nloc = b.st[0], nx = b.st[1];
        if (nloc == 0u) { xcd_barrier_complete(bar, b.x, nloc, nx); b.st[0] = nloc; b.st[1] = nx; }
        const unsigned old = xb_add(&bar[XB_XSUB(b.x)], 1u);
        const unsigned gen = old / nloc;
        if (old + 1u == (gen + 1u) * nloc) {
            __builtin_amdgcn_fence(__ATOMIC_RELEASE, "agent");
            asm volatile("s_waitcnt vmcnt(0)" ::: "memory");
            const unsigned og = xb_add(&bar[XB_TOP], 1u);
            const unsigned tg = og / nx;
            if (og + 1u == (tg + 1u) * nx) xb_add(&bar[XB_TOPGEN], 1u);
            else XB_SPIN(xb_ld(&bar[XB_TOPGEN]) == tg, bar);
            __builtin_amdgcn_fence(__ATOMIC_ACQUIRE, "agent");
            xb_add(&bar[XB_XGEN(b.x)], 1u);
            asm volatile("s_waitcnt vmcnt(0)" ::: "memory");
        } else {
            XB_SPIN(xb_ld(&bar[XB_XGEN(b.x)]) == gen, bar);
            __builtin_amdgcn_fence(__ATOMIC_ACQUIRE, "agent");
            asm volatile("s_waitcnt vmcnt(0)" ::: "memory");
        }
    }
    __syncthreads();
}

constexpr size_t MiB = 1u << 20;
constexpr size_t WS_CTL = 0, CTL_ZERO_BYTES = 2 * MiB;
constexpr size_t WS_ROWSS = 256 * 1024, WS_MOD = 512 * 1024, WS_SB2 = 1 * MiB, WS_GMOD2 = 1536 * 1024;
constexpr size_t WS_ROT = 2 * MiB, WS_WIN = 6 * MiB, WS_WOUT = 13 * MiB, WS_WGU = 15 * MiB, WS_WDN = 26 * MiB;
constexpr size_t WS_XN = 32 * MiB, WS_OB = 97 * MiB, WS_ACT = 162 * MiB, WS_H = WS_ACT, WS_E = 390 * MiB, WS_X1B = 398 * MiB, WS_END = 463 * MiB;
constexpr size_t ACT_STRIDE = (size_t)MT * 512;
static_assert(WS_ROWSS + (size_t)MT * 4 <= WS_MOD && WS_MOD + (size_t)NBT * 6 * DM * 4 <= WS_SB2 && WS_SB2 + (size_t)2 * NBT * DFF * 4 <= WS_GMOD2 && WS_GMOD2 + (size_t)NBT * DM * 4 <= CTL_ZERO_BYTES, "ctl map");
static_assert(WS_WIN + (size_t)DIN * DM * 2 <= WS_WOUT && WS_WGU + (size_t)NGU * DM * 2 <= WS_WDN && WS_WDN + (size_t)DM * DFF * 2 <= WS_XN, "weights map");
static_assert(WS_XN + (size_t)MT * DM * 2 <= WS_OB && WS_OB + (size_t)MT * DM * 2 <= WS_ACT && WS_ACT + 7 * ACT_STRIDE * 2 <= WS_E && WS_X1B + (size_t)MP * DM * 2 <= WS_END && WS_H + (size_t)MT * DFF * 2 <= WS_END, "act map");
constexpr int CW_BAR = 4096;
constexpr int CW_QUEUE = 16384;
constexpr int CW_CNTA = 20480;
constexpr int RING_BYTES = 131072, LDSCTL_OFF = RING_BYTES, MISC_OFF = LDSCTL_OFF + 320;
constexpr int TAB_OFF = 132096, CB_OFF = TAB_OFF + 4096, WSC_OFF = CB_OFF + 64, QSLOT_OFF = WSC_OFF + 8 * 256, LDS_BYTES = 147456;
static_assert(QSLOT_OFF + 64 <= LDS_BYTES && MISC_OFF + 128 <= TAB_OFF, "LDS map");
constexpr int NWAVES = 8;
constexpr int WOUT_MODE = 4;

struct Args { const float* in[24]; float* out; unsigned char* ws; };
struct Frame {
    LAS unsigned char* lds; volatile LAS unsigned* MISC; gu32* ctl; int tid, lane, wave, G;
    const Args* A; float* out; unsigned char* ws;
};

__device__ __forceinline__ int dst_row(int mode, int n) {
    if (mode == 0) return n;
    if (mode == 1) { const int l = n & 255;
        return (n & ~255) + 128 * ((l >> 5) & 1) + 32 * (l >> 6) + 16 * ((l >> 2) & 1) + 4 * ((l >> 3) & 3) + (l & 3); }
    if (mode == 4) { const int l = n & 127;
        return (n & ~127) + 32 * (l >> 5) + 16 * ((l >> 2) & 1) + 4 * ((l >> 3) & 3) + (l & 3); }
    const int fl = n & 127;
    return (n >> 7) * 256 + 128 * (mode - 2) + 32 * (fl >> 5) + 16 * ((fl >> 2) & 1) + 4 * ((fl >> 3) & 3) + (fl & 3);
}
__device__ __forceinline__ void p0_transpose_item(const float* W, int K, int N, bf16* WT, int mode, LAS float* scr, int item, int lane) {
    const int nblk = N / 32, kb = item / nblk, nb = item % nblk, k0 = 64 * kb, n0 = 32 * nb;
#pragma unroll
    for (int i = 0; i < 32; ++i) { const int kk = 2 * i + (lane >> 5); scr[kk * 33 + (lane & 31)] = __builtin_nontemporal_load(W + (size_t)(k0 + kk) * N + n0 + (lane & 31)); }
    LDS_WAIT(); asm volatile("" ::: "memory");
    const int c = lane & 7;
#pragma unroll
    for (int j = 0; j < 4; ++j) { const int n = (lane >> 3) + 8 * j; const LAS float* s = scr + (8 * c) * 33 + n;
        v4u o; o.x = pk2(s[0 * 33], s[1 * 33]); o.y = pk2(s[2 * 33], s[3 * 33]); o.z = pk2(s[4 * 33], s[5 * 33]); o.w = pk2(s[6 * 33], s[7 * 33]);
        *(GAS v4u*)(WT + (size_t)dst_row(mode, n0 + n) * K + k0 + 8 * c) = o; }
    LDS_WAIT(); asm volatile("" ::: "memory");
}
__device__ __forceinline__ float wave_sum(float v) {
#pragma unroll
    for (int o = 1; o < 64; o <<= 1) v += __shfl_xor(v, o);
    return v;
}
__device__ __forceinline__ void gemv20_item(Frame& F, const float* W, int N, int e, bool valid, int kc, float* outp, int ostride, const float* bias) {
    LAS const float* sc = (LAS const float*)F.lds;
    float acc[NBT];
#pragma unroll
    for (int b = 0; b < NBT; ++b) acc[b] = 0.f;
    if (valid) {
#pragma unroll 16
        for (int d = 0; d < 64; ++d) { const float w = __builtin_nontemporal_load(W + (size_t)(kc * 64 + d) * N + e);
#pragma unroll
            for (int b = 0; b < NBT; ++b) acc[b] += sc[b * 64 + d] * w; }
        const float bb = (bias && kc == 0) ? bias[e] : 0.f;
#pragma unroll
        for (int b = 0; b < NBT; ++b) atomicAdd(outp + (size_t)b * ostride + e, acc[b] + bb);
    }
}
__device__ __forceinline__ void p0a(Frame& F, bool gemv = true) {
    const float* cp = F.A->in[2]; const float* cs = F.A->in[3]; const float* w_ada = F.A->in[7]; const float* b_ada = F.A->in[8];
    float* mod = (float*)(F.ws + WS_MOD);
    if (gemv) for (int it = blockIdx.x; it < 256; it += F.G) {
        const int cg = it & 15, kc = it >> 4;
        LAS float* sc = (LAS float*)F.lds;
        for (int idx = F.tid; idx < NBT * 64; idx += 512) { const int b = idx >> 6, d = idx & 63;
            const float c = b < NBP ? cp[b * DM + kc * 64 + d] : cs[(b - NBP) * DM + kc * 64 + d]; sc[idx] = c / (1.f + __expf(-c)); }
        __syncthreads();
        gemv20_item(F, w_ada, 6 * DM, cg * 384 + (F.tid < 384 ? F.tid : 0), F.tid < 384, kc, mod, 6 * DM, b_ada);
        __syncthreads();
    }
    LAS float* scr = (LAS float*)(F.lds + F.wave * 16384);
    const int gw = blockIdx.x * NWAVES + F.wave, NGW = F.G * NWAVES;
    constexpr int I_IN = (DM / 64) * (DIN / 32), I_O = (DM / 64) * (DM / 32), I_G = (DM / 64) * (DFF / 32), I_D = (DFF / 64) * (DM / 32);
    constexpr int NITEMS = I_IN + I_O + 2 * I_G + I_D;
    bf16* win = (bf16*)(F.ws + WS_WIN); bf16* wout = (bf16*)(F.ws + WS_WOUT); bf16* wgu = (bf16*)(F.ws + WS_WGU); bf16* wdn = (bf16*)(F.ws + WS_WDN);
    for (int i = gw; i < NITEMS; i += NGW) {
        int r = i;
        if (r < I_IN) { p0_transpose_item(F.A->in[11], DM, DIN, win, 1, scr, r, F.lane); continue; } r -= I_IN;
        if (r < I_O) { p0_transpose_item(F.A->in[19], DM, DM, wout, WOUT_MODE, scr, r, F.lane); continue; } r -= I_O;
        if (r < I_G) { p0_transpose_item(F.A->in[20], DM, DFF, wgu, 2, scr, r, F.lane); continue; } r -= I_G;
        if (r < I_G) { p0_transpose_item(F.A->in[21], DM, DFF, wgu, 3, scr, r, F.lane); continue; } r -= I_G;
        p0_transpose_item(F.A->in[22], DFF, DM, wdn, WOUT_MODE, scr, r, F.lane);
    }
    float* rot = (float*)(F.ws + WS_ROT);
    for (int idx = blockIdx.x * 512 + F.tid; idx < 8192 * 64; idx += F.G * 512) {
        const int pos = idx >> 6, ip = idx & 63;
        const float inv = 1.0f / exp2f(((float)ip * (1.0f / 63.0f)) * 13.287712379549449f);
        const float ang = (float)pos * inv;
        const double rev = (double)ang * 0.15915494309189535; const float fr = (float)(rev - __builtin_rint(rev));
        float2 o; o.x = __builtin_amdgcn_cosf(fr); o.y = __builtin_amdgcn_sinf(fr);
        ((float2*)rot)[idx] = o;
    }
}
__device__ __forceinline__ void p0b(Frame& F, bool gemv = true) {
    const float* mod = (const float*)(F.ws + WS_MOD);
    const int it = blockIdx.x;
    if (it < 192 && gemv) {
        const int mat = it & 1, rest = it >> 1, cg = rest % 6, kc = rest / 6;
        LAS float* sc = (LAS float*)F.lds;
        for (int idx = F.tid; idx < NBT * 64; idx += 512) { const int b = idx >> 6, d = idx & 63; sc[idx] = mod[(size_t)b * 6 * DM + 3 * DM + kc * 64 + d]; }
        __syncthreads();
        const int f = cg * 512 + F.tid;
        gemv20_item(F, (mat ? F.A->in[21] : F.A->in[20]), DFF, f, f < DFF, kc, (float*)(F.ws + WS_SB2) + (size_t)mat * NBT * DFF, DFF, nullptr);
        __syncthreads();
    }
    { float* gm2 = (float*)(F.ws + WS_GMOD2);
      for (int idx = blockIdx.x * 512 + F.tid; idx < NBT * DM; idx += F.G * 512) { const int b = idx >> 10, c = idx & 1023; gm2[idx] = F.A->in[10][c] * (1.f + mod[(size_t)b * 6 * DM + 4 * DM + c]); } }
    const float* g1 = F.A->in[9]; bf16* xn = (bf16*)(F.ws + WS_XN);
    const int gw = blockIdx.x * NWAVES + F.wave, NGW = F.G * NWAVES;
    for (int m0 = gw; m0 < MT; m0 += 4 * NGW) {
        f32x4 v[4][4];
#pragma unroll
        for (int q = 0; q < 4; ++q) { const int m = m0 + q * NGW; if (m < MT) {
            const GAS f32x4* xr = (const GAS f32x4*)(m < MP ? F.A->in[0] + (size_t)m * DM : F.A->in[1] + (size_t)(m - MP) * DM) + F.lane;
#pragma unroll
            for (int j = 0; j < 4; ++j) v[q][j] = __builtin_nontemporal_load((const f32x4*)(xr + 64 * j)); } }
#pragma unroll
        for (int q = 0; q < 4; ++q) { const int m = m0 + q * NGW; if (m < MT) {
            const float* mb = mod + (size_t)row_batch(m) * 6 * DM; float s = 0.f;
#pragma unroll
            for (int j = 0; j < 4; ++j) s += (v[q][j].x * v[q][j].x + v[q][j].y * v[q][j].y) + (v[q][j].z * v[q][j].z + v[q][j].w * v[q][j].w);
            const float rstd = rsqrtf(wave_sum(s) * (1.f / DM) + EPSN);
            GAS unsigned long long* o8 = (GAS unsigned long long*)(xn + (size_t)m * DM) + F.lane;
#pragma unroll
            for (int j = 0; j < 4; ++j) { const int c = 4 * F.lane + 256 * j;
                const f32x4 g = *(const f32x4*)(g1 + c), sc1 = *(const f32x4*)(mb + DM + c), sh1 = *(const f32x4*)(mb + c);
                const f32x4 h = v[q][j] * rstd * g * (sc1 + 1.f) + sh1;
                o8[64 * j] = (unsigned long long)pk2(h.x, h.y) | ((unsigned long long)pk2(h.z, h.w) << 32); } } }
    }
}


namespace p2 {
typedef short bf16x8 __attribute__((ext_vector_type(8)));
typedef short s16x4 __attribute__((ext_vector_type(4)));
typedef float f32x16 __attribute__((ext_vector_type(16)));
typedef float f32x4 __attribute__((ext_vector_type(4)));
typedef unsigned u32x4 __attribute__((ext_vector_type(4)));
typedef unsigned u32x2 __attribute__((ext_vector_type(2)));
typedef float f32x2_t __attribute__((ext_vector_type(2))); typedef __bf16 bf16x2_t __attribute__((ext_vector_type(2)));
__device__ __forceinline__ unsigned cvtpk(float lo, float hi) { f32x2_t v = {lo, hi}; bf16x2_t b = __builtin_convertvector(v, bf16x2_t); return __builtin_bit_cast(unsigned, b); }
__device__ __forceinline__ int crow(int r, int hi) { return (r & 3) + 8 * (r >> 2) + 4 * hi; }
__device__ __forceinline__ s16x4 vtr(LAS const unsigned char* p) { return __builtin_bit_cast(s16x4, __builtin_amdgcn_ds_read_tr16_b64_v4i16((LAS s16x4*)p)); }
__device__ __forceinline__ bf16x8 cat8(s16x4 l, s16x4 h) { return (bf16x8){l[0], l[1], l[2], l[3], h[0], h[1], h[2], h[3]}; }
__device__ __forceinline__ bf16x8 pack8(f32x4 a, f32x4 b) { u32x4 w = {cvtpk(a[0], a[1]), cvtpk(a[2], a[3]), cvtpk(b[0], b[1]), cvtpk(b[2], b[3])}; return __builtin_bit_cast(bf16x8, w); }
__device__ __forceinline__ int v_st(int k, int c) { const int kk = (k & ~0xC) | ((k & 4) << 1) | ((k & 8) >> 1); return ((kk >> 3) * 4 + (c >> 5)) * 512 + ((kk & 7) * 32 + (c & 31)) * 2; }
__device__ __forceinline__ int v_rd_base(int lane) { return ((lane & 3) << 3) | (((lane >> 2) & 3) << 6) | (((lane >> 4) & 1) << 5) | (((lane >> 5) & 1) << 8); }
#define PK4(P, BASE, OUT) do { unsigned a0_ = cvtpk(P[BASE + 0], P[BASE + 1]), a1_ = cvtpk(P[BASE + 2], P[BASE + 3]);   \
    unsigned b0_ = cvtpk(P[BASE + 4], P[BASE + 5]), b1_ = cvtpk(P[BASE + 6], P[BASE + 7]);                              \
    auto r0_ = __builtin_amdgcn_permlane32_swap(a0_, b0_, false, false); auto r1_ = __builtin_amdgcn_permlane32_swap(a1_, b1_, false, false); \
    u32x4 w_ = {r0_[0], r1_[0], r0_[1], r1_[1]}; OUT = __builtin_bit_cast(bf16x8, w_); } while (0)

__device__ __forceinline__ int t5_bucket(int rel) {
    const int n = rel < 0 ? -rel : rel; const int ret = rel > 0 ? 16 : 0;
    const int large = n < 12 ? 8 : n < 16 ? 9 : n < 23 ? 10 : n < 32 ? 11 : n < 46 ? 12 : n < 64 ? 13 : n < 91 ? 14 : 15;
    return ret + (n < 8 ? n : large);
}
__device__ __forceinline__ void p2_setup(Frame& F) {
    const float* gq = F.A->in[12]; const float* gk = F.A->in[13]; const float* rb = F.A->in[23];
    float gqm = 0.f, gkm = 0.f, s1 = 0.f, s2 = 0.f;
    for (int d = 0; d < 64; ++d) { gqm = fmaxf(gqm, fabsf(gq[d])); gkm = fmaxf(gkm, fabsf(gk[d])); s1 += F.A->in[14][d] * F.A->in[15][d]; s2 += F.A->in[16][d] * F.A->in[17][d]; }
    LAS float* tab = (LAS float*)(F.lds + TAB_OFF); LAS float* cb = (LAS float*)(F.lds + CB_OFF);
    if (F.tid < 256) {
        const int rel = F.tid - 192; const int bk = t5_bucket(rel);
        for (int h = 0; h < 4; ++h) { float bm = -1e30f; for (int k = 0; k < 32; ++k) bm = fmaxf(bm, rb[k * 4 + h]);
            float bn = 1e30f; for (int k = 0; k < 32; ++k) bn = fminf(bn, rb[k * 4 + h]);
            const float bound = (8.f * gqm * gkm * 1.02f + (bm - bn)) * LOG2E;
            const float ch = rb[15 * 4 + h] + fmaxf(0.f, bound - 100.f) / LOG2E;
            tab[h * 256 + F.tid] = (rb[bk * 4 + h] - ch) * LOG2E;
            if (F.tid == 0) cb[h] = (rb[15 * 4 + h] - ch) * LOG2E; }
        if (F.tid == 0) cb[4] = __expf(s1) - __expf(s2) + LAM_INIT;
    }
    __syncthreads();
}

template <bool DVP = false>
__device__ __forceinline__ void attn_finish(LAS unsigned char* lds, f32x16 (&o)[4], const float (&rl)[16], bool active, int mp, int rg, float lam, const float* gs, bf16* orow0, int lane) {
    const int r32 = lane & 31, hi = lane >> 5;
    LAS float* ex = (LAS float*)lds + rg * 4096;
    if (active && mp == 1) {
#pragma unroll
        for (int d0 = 0; d0 < 4; ++d0)
#pragma unroll
            for (int r = 0; r < 16; ++r) ex[(d0 * 16 + r) * 64 + lane] = o[d0][r] * rl[r];
    }
    __syncthreads();
    if (active && mp == 0) {
#pragma unroll
        for (int d0 = 0; d0 < 4; ++d0)
#pragma unroll
            for (int r = 0; r < 16; ++r) o[d0][r] = o[d0][r] * rl[r] - lam * ex[(d0 * 16 + r) * 64 + lane];
        float gsv[4];
#pragma unroll
        for (int d0 = 0; d0 < 4; ++d0) gsv[d0] = gs[DVP ? 4 * r32 + d0 : 32 * d0 + r32] * (1.f - LAM_INIT);
        LAS bf16* st = (LAS bf16*)ex;
#pragma unroll
        for (int r = 0; r < 16; ++r) {
            float s = (o[0][r] * o[0][r] + o[1][r] * o[1][r]) + (o[2][r] * o[2][r] + o[3][r] * o[3][r]);
            s += __shfl_xor(s, 1); s += __shfl_xor(s, 2); s += __shfl_xor(s, 4); s += __shfl_xor(s, 8); s += __shfl_xor(s, 16);
            const float rn = rsqrtf(s * (1.f / 128.f) + EPSN);
#pragma unroll
            for (int d0 = 0; d0 < 4; ++d0) st[crow(r, hi) * 136 + (DVP ? 4 * r32 + d0 : d0 * 32 + r32)] = (bf16)f2bf(o[d0][r] * rn * gsv[d0]);
        }
#pragma unroll
        for (int i = 0; i < 8; ++i) { const int pi = i * 64 + lane, row = pi >> 4, ch = pi & 15;
            const u32x4 v = *(LAS const u32x4*)(st + row * 136 + ch * 8); *(u32x4*)(orow0 + (size_t)row * DM + ch * 8) = v; }
    }
    __syncthreads();
}

#ifndef ATT_VAR
#define ATT_VAR 0
#endif
template <int VAR>
__device__ __forceinline__ void attn_unit(Frame& F, const bf16* QA, const bf16* KA, const bf16* VA, bf16* OB, int b, int h, int qblk, float lam) {
    LAS unsigned char* lds = F.lds; int tid = F.tid; asm volatile("" : "+v"(tid)); const int wid = F.wave, lane = tid & 63;
    const int r32 = lane & 31, hi = lane >> 5, mp = wid >> 2, rg = wid & 3;
    const int q0 = qblk * 128, qw0 = q0 + rg * 32; const size_t rowbase = (size_t)b * SEQ;
    bf16x8 qr[4];
    { const bf16* qp = QA + (rowbase + qw0 + r32) * 512 + h * 128 + mp * 64 + hi * 8;
#pragma unroll
      for (int d0 = 0; d0 < 4; ++d0) qr[d0] = __builtin_nontemporal_load((const bf16x8*)(qp + d0 * 16)); }
    f32x16 o[4];
#pragma unroll
    for (int d0 = 0; d0 < 4; ++d0)
#pragma unroll
        for (int r = 0; r < 16; ++r) o[d0][r] = 0.f;
    float lsum = 0.f;
    const int NTw = (qw0 >> 6) + 1, NTu = (q0 >> 6) + 2, far_max = qw0 - 154;
    const float cbh = ((LAS const float*)(lds + CB_OFF))[h];
    LAS const float* tab = (LAS const float*)(lds + TAB_OFF) + h * 256;
    const bf16* kbu = KA + rowbase * 512 + h * 128; const bf16* vbu = VA + rowbase * 512 + h * 128;
    unsigned kofs[2], vofs[2];
#pragma unroll
    for (int i = 0; i < 2; ++i) { const int d = wid + 8 * i;
        const int key = 4 * d + (lane >> 4);
        kofs[i] = (unsigned)(key * 512 + (((lane & 15) ^ (key & 15)) * 8));
        const int kk = (d >> 1) * 8 + ((lane >> 2) & 7), kv = (kk & ~0xC) | ((kk & 4) << 1) | ((kk & 8) >> 1);
        vofs[i] = (unsigned)(kv * 512 + (2 * (d & 1) + (lane >> 5)) * 32 + (lane & 3) * 8); }
    int ka[4];
#pragma unroll
    for (int d0 = 0; d0 < 4; ++d0) ka[d0] = r32 * 256 + (((mp * 8 + 2 * d0 + hi) ^ (r32 & 15)) * 16);
    const int vrb = v_rd_base(lane);
    constexpr int VRING = 32768;
    const unsigned ldsbase = (unsigned)(size_t)lds;
#ifndef ATT_STAGGER
#define ATT_STAGGER 1
#endif
#ifndef ATT_DMA
#define ATT_DMA 1
#endif
#if ATT_DMA
#define DMA16(ldsa, voff, sbase) asm volatile("s_mov_b32 m0, %0\n\ts_nop 0\n\tglobal_load_lds_dwordx4 %1, %2" :: "s"(ldsa), "v"(voff), "s"(sbase) : "memory", "m0")
#define LOADS(S, t) do { if (VAR & 1) break; const size_t go_ = (size_t)(t) * 64 * 512; const int ko_ = ((t) & 1) * 16384, vo_ = VRING + ((t) & 3) * 16384; \
        const bf16* kb_ = kbu + go_; const bf16* vb2_ = vbu + go_; const unsigned lb_ = ldsbase + wid * 1024; \
        DMA16(lb_ + ko_, kofs[0] * 2u, kb_); DMA16(lb_ + ko_ + 8192, kofs[1] * 2u, kb_); DMA16(lb_ + vo_, vofs[0] * 2u, vb2_); DMA16(lb_ + vo_ + 8192, vofs[1] * 2u, vb2_); } while (0)
#define WRITES(S, ko, vo) do { } while (0)
#define STAGE_WAIT() asm volatile("s_waitcnt vmcnt(0)" ::: "memory")
#else
    u32x4 sa0, sa1, sa2, sa3, sb0, sb1, sb2, sb3;
#define LOADS(S, t) do { if (VAR & 1) break; const size_t go_ = (size_t)(t) * 64 * 512; S##0 = *(const u32x4*)(kbu + go_ + kofs[0]); S##1 = *(const u32x4*)(kbu + go_ + kofs[1]); S##2 = *(const u32x4*)(vbu + go_ + vofs[0]); S##3 = *(const u32x4*)(vbu + go_ + vofs[1]); } while (0)
#define WRITES(S, ko, vo) do { if (VAR & 1) break; *(LAS u32x4*)(lds + (ko) + wid * 1024 + lane * 16) = S##0; *(LAS u32x4*)(lds + (ko) + 8192 + wid * 1024 + lane * 16) = S##1; \
        *(LAS u32x4*)(lds + (vo) + wid * 1024 + lane * 16) = S##2; *(LAS u32x4*)(lds + (vo) + 8192 + wid * 1024 + lane * 16) = S##3; } while (0)
#define STAGE_WAIT() do { } while (0)
#endif
    bf16x8 pa0, pa1, pa2, pa3;
    { const u32x4 z4 = {0u, 0u, 0u, 0u}; pa0 = __builtin_bit_cast(bf16x8, z4); pa1 = pa0; pa2 = pa0; pa3 = pa0; }
    f32x16 p0, p1, lacc;
#pragma unroll
    for (int r = 0; r < 16; ++r) { p0[r] = 0.f; p1[r] = 0.f; lacc[r] = 0.f; }
    const bf16x8 ones = {(short)0x3F80, (short)0x3F80, (short)0x3F80, (short)0x3F80, (short)0x3F80, (short)0x3F80, (short)0x3F80, (short)0x3F80};
#define SBAR() __builtin_amdgcn_sched_barrier(0)
#define QK(ko, t) do { \
        f32x16 z_; _Pragma("unroll") for (int r = 0; r < 16; ++r) z_[r] = 0.f; \
        if (VAR & 8) { p0 = z_; p1 = z_; asm volatile("" : "+v"(p0), "+v"(p1)); } else { \
        _Pragma("unroll") for (int d0 = 0; d0 < 4; ++d0) { \
            const bf16x8 b0 = (VAR & 32) ? pa0 : *(LAS const bf16x8*)(lds + (ko) + ka[d0]), b1 = (VAR & 32) ? pa1 : *(LAS const bf16x8*)(lds + (ko) + ka[d0] + 8192), qf = qr[d0]; \
            p0 = __builtin_amdgcn_mfma_f32_32x32x16_bf16(b0, qf, d0 == 0 ? z_ : p0, 0, 0, 0); \
            p1 = __builtin_amdgcn_mfma_f32_32x32x16_bf16(b1, qf, d0 == 0 ? z_ : p1, 0, 0, 0); } } \
        if (64 * (t) > far_max || cbh != 0.f) {        \
            const int bi_ = 64 * (t) - qw0 - r32 + 4 * hi + 192; \
            _Pragma("unroll") for (int r = 0; r < 16; ++r) { const int i0_ = bi_ + (r & 3) + 8 * (r >> 2), i1_ = i0_ + 32; \
                p0[r] += tab[i0_ < 0 ? 0 : i0_]; p1[r] += tab[i1_ < 0 ? 0 : i1_]; } \
        } } while (0)
#define EX2(P, B) do { if (!(VAR & 2)) { P[B] = __builtin_amdgcn_exp2f(P[B]); P[B + 1] = __builtin_amdgcn_exp2f(P[B + 1]); } asm volatile("" : "+v"(P)); } while (0)
#define EXG(g) do { if ((g) < 8) EX2(p0, 2 * (g)); else EX2(p1, 2 * ((g) - 8)); } while (0)
#define VFR(d0, ks) ((VAR & 32) ? pa0 : cat8(vtr(vb_ + (d0) * 512 + (ks) * 4096), vtr(vb_ + (d0) * 512 + (ks) * 4096 + 2048)))
#define PVX(vo, DOEXP) do { if (VAR & 4) { if (DOEXP) { _Pragma("unroll") for (int g_ = 0; g_ < 16; ++g_) EXG(g_); } break; } \
        LAS const unsigned char* vb_ = lds + (vo) + vrb; \
        bf16x8 vf0 = VFR(0, 0), vf1 = VFR(0, 1), vf2; \
        SBAR(); \
        o[0] = __builtin_amdgcn_mfma_f32_32x32x16_bf16(pa0, vf0, o[0], 0, 0, 0); vf2 = VFR(0, 2); if (DOEXP) EXG(0); SBAR(); \
        o[0] = __builtin_amdgcn_mfma_f32_32x32x16_bf16(pa1, vf1, o[0], 0, 0, 0); vf0 = VFR(0, 3); if (DOEXP) EXG(1); SBAR(); \
        o[0] = __builtin_amdgcn_mfma_f32_32x32x16_bf16(pa2, vf2, o[0], 0, 0, 0); vf1 = VFR(1, 0); if (DOEXP) EXG(2); SBAR(); \
        o[0] = __builtin_amdgcn_mfma_f32_32x32x16_bf16(pa3, vf0, o[0], 0, 0, 0); vf2 = VFR(1, 1); if (DOEXP) EXG(3); SBAR(); \
        o[1] = __builtin_amdgcn_mfma_f32_32x32x16_bf16(pa0, vf1, o[1], 0, 0, 0); vf0 = VFR(1, 2); if (DOEXP) EXG(4); SBAR(); \
        o[1] = __builtin_amdgcn_mfma_f32_32x32x16_bf16(pa1, vf2, o[1], 0, 0, 0); vf1 = VFR(1, 3); if (DOEXP) EXG(5); SBAR(); \
        o[1] = __builtin_amdgcn_mfma_f32_32x32x16_bf16(pa2, vf0, o[1], 0, 0, 0); vf2 = VFR(2, 0); if (DOEXP) EXG(6); SBAR(); \
        o[1] = __builtin_amdgcn_mfma_f32_32x32x16_bf16(pa3, vf1, o[1], 0, 0, 0); vf0 = VFR(2, 1); if (DOEXP) EXG(7); SBAR(); \
        o[2] = __builtin_amdgcn_mfma_f32_32x32x16_bf16(pa0, vf2, o[2], 0, 0, 0); vf1 = VFR(2, 2); if (DOEXP) EXG(8); SBAR(); \
        o[2] = __builtin_amdgcn_mfma_f32_32x32x16_bf16(pa1, vf0, o[2], 0, 0, 0); vf2 = VFR(2, 3); if (DOEXP) EXG(9); SBAR(); \
        o[2] = __builtin_amdgcn_mfma_f32_32x32x16_bf16(pa2, vf1, o[2], 0, 0, 0); vf0 = VFR(3, 0); if (DOEXP) EXG(10); SBAR(); \
        o[2] = __builtin_amdgcn_mfma_f32_32x32x16_bf16(pa3, vf2, o[2], 0, 0, 0); vf1 = VFR(3, 1); if (DOEXP) EXG(11); SBAR(); \
        o[3] = __builtin_amdgcn_mfma_f32_32x32x16_bf16(pa0, vf0, o[3], 0, 0, 0); lacc = __builtin_amdgcn_mfma_f32_32x32x16_bf16(pa0, ones, lacc, 0, 0, 0); vf2 = VFR(3, 2); if (DOEXP) EXG(12); SBAR(); \
        o[3] = __builtin_amdgcn_mfma_f32_32x32x16_bf16(pa1, vf1, o[3], 0, 0, 0); lacc = __builtin_amdgcn_mfma_f32_32x32x16_bf16(pa1, ones, lacc, 0, 0, 0); vf0 = VFR(3, 3); if (DOEXP) EXG(13); SBAR(); \
        o[3] = __builtin_amdgcn_mfma_f32_32x32x16_bf16(pa2, vf2, o[3], 0, 0, 0); lacc = __builtin_amdgcn_mfma_f32_32x32x16_bf16(pa2, ones, lacc, 0, 0, 0); if (DOEXP) EXG(14); SBAR(); \
        o[3] = __builtin_amdgcn_mfma_f32_32x32x16_bf16(pa3, vf0, o[3], 0, 0, 0); lacc = __builtin_amdgcn_mfma_f32_32x32x16_bf16(pa3, ones, lacc, 0, 0, 0); if (DOEXP) EXG(15); SBAR(); } while (0)
    LOADS(sa, 0); WRITES(sa, 0, VRING); STAGE_WAIT();
    asm volatile("" :: "v"(qr[0]), "v"(qr[1]), "v"(qr[2]), "v"(qr[3]));
    __syncthreads();
#if !ATT_DMA
    if (1 < NTu) LOADS(sa, 1);
#endif
#ifndef ATT_LAG
#define ATT_LAG 0
#endif
    const int NSTEP = NTu + 1 + ATT_LAG;
#define PVPART(jt) do { const int j_ = (jt); \
        PVX(VRING + ((j_ > 0 ? j_ : 0) & 3) * 16384, 1); \
        if (j_ + 1 >= 0 && j_ + 1 < NTw) { PK4(p0, 0, pa0); PK4(p0, 8, pa1); PK4(p1, 0, pa2); PK4(p1, 8, pa3); } } while (0)
#define STEP(tt, LS, WS) do { const int kcur = ((tt) & 1) * 16384; \
        if (ATT_DMA) { if ((tt) + 1 < NTu) LOADS(LS, (tt) + 1); } else { if ((tt) + 2 < NTu) LOADS(LS, (tt) + 2); } \
        if (ATT_LAG && mp == 1 && (tt) >= 1 && (tt) <= NTw + 1) PVPART((tt) - 2);            \
        if ((tt) < NTw) QK(kcur, (tt)); \
        if ((tt) + 1 < NTu) WRITES(WS, kcur ^ 16384, VRING + (((tt) + 1) & 3) * 16384); \
        if ((!ATT_LAG || mp == 0) && (tt) <= NTw) PVPART((tt) - 1); \
        STAGE_WAIT(); \
        if (!(VAR & 16)) __syncthreads(); } while (0)
    for (int t = 0; t < NSTEP; t += 2) {
        STEP(t, sb, sa);
        if (t + 1 >= NSTEP) break;
        STEP(t + 1, sa, sb);
    }
#undef PVPART
#undef STEP
#undef LOADS
#undef WRITES
#undef STAGE_WAIT
#undef QK
#undef EX2
#undef EXG
#undef VFR
#undef PVX
#undef SBAR
    float rl[16];
#pragma unroll
    for (int r = 0; r < 16; ++r) rl[r] = 1.f / lacc[r];
    attn_finish(lds, o, rl, true, mp, rg, lam, F.A->in[18], OB + (rowbase + qw0) * DM + h * 128, lane);
}

__device__ __forceinline__ void sattn_unit(Frame& F, const bf16* QA, bf16* OB, int bs, int h, float lam) {
    LAS unsigned char* lds = F.lds; int tid = F.tid; asm volatile("" : "+v"(tid)); const int wid = F.wave, lane = tid & 63;
    const int r32 = lane & 31, hi = lane >> 5, mp = wid >> 2, sp = wid & 3;
    const size_t row0 = (size_t)MP + (size_t)bs * LS;
    bf16x8 qr[4];
    { const bf16* qp = QA + (row0 + r32) * 512 + h * 128 + mp * 64 + hi * 8;
#pragma unroll
      for (int d0 = 0; d0 < 4; ++d0) qr[d0] = *(const bf16x8*)(qp + d0 * 16); }
    f32x16 o[4];
#pragma unroll
    for (int d0 = 0; d0 < 4; ++d0)
#pragma unroll
        for (int r = 0; r < 16; ++r) o[d0][r] = 0.f;
    float lsum = 0.f;
    LAS const float* tab = (LAS const float*)(lds + TAB_OFF) + h * 256;
    f32x4 kl[8], vl[16];
    LAS unsigned char* kst = lds + wid * 8192; const int kkey = lane >> 4, kpc = lane & 15;
#define SA_BASE(tt_, kp_, vp_) const float* kp_; const float* vp_; \
        if ((tt_) < 64) { const size_t off_ = ((size_t)(bs * PAST + (tt_) * 32) * 4 + h) * 128; kp_ = F.A->in[4] + off_; vp_ = F.A->in[5] + off_; } \
        else { const size_t off_ = ((size_t)(bs * LS) * 4 + h) * 128; kp_ = F.out + OFF_KS + off_; vp_ = F.out + OFF_VS + off_; }
#define SA_KLOAD(tt_) do { SA_BASE(tt_, kp_, vp_) (void)vp_; const float* a_ = kp_ + (size_t)kkey * 512 + mp * 64 + kpc * 4; \
        _Pragma("unroll") for (int i_ = 0; i_ < 8; ++i_) kl[i_] = __builtin_nontemporal_load((const f32x4*)(a_ + (size_t)i_ * 4 * 512)); } while (0)
#define SA_VLOAD(tt_) do { SA_BASE(tt_, kp_, vp_) (void)kp_; const float* v0p_ = vp_ + (size_t)(8 * hi) * 512 + 4 * r32; \
        _Pragma("unroll") for (int j = 0; j < 8; ++j) { vl[j] = __builtin_nontemporal_load((const f32x4*)(v0p_ + j * 512)); vl[8 + j] = __builtin_nontemporal_load((const f32x4*)(v0p_ + (16 + j) * 512)); } } while (0)
    SA_KLOAD(sp); SA_VLOAD(sp);
    for (int tt = sp; tt < 65; tt += 4) {
#pragma unroll
        for (int i = 0; i < 8; ++i) { u32x2 wv; wv.x = cvtpk(kl[i][0], kl[i][1]); wv.y = cvtpk(kl[i][2], kl[i][3]); *(LAS u32x2*)(kst + (4 * i + kkey) * 144 + kpc * 8) = wv; }
        if (tt + 4 < 65) SA_KLOAD(tt + 4);
        bf16x8 kf[4];
#pragma unroll
        for (int d0 = 0; d0 < 4; ++d0) kf[d0] = *(LAS const bf16x8*)(kst + r32 * 144 + d0 * 32 + hi * 16);
        f32x16 p;
#pragma unroll
        for (int r = 0; r < 16; ++r) p[r] = 0.f;
#pragma unroll
        for (int d0 = 0; d0 < 4; ++d0) p = __builtin_amdgcn_mfma_f32_32x32x16_bf16(kf[d0], qr[d0], p, 0, 0, 0);
        const int relb = tt * 32 - PAST - r32 + 4 * hi;
        float ps = 0.f;
#pragma unroll
        for (int r = 0; r < 16; ++r) { int rel = relb + (r & 3) + 8 * (r >> 2); rel = rel < -192 ? -192 : rel; p[r] = __builtin_amdgcn_exp2f(p[r] + tab[rel + 192]); ps += p[r]; }
        lsum += ps;
        bf16x8 pa0, pa1;
        PK4(p, 0, pa0); PK4(p, 8, pa1);
#pragma unroll
        for (int d0 = 0; d0 < 4; ++d0) {
            f32x4 a, c, e, g;
            a[0] = vl[0][d0]; a[1] = vl[1][d0]; a[2] = vl[2][d0]; a[3] = vl[3][d0]; c[0] = vl[4][d0]; c[1] = vl[5][d0]; c[2] = vl[6][d0]; c[3] = vl[7][d0];
            e[0] = vl[8][d0]; e[1] = vl[9][d0]; e[2] = vl[10][d0]; e[3] = vl[11][d0]; g[0] = vl[12][d0]; g[1] = vl[13][d0]; g[2] = vl[14][d0]; g[3] = vl[15][d0];
            o[d0] = __builtin_amdgcn_mfma_f32_32x32x16_bf16(pa0, pack8(a, c), o[d0], 0, 0, 0);
            o[d0] = __builtin_amdgcn_mfma_f32_32x32x16_bf16(pa1, pack8(e, g), o[d0], 0, 0, 0);
        }
        if (tt + 4 < 65) SA_VLOAD(tt + 4);
    }
#undef SA_BASE
#undef SA_KLOAD
#undef SA_VLOAD
    __syncthreads();
    { auto rr = __builtin_amdgcn_permlane32_swap(__float_as_uint(lsum), __float_as_uint(lsum), false, false); lsum = __uint_as_float(rr[0]) + __uint_as_float(rr[1]); }
    LAS float* exb = (LAS float*)lds; LAS float* wsc = (LAS float*)(lds + WSC_OFF);
    if (hi == 0) wsc[wid * 64 + r32] = lsum;
    if (sp > 0) { LAS float* e = exb + (mp * 3 + sp - 1) * 4096;
#pragma unroll
        for (int d0 = 0; d0 < 4; ++d0)
#pragma unroll
            for (int r = 0; r < 16; ++r) e[(d0 * 16 + r) * 64 + lane] = o[d0][r]; }
    __syncthreads();
    float rl[16];
    if (sp == 0) {
#pragma unroll
        for (int k = 0; k < 3; ++k) { LAS const float* e = exb + (mp * 3 + k) * 4096;
#pragma unroll
            for (int d0 = 0; d0 < 4; ++d0)
#pragma unroll
                for (int r = 0; r < 16; ++r) o[d0][r] += e[(d0 * 16 + r) * 64 + lane]; }
#pragma unroll
        for (int r = 0; r < 16; ++r) { const int q = crow(r, hi); rl[r] = 1.f / ((wsc[(mp * 4 + 0) * 64 + q] + wsc[(mp * 4 + 1) * 64 + q]) + (wsc[(mp * 4 + 2) * 64 + q] + wsc[(mp * 4 + 3) * 64 + q])); }
    } else {
#pragma unroll
        for (int r = 0; r < 16; ++r) rl[r] = 0.f;
    }
    __syncthreads();
    attn_finish<true>(lds, o, rl, sp == 0, mp, 0, lam, F.A->in[18], OB + row0 * DM + h * 128, lane);
}

#define RSB() __builtin_amdgcn_sched_barrier(0)
constexpr int RT_ROW = 288, RT_TILE = 64 * RT_ROW, RT_BUF = 3 * RT_TILE, RT_P = 2 * RT_BUF, RT_PROW = 144, RT_RED = RT_P + 64 * RT_PROW;
static_assert(RT_RED + 8 * 64 * 4 <= RING_BYTES, "retention LDS");
__device__ __forceinline__ bf16x8 rt_qfrag(LAS const unsigned char* Qt, int it, int s, int fr, int g) {
    LAS const unsigned char* qa = Qt + (16 * it + fr) * RT_ROW + (32 * s + 4 * g) * 2; return cat8(*(LAS const s16x4*)qa, *(LAS const s16x4*)(qa + 32)); }
__device__ __forceinline__ bf16x8 rt_kfrag(LAS const unsigned char* Kt, int kt, int ks, int g, int q4, int p4) {
    LAS const unsigned char* ka_ = Kt + (32 * ks + 8 * g + q4) * RT_ROW + (16 * kt + 4 * p4) * 2; return cat8(vtr(ka_), vtr(ka_ + 4 * RT_ROW)); }
constexpr int RG_CH = 16, RG_N = (SEQ / 64) / RG_CH;
__device__ __forceinline__ void ret_groupA(Frame& F, const bf16* KR, const bf16* VR, float* E, int b, int h, int grp) {
    LAS unsigned char* lds = F.lds; int tid = F.tid; asm volatile("" : "+v"(tid)); const int w = F.wave, lane = tid & 63;
    const int fr = lane & 15, g = lane >> 4, q4 = fr >> 2, p4 = fr & 3;
    const float l2g = __log2f(1.f - exp2f(-5.f - (float)h)); const float g64 = exp2f(64.f * l2g);
    f32x4 S[8];
#pragma unroll
    for (int kt = 0; kt < 8; ++kt) S[kt] = (f32x4){0.f, 0.f, 0.f, 0.f};
    const size_t rowbase = (size_t)b * SEQ + (size_t)grp * RG_CH * 64;
    const int srow = tid >> 4, sc16 = tid & 15;
    const size_t gofs = (rowbase + srow) * 512 + h * 128 + sc16 * 8;
    const int lofs = srow * RT_ROW + sc16 * 16;
    u32x4 st[4];
#define ALOAD(c) do { const size_t go_ = gofs + (size_t)(c) * 64 * 512; st[0] = *(const u32x4*)(KR + go_); st[1] = *(const u32x4*)(KR + go_ + 32 * 512); st[2] = *(const u32x4*)(VR + go_); st[3] = *(const u32x4*)(VR + go_ + 32 * 512); } while (0)
#define AWRITE(bo) do { _Pragma("unroll") for (int j_ = 0; j_ < 4; ++j_) *(LAS u32x4*)(lds + (bo) + (1 + (j_ >> 1)) * RT_TILE + (j_ & 1) * 32 * RT_ROW + lofs) = st[j_]; } while (0)
    ALOAD(0); AWRITE(0); __syncthreads();
    for (int c = 0; c < RG_CH; ++c) {
        const int cur = (c & 1) * RT_BUF;
        LAS const unsigned char* Kt = lds + cur + RT_TILE; LAS const unsigned char* Vt = lds + cur + 2 * RT_TILE;
        if (c + 1 < RG_CH) ALOAD(c + 1);
        bf16x8 vf[2];
#pragma unroll
        for (int ks = 0; ks < 2; ++ks) { LAS const unsigned char* va = Vt + (32 * ks + 8 * g + q4) * RT_ROW + (16 * w + 4 * p4) * 2; vf[ks] = cat8(vtr(va), vtr(va + 4 * RT_ROW)); }
#pragma unroll
        for (int kt = 0; kt < 8; ++kt) S[kt] = S[kt] * g64;
        { bf16x8 fg[4];
          fg[0] = rt_kfrag(Kt, 0, 0, g, q4, p4); fg[1] = rt_kfrag(Kt, 0, 1, g, q4, p4); fg[2] = rt_kfrag(Kt, 1, 0, g, q4, p4); RSB();
#pragma unroll
          for (int n = 0; n < 16; ++n) { if (n + 3 < 16) fg[(n + 3) & 3] = rt_kfrag(Kt, (n + 3) >> 1, (n + 3) & 1, g, q4, p4);
              S[n >> 1] = __builtin_amdgcn_mfma_f32_16x16x32_bf16(fg[n & 3], vf[n & 1], S[n >> 1], 0, 0, 0); RSB(); } }
        if (c + 1 < RG_CH) AWRITE(cur ^ RT_BUF);
        __syncthreads();
    }
#undef ALOAD
#undef AWRITE
    float* ep = E + ((size_t)((b * 4 + h) * RG_N + grp) * 128) * 128;
#pragma unroll
    for (int kt = 0; kt < 8; ++kt)
#pragma unroll
        for (int r = 0; r < 4; ++r) ep[(size_t)(16 * kt + 4 * g + r) * 128 + 16 * w + fr] = S[kt][r];
    asm volatile("s_waitcnt vmcnt(0)" ::: "memory");
    __syncthreads();
    if (tid == 0) { __builtin_amdgcn_fence(__ATOMIC_RELEASE, "agent"); asm volatile("s_waitcnt vmcnt(0)" ::: "memory");
        __hip_atomic_fetch_add((unsigned*)(F.ctl + CW_CNTA + 64 * (b * 4 + h)), 1u, __ATOMIC_RELAXED, __HIP_MEMORY_SCOPE_AGENT); }
    __syncthreads();
}
__device__ __forceinline__ void ret_groupB(Frame& F, const bf16* QR, const bf16* KR, const bf16* VR, const bf16* GR, bf16* OB, const float* E, int b, int h, int grp) {
    LAS unsigned char* lds = F.lds; int tid = F.tid; asm volatile("" : "+v"(tid)); const int w = F.wave, lane = tid & 63;
    const int fr = lane & 15, g = lane >> 4, q4 = fr >> 2, p4 = fr & 3;
    const float l2g = __log2f(1.f - exp2f(-5.f - (float)h)); const float g64 = exp2f(64.f * l2g);
    float cs[4];
#pragma unroll
    for (int it = 0; it < 4; ++it) { const int i = 16 * it + fr; cs[it] = exp2f((float)(i + 1) * l2g); }
    const size_t rowbase = (size_t)b * SEQ + (size_t)grp * RG_CH * 64;
    const int srow = tid >> 4, sc16 = tid & 15;
    const size_t gofs = (rowbase + srow) * 512 + h * 128 + sc16 * 8;
    const int lofs = srow * RT_ROW + sc16 * 16;
    u32x4 st[6]; u32x2 gpre[4];
    const size_t grow0 = (rowbase + fr) * 512 + h * 128 + 16 * w + 4 * g;
#define NTL_(p) __builtin_nontemporal_load((const u32x4*)(p))
#define RLOAD(c) do { const size_t go_ = gofs + (size_t)(c) * 64 * 512; st[0] = NTL_(QR + go_); st[1] = NTL_(QR + go_ + 32 * 512); \
        st[2] = NTL_(KR + go_); st[3] = NTL_(KR + go_ + 32 * 512); st[4] = NTL_(VR + go_); st[5] = NTL_(VR + go_ + 32 * 512); } while (0)
#define RWRITE(bo) do { _Pragma("unroll") for (int j_ = 0; j_ < 6; ++j_) *(LAS u32x4*)(lds + (bo) + (j_ >> 1) * RT_TILE + (j_ & 1) * 32 * RT_ROW + lofs) = st[j_]; } while (0)
    RLOAD(0);
    if (tid == 0) { unsigned sp_ = 0; gu32* cp = F.ctl + CW_CNTA + 64 * (b * 4 + h);
        while (__hip_atomic_load(cp, __ATOMIC_RELAXED, __HIP_MEMORY_SCOPE_AGENT) < (unsigned)RG_N) { __builtin_amdgcn_s_sleep(4); if (++sp_ > (1u << 22)) break; }
        __builtin_amdgcn_fence(__ATOMIC_ACQUIRE, "agent"); asm volatile("s_waitcnt vmcnt(0)" ::: "memory"); }
    RWRITE(0);
    __syncthreads();
    f32x4 S[8];
#pragma unroll
    for (int kt = 0; kt < 8; ++kt) S[kt] = (f32x4){0.f, 0.f, 0.f, 0.f};
    for (int gp = 0; gp < grp; ++gp) {
        const float wgt = exp2f((float)(1024 * (grp - 1 - gp)) * l2g);
        const float* ep = E + ((size_t)((b * 4 + h) * RG_N + gp) * 128) * 128;
#pragma unroll
        for (int kt = 0; kt < 8; ++kt)
#pragma unroll
            for (int r = 0; r < 4; ++r) S[kt][r] += wgt * ep[(size_t)(16 * kt + 4 * g + r) * 128 + 16 * w + fr];
    }
    LAS float* red = (LAS float*)(lds + RT_RED);
    for (int c = 0; c < RG_CH; ++c) {
        const int cur = (c & 1) * RT_BUF;
        LAS const unsigned char* Qt = lds + cur; LAS const unsigned char* Kt = lds + cur + RT_TILE; LAS const unsigned char* Vt = lds + cur + 2 * RT_TILE;
        if (c + 1 < RG_CH) RLOAD(c + 1);
#pragma unroll
        for (int it = 0; it < 4; ++it) gpre[it] = __builtin_nontemporal_load((const u32x2*)(GR + grow0 + (size_t)(c * 64 + 16 * it) * 512));
        { const int it = w >> 1; const int i = 16 * it + fr; const float ps_ = exp2f((float)(i - 63) * l2g);
#pragma unroll
          for (int jj = 0; jj < 2; ++jj) { const int jt = 2 * (w & 1) + jj;
            f32x4 acc = (f32x4){0.f, 0.f, 0.f, 0.f};
            if (jt <= it) {
                bf16x8 ka_[4], qb_[4];
#pragma unroll
                for (int ks = 0; ks < 4; ++ks) { ka_[ks] = *(LAS const bf16x8*)(Kt + (16 * jt + fr) * RT_ROW + (32 * ks + 8 * g) * 2); qb_[ks] = *(LAS const bf16x8*)(Qt + (16 * it + fr) * RT_ROW + (32 * ks + 8 * g) * 2); }
                RSB();
#pragma unroll
                for (int ks = 0; ks < 4; ++ks) acc = __builtin_amdgcn_mfma_f32_16x16x32_bf16(ka_[ks], qb_[ks], acc, 0, 0, 0);
            }
            const int j0 = 16 * jt + 4 * g; u32x2 wv;
            wv.x = cvtpk(j0 + 0 <= i ? acc[0] * ps_ : 0.f, j0 + 1 <= i ? acc[1] * ps_ : 0.f); wv.y = cvtpk(j0 + 2 <= i ? acc[2] * ps_ : 0.f, j0 + 3 <= i ? acc[3] * ps_ : 0.f);
            *(LAS u32x2*)(lds + RT_P + i * RT_PROW + j0 * 2) = wv; } }
        f32x4 X[4];
        { bf16x8 af[4], qf[4];
#pragma unroll
          for (int s = 0; s < 4; ++s) af[s] = pack8(S[2 * s], S[2 * s + 1]);
#pragma unroll
          for (int it = 0; it < 4; ++it) X[it] = (f32x4){0.f, 0.f, 0.f, 0.f};
          qf[0] = rt_qfrag(Qt, 0, 0, fr, g); qf[1] = rt_qfrag(Qt, 0, 1, fr, g); qf[2] = rt_qfrag(Qt, 0, 2, fr, g); RSB();
#pragma unroll
          for (int n = 0; n < 16; ++n) { if (n + 3 < 16) qf[(n + 3) & 3] = rt_qfrag(Qt, (n + 3) >> 2, (n + 3) & 3, fr, g);
              X[n >> 2] = __builtin_amdgcn_mfma_f32_16x16x32_bf16(af[n & 3], qf[n & 3], X[n >> 2], 0, 0, 0); RSB(); } }
        __syncthreads();
        bf16x8 vf[2];
#pragma unroll
        for (int ks = 0; ks < 2; ++ks) { LAS const unsigned char* va = Vt + (32 * ks + 8 * g + q4) * RT_ROW + (16 * w + 4 * p4) * 2; vf[ks] = cat8(vtr(va), vtr(va + 4 * RT_ROW)); }
        f32x4 Y[4];
#pragma unroll
        for (int it = 0; it < 4; ++it) Y[it] = (f32x4){0.f, 0.f, 0.f, 0.f};
#pragma unroll
        for (int kt = 0; kt < 8; ++kt) S[kt] = S[kt] * g64;
        { bf16x8 fg[4];
#define BFRAG(n_) ((n_) < 8 ? *(LAS const bf16x8*)(lds + RT_P + (16 * ((n_) >> 1) + fr) * RT_PROW + (32 * ((n_) & 1) + 8 * g) * 2) : rt_kfrag(Kt, ((n_) - 8) >> 1, (n_) & 1, g, q4, p4))
          fg[0] = BFRAG(0); fg[1] = BFRAG(1); fg[2] = BFRAG(2); RSB();
#pragma unroll
          for (int n = 0; n < 24; ++n) { if (n + 3 < 24) fg[(n + 3) & 3] = BFRAG(n + 3);
              if (n < 8) Y[n >> 1] = __builtin_amdgcn_mfma_f32_16x16x32_bf16(vf[n & 1], fg[n & 3], Y[n >> 1], 0, 0, 0);
              else S[(n - 8) >> 1] = __builtin_amdgcn_mfma_f32_16x16x32_bf16(fg[n & 3], vf[n & 1], S[(n - 8) >> 1], 0, 0, 0);
              RSB(); }
#undef BFRAG
        }
        f32x4 ov[4];
#pragma unroll
        for (int it = 0; it < 4; ++it) { ov[it] = Y[it] + X[it] * cs[it];
            float sq = (ov[it][0] * ov[it][0] + ov[it][1] * ov[it][1]) + (ov[it][2] * ov[it][2] + ov[it][3] * ov[it][3]);
            sq += __shfl_xor(sq, 16); sq += __shfl_xor(sq, 32);
            if (g == 0) red[w * 64 + 16 * it + fr] = sq; }
        if (c + 1 < RG_CH) RWRITE(cur ^ RT_BUF);
        __syncthreads();
#pragma unroll
        for (int it = 0; it < 4; ++it) { const int i = 16 * it + fr; float tot = 0.f;
#pragma unroll
            for (int ww = 0; ww < 8; ++ww) tot += red[ww * 64 + i];
            const float rstd = rsqrtf(tot * (1.f / 128.f) + EPSN);
            const size_t row = rowbase + (size_t)c * 64 + i;
            const u32x2 gv = gpre[it];
            const float g0 = __uint_as_float(gv.x << 16), g1 = __uint_as_float(gv.x & 0xffff0000u), g2 = __uint_as_float(gv.y << 16), g3 = __uint_as_float(gv.y & 0xffff0000u);
            u32x2 ow; ow.x = cvtpk(ov[it][0] * rstd * g0, ov[it][1] * rstd * g1); ow.y = cvtpk(ov[it][2] * rstd * g2, ov[it][3] * rstd * g3);
            *(u32x2*)(OB + row * DM + 512 + h * 128 + 16 * w + 4 * g) = ow; }
    }
#undef RLOAD
#undef RWRITE
#undef NTL_
    if (grp == RG_N - 1) {
        float* rp = F.out + OFF_RP + ((size_t)(b * 4 + h) * 128) * 128;
#pragma unroll
        for (int kt = 0; kt < 8; ++kt)
#pragma unroll
            for (int r = 0; r < 4; ++r) rp[(size_t)(16 * kt + 4 * g + r) * 128 + 16 * w + fr] = S[kt][r];
    }
    __syncthreads();
}

__device__ __forceinline__ void ret_sample(Frame& F, const bf16* QR, const bf16* KR, const bf16* VR, const bf16* GR, bf16* OB, int bs, int h) {
    LAS unsigned char* lds = F.lds; int tid = F.tid; asm volatile("" : "+v"(tid)); const int w = F.wave, lane = tid & 63;
    const int fr = lane & 15, g = lane >> 4, q4 = fr >> 2, p4 = fr & 3;
    const float l2g = __log2f(1.f - exp2f(-5.f - (float)h)); const float g32 = exp2f(32.f * l2g);
    const size_t row0 = (size_t)MP + (size_t)bs * LS;
    LAS const unsigned char* Qt = lds; LAS const unsigned char* Kt = lds + RT_TILE; LAS const unsigned char* Vt = lds + 2 * RT_TILE;
    { const int srow = tid >> 4, sc16 = tid & 15; const size_t go_ = (row0 + srow) * 512 + h * 128 + sc16 * 8; const int lofs = srow * RT_ROW + sc16 * 16;
      const u32x4 a = *(const u32x4*)(QR + go_), b = *(const u32x4*)(KR + go_), c = *(const u32x4*)(VR + go_);
      *(LAS u32x4*)(lds + lofs) = a; *(LAS u32x4*)(lds + RT_TILE + lofs) = b; *(LAS u32x4*)(lds + 2 * RT_TILE + lofs) = c; }
    const float* S0 = F.A->in[6] + ((size_t)(bs * 4 + h) * 128) * 128;
    f32x4 S[8];
#pragma unroll
    for (int kt = 0; kt < 8; ++kt)
#pragma unroll
        for (int r = 0; r < 4; ++r) S[kt][r] = __builtin_nontemporal_load(S0 + (size_t)(16 * kt + 4 * g + r) * 128 + 16 * w + fr);
    u32x2 gpre[2];
#pragma unroll
    for (int it = 0; it < 2; ++it) gpre[it] = __builtin_nontemporal_load((const u32x2*)(GR + (row0 + 16 * it + fr) * 512 + h * 128 + 16 * w + 4 * g));
    __syncthreads();
    if (w < 4) { const int it = w >> 1, jt = w & 1; const int i = 16 * it + fr; const float ps_ = exp2f((float)(i - 31) * l2g);
        f32x4 acc = (f32x4){0.f, 0.f, 0.f, 0.f};
        if (jt <= it) {
#pragma unroll
            for (int ks = 0; ks < 4; ++ks) { const bf16x8 a = *(LAS const bf16x8*)(Kt + (16 * jt + fr) * RT_ROW + (32 * ks + 8 * g) * 2);
                const bf16x8 bq = *(LAS const bf16x8*)(Qt + (16 * it + fr) * RT_ROW + (32 * ks + 8 * g) * 2);
                acc = __builtin_amdgcn_mfma_f32_16x16x32_bf16(a, bq, acc, 0, 0, 0); }
        }
        const int j0 = 16 * jt + 4 * g; u32x2 wv;
        wv.x = cvtpk(j0 + 0 <= i ? acc[0] * ps_ : 0.f, j0 + 1 <= i ? acc[1] * ps_ : 0.f); wv.y = cvtpk(j0 + 2 <= i ? acc[2] * ps_ : 0.f, j0 + 3 <= i ? acc[3] * ps_ : 0.f);
        *(LAS u32x2*)(lds + RT_P + i * RT_PROW + j0 * 2) = wv; }
    f32x4 X[2];
    { bf16x8 af[4];
#pragma unroll
      for (int s = 0; s < 4; ++s) af[s] = pack8(S[2 * s], S[2 * s + 1]);
#pragma unroll
      for (int it = 0; it < 2; ++it) { X[it] = (f32x4){0.f, 0.f, 0.f, 0.f};
#pragma unroll
        for (int s = 0; s < 4; ++s) { LAS const unsigned char* qa = Qt + (16 * it + fr) * RT_ROW + (32 * s + 4 * g) * 2;
            const s16x4 lo = *(LAS const s16x4*)qa, hi4 = *(LAS const s16x4*)(qa + 32);
            X[it] = __builtin_amdgcn_mfma_f32_16x16x32_bf16(af[s], cat8(lo, hi4), X[it], 0, 0, 0); } } }
    __syncthreads();
    bf16x8 vf;
    { LAS const unsigned char* va = Vt + (8 * g + q4) * RT_ROW + (16 * w + 4 * p4) * 2; vf = cat8(vtr(va), vtr(va + 4 * RT_ROW)); }
    f32x4 Y[2];
#pragma unroll
    for (int it = 0; it < 2; ++it) { const bf16x8 pb = *(LAS const bf16x8*)(lds + RT_P + (16 * it + fr) * RT_PROW + (8 * g) * 2);
        Y[it] = __builtin_amdgcn_mfma_f32_16x16x32_bf16(vf, pb, (f32x4){0.f, 0.f, 0.f, 0.f}, 0, 0, 0); }
#pragma unroll
    for (int kt = 0; kt < 8; ++kt) { S[kt] = S[kt] * g32;
        LAS const unsigned char* ka_ = Kt + (8 * g + q4) * RT_ROW + (16 * kt + 4 * p4) * 2;
        S[kt] = __builtin_amdgcn_mfma_f32_16x16x32_bf16(cat8(vtr(ka_), vtr(ka_ + 4 * RT_ROW)), vf, S[kt], 0, 0, 0); }
    { float* rp = F.out + OFF_RS + ((size_t)(bs * 4 + h) * 128) * 128;
#pragma unroll
      for (int kt = 0; kt < 8; ++kt)
#pragma unroll
        for (int r = 0; r < 4; ++r) rp[(size_t)(16 * kt + 4 * g + r) * 128 + 16 * w + fr] = S[kt][r]; }
    LAS float* red = (LAS float*)(lds + RT_RED);
    f32x4 ov[2];
#pragma unroll
    for (int it = 0; it < 2; ++it) { const float cs_ = exp2f((float)(16 * it + fr + 1) * l2g); ov[it] = Y[it] + X[it] * cs_;
        float sq = (ov[it][0] * ov[it][0] + ov[it][1] * ov[it][1]) + (ov[it][2] * ov[it][2] + ov[it][3] * ov[it][3]);
        sq += __shfl_xor(sq, 16); sq += __shfl_xor(sq, 32);
        if (g == 0) red[w * 64 + 16 * it + fr] = sq; }
    __syncthreads();
#pragma unroll
    for (int it = 0; it < 2; ++it) { const int i = 16 * it + fr; float tot = 0.f;
#pragma unroll
        for (int ww = 0; ww < 8; ++ww) tot += red[ww * 64 + i];
        const float rstd = rsqrtf(tot * (1.f / 128.f) + EPSN);
        const u32x2 gv = gpre[it];
        const float g0 = __uint_as_float(gv.x << 16), g1 = __uint_as_float(gv.x & 0xffff0000u), g2 = __uint_as_float(gv.y << 16), g3 = __uint_as_float(gv.y & 0xffff0000u);
        u32x2 ow; ow.x = cvtpk(ov[it][0] * rstd * g0, ov[it][1] * rstd * g1); ow.y = cvtpk(ov[it][2] * rstd * g2, ov[it][3] * rstd * g3);
        *(u32x2*)(OB + (row0 + i) * DM + 512 + h * 128 + 16 * w + 4 * g) = ow; }
    __syncthreads();
}

__device__ __forceinline__ int q_next(Frame& F, int q, int rep = 0) {
    volatile LAS int* slot = (volatile LAS int*)(F.lds + QSLOT_OFF);
    if (F.tid == 0) *slot = (int)__hip_atomic_fetch_add((unsigned*)(F.ctl + CW_QUEUE + 64 * (q + 8 * rep)), 1u, __ATOMIC_RELAXED, __HIP_MEMORY_SCOPE_AGENT);
    __syncthreads();
    const int v = *slot;
    __syncthreads();
    return v;
}
#ifndef P2M
#define P2M 31
#endif
constexpr int Q_ITEMS = 16 + 128 + 16 + 8 + 8;
__device__ __forceinline__ void phase2(Frame& F, int rep = 0, int mask = 31) {
    p2_setup(F);
    const float lam = ((LAS const float*)(F.lds + CB_OFF))[4];
    bf16* act = (bf16*)(F.ws + WS_ACT);
    const bf16* QA = act, *KA = act + ACT_STRIDE, *VA = act + 2 * ACT_STRIDE, *QR = act + 3 * ACT_STRIDE, *KR = act + 4 * ACT_STRIDE, *VR = act + 5 * ACT_STRIDE, *GR = act + 6 * ACT_STRIDE;
    bf16* OB = (bf16*)(F.ws + WS_OB); float* E = (float*)(F.ws + WS_E);
    const int xcc = (int)(xb_xcc_id() & 7u);
    for (int k = 0; k < 8; ++k) {
        const int q = (xcc + k) & 7;
        for (;;) {
            const int i = q_next(F, q, rep);
            if (i >= Q_ITEMS) break;
            if (i < 16) { if (mask & P2M & 1) { const int bh = 2 * q + (i >> 3); ret_groupA(F, KR, VR, E, bh >> 2, bh & 3, i & 7); } }
            else if (i >= 48 && i < 64) { if (mask & P2M & 16) { const int bh = 2 * q + ((i - 48) >> 3); ret_groupB(F, QR, KR, VR, GR, OB, E, bh >> 2, bh & 3, (i - 48) & 7); } }
            else if (i >= 64 && i < 72) { if (mask & P2M & 4) { const int id = 8 * q + (i - 64); sattn_unit(F, QA, OB, id >> 2, id & 3, lam); } }
            else if (i >= 72 && i < 80) { if (mask & P2M & 8) { const int id = 8 * q + (i - 72); ret_sample(F, QR, KR, VR, GR, OB, id >> 2, id & 3); } }
            else { if (mask & P2M & 2) { const int j = i < 48 ? i - 16 : i - 48, bh = 2 * q + (j & 1); if (rep == 0) attn_unit<0>(F, QA, KA, VA, OB, bh >> 2, bh & 3, 63 - (j >> 1), lam); else attn_unit<ATT_VAR>(F, QA, KA, VA, (bf16*)(F.ws + WS_XN), bh >> 2, bh & 3, 63 - (j >> 1), lam); } }
        }
    }
}
}


namespace sg {
using p2::bf16x8; using p2::f32x16; using p2::crow;
template <int NB>
__device__ __forceinline__ void wave_mm(f32x16 (&acc)[NB], LAS unsigned char* wl, const bf16* A, int lda, const bf16* Bm, int ldb, const int (&brow)[NB][4], int k0, int k1, int lane) {
#pragma unroll
    for (int nb = 0; nb < NB; ++nb)
#pragma unroll
        for (int r = 0; r < 16; ++r) acc[nb][r] = 0.f;
    const int r32 = lane & 31, hi = lane >> 5, lrow = lane >> 3, lpc = lane & 7;
    p2::u32x4 st[1 + NB][4];
#define SG_LOAD(ks) do { _Pragma("unroll") for (int i = 0; i < 4; ++i) { st[0][i] = *(const p2::u32x4*)(A + (size_t)(8 * i + lrow) * lda + (ks) + lpc * 8); \
        _Pragma("unroll") for (int nb = 0; nb < NB; ++nb) st[1 + nb][i] = *(const p2::u32x4*)(Bm + (size_t)brow[nb][i] * ldb + (ks) + lpc * 8); } } while (0)
    SG_LOAD(k0);
    for (int ks = k0; ks < k1; ks += 64) {
#pragma unroll
        for (int t = 0; t < 1 + NB; ++t)
#pragma unroll
            for (int i = 0; i < 4; ++i) { const int row = 8 * i + lrow; *(LAS p2::u32x4*)(wl + t * 4096 + row * 128 + ((lpc ^ ((row >> 1) & 7)) * 16)) = st[t][i]; }
        if (ks + 64 < k1) SG_LOAD(ks + 64);
#pragma unroll
        for (int u = 0; u < 4; ++u) { const int po = ((2 * u + hi) ^ ((r32 >> 1) & 7)) * 16;
            const bf16x8 a = *(LAS const bf16x8*)(wl + r32 * 128 + po);
#pragma unroll
            for (int nb = 0; nb < NB; ++nb) { const bf16x8 b = *(LAS const bf16x8*)(wl + (1 + nb) * 4096 + r32 * 128 + po); acc[nb] = __builtin_amdgcn_mfma_f32_32x32x16_bf16(a, b, acc[nb], 0, 0, 0); } }
    }
#undef SG_LOAD
}
__device__ __forceinline__ float half_sum(float s) { s += __shfl_xor(s, 1); s += __shfl_xor(s, 2); s += __shfl_xor(s, 4); s += __shfl_xor(s, 8); s += __shfl_xor(s, 16); return s; }
__device__ __forceinline__ float bf2f(bf16 v) { return __uint_as_float((unsigned)v << 16); }

__device__ __forceinline__ void p1_sample(Frame& F, const bf16* XN, const bf16* Win, bf16* act) {
    int tid = F.tid; asm volatile("" : "+v"(tid)); const int lane = tid & 63, r32 = lane & 31, hi = lane >> 5;
    const int gw = blockIdx.x + F.G * F.wave, NGW = F.G * NWAVES;
    const float* rot = (const float*)(F.ws + WS_ROT);
    for (int id = gw; id < 16 * (DIN / 64); id += NGW) {
        const int cg = id >> 4, rt = id & 15, m0 = MP + 32 * rt, n0 = 64 * cg;
        f32x16 acc[2];
        int brow[2][4];
#pragma unroll
        for (int nb = 0; nb < 2; ++nb)
#pragma unroll
            for (int i = 0; i < 4; ++i) brow[nb][i] = dst_row(1, n0 + 32 * nb + 8 * i + (lane >> 3));
        wave_mm<2>(acc, F.lds + F.wave * 12288, XN + (size_t)m0 * DM, DM, Win, DM, brow, 0, DM, lane);
        const int type = n0 >> 9, lc = (n0 & 511) + r32;
        bf16* dst = act + (size_t)type * ACT_STRIDE;
        if (type <= 1) {
            const float* g = type == 0 ? F.A->in[12] : F.A->in[13]; const float g0 = g[r32], g1 = g[32 + r32], osc = type == 0 ? QSCALE : 1.f;
#pragma unroll
            for (int r = 0; r < 16; ++r) { const int m = m0 + crow(r, hi);
                const float rinv = rsqrtf(half_sum(acc[0][r] * acc[0][r] + acc[1][r] * acc[1][r]) * (1.f / 64.f) + EPSN);
                const float y0 = acc[0][r] * rinv * g0, y1 = acc[1][r] * rinv * g1;
                if (type == 1) { float* ko = F.out + OFF_KS + (size_t)(m - MP) * 512 + lc; ko[0] = y0; ko[32] = y1; }
                dst[(size_t)m * 512 + lc] = (bf16)f2bf(y0 * osc); dst[(size_t)m * 512 + lc + 32] = (bf16)f2bf(y1 * osc); }
        } else if (type == 3 || type == 4) {
            const int h = (n0 & 511) >> 7; const float l2g = __log2f(1.f - exp2f(-5.f - (float)h));
            float2 cs[16][2];
#pragma unroll
            for (int r = 0; r < 16; ++r) { const int ts = crow(r, hi);
#pragma unroll
                for (int nb = 0; nb < 2; ++nb) cs[r][nb] = *(const float2*)(rot + (size_t)(PAST + ts) * 128 + (((lc + 32 * nb) & 127) & ~1)); }
#pragma unroll
            for (int r = 0; r < 16; ++r) { const int m = m0 + crow(r, hi), ts = crow(r, hi);
                const float ksc = type == 4 ? 0.08838834764831845f * exp2f((float)(31 - ts) * l2g) : 1.f;
#pragma unroll
                for (int nb = 0; nb < 2; ++nb) { const float v = acc[nb][r], pv = __shfl_xor(v, 1);
                    const float c = cs[r][nb].x, sn = cs[r][nb].y;
                    const float y = (lane & 1) ? (pv * sn + v * c) : (v * c - pv * sn);
                    dst[(size_t)m * 512 + lc + 32 * nb] = (bf16)f2bf(y * ksc); } }
        } else {
#pragma unroll
            for (int r = 0; r < 16; ++r) { const int m = m0 + crow(r, hi);
#pragma unroll
                for (int nb = 0; nb < 2; ++nb) { float y = acc[nb][r];
                    if (type == 2) F.out[OFF_VS + (size_t)(m - MP) * 512 + lc + 32 * nb] = y;
                    if (type == 6) y = pg8::silu_f(y);
                    dst[(size_t)m * 512 + lc + 32 * nb] = (bf16)f2bf(y); } }
        }
    }
}
__device__ __forceinline__ void p3_sample(Frame& F, const bf16* OB, const bf16* Wout, bf16* XN2, const float* mod, float* rowss) {
    int tid = F.tid; asm volatile("" : "+v"(tid)); const int lane = tid & 63, r32 = lane & 31, hi = lane >> 5;
    const int gw = blockIdx.x + F.G * F.wave, NGW = F.G * NWAVES;
    for (int id = gw; id < 16 * (DM / 64); id += NGW) {
        const int cg = id >> 4, rt = id & 15, m0 = MP + 32 * rt, n0 = 64 * cg;
        f32x16 acc[2];
        int brow[2][4];
#pragma unroll
        for (int nb = 0; nb < 2; ++nb)
#pragma unroll
            for (int i = 0; i < 4; ++i) brow[nb][i] = dst_row(WOUT_MODE, n0 + 32 * nb + 8 * i + (lane >> 3));
        wave_mm<2>(acc, F.lds + F.wave * 12288, OB + (size_t)m0 * DM, DM, Wout, DM, brow, 0, DM, lane);
        const float* mb = mod + (size_t)(NBP + rt) * 6 * DM;
        float gt[2], gm[2];
#pragma unroll
        for (int nb = 0; nb < 2; ++nb) { const int col = n0 + 32 * nb + r32; gt[nb] = mb[2 * DM + col]; gm[nb] = F.A->in[10][col] * (1.f + mb[4 * DM + col]); }
        float xin[16][2];
#pragma unroll
        for (int r = 0; r < 16; ++r)
#pragma unroll
            for (int nb = 0; nb < 2; ++nb) xin[r][nb] = F.A->in[1][(size_t)(m0 + crow(r, hi) - MP) * DM + n0 + 32 * nb + r32];
#pragma unroll
        for (int r = 0; r < 16; ++r) { const int m = m0 + crow(r, hi); float ss = 0.f;
#pragma unroll
            for (int nb = 0; nb < 2; ++nb) { const int col = n0 + 32 * nb + r32;
                const float x1 = xin[r][nb] + gt[nb] * acc[nb][r];
                F.out[OFF_Y + (size_t)m * DM + col] = x1; XN2[(size_t)m * DM + col] = (bf16)f2bf(x1 * gm[nb]); ss += x1 * x1; }
            ss = half_sum(ss);
            if (r32 == 0) atomicAdd(rowss + m, ss); }
    }
}
__device__ __forceinline__ void p4_sample(Frame& F, const bf16* XN2, const bf16* Wgu, const float* rowss, const float* sbg, const float* sbu, bf16* H) {
    int tid = F.tid; asm volatile("" : "+v"(tid)); const int lane = tid & 63, r32 = lane & 31, hi = lane >> 5;
    const int gw = blockIdx.x + F.G * F.wave, NGW = F.G * NWAVES;
    for (int id = gw; id < 16 * (DFF / 32); id += NGW) {
        const int fg = id >> 4, rt = id & 15, m0 = MP + 32 * rt, f = 32 * fg + r32;
        f32x16 acc[2];
        int brow[2][4];
#pragma unroll
        for (int nb = 0; nb < 2; ++nb)
#pragma unroll
            for (int i = 0; i < 4; ++i) brow[nb][i] = dst_row(2 + nb, 32 * fg + 8 * i + (lane >> 3));
        wave_mm<2>(acc, F.lds + F.wave * 12288, XN2 + (size_t)m0 * DM, DM, Wgu, DM, brow, 0, DM, lane);
        const float bg = sbg[(size_t)(NBP + rt) * DFF + f], bu = sbu[(size_t)(NBP + rt) * DFF + f];
        float rsv[16];
#pragma unroll
        for (int r = 0; r < 16; ++r) rsv[r] = rowss[m0 + crow(r, hi)];
#pragma unroll
        for (int r = 0; r < 16; ++r) { const int m = m0 + crow(r, hi); const float rstd = rsqrtf(rsv[r] * (1.f / (float)DM) + EPSN);
            H[(size_t)m * DFF + f] = (bf16)f2bf(pg8::silu_f(acc[0][r] * rstd + bg) * (acc[1][r] * rstd + bu)); }
    }
}
__device__ __forceinline__ void p5_sample(Frame& F, const bf16* H, const bf16* Wdn, const float* mod) {
    int tid = F.tid; asm volatile("" : "+v"(tid)); const int lane = tid & 63, r32 = lane & 31, hi = lane >> 5;
    const int gw = blockIdx.x + F.G * F.wave, NGW = F.G * NWAVES;
    for (int id = gw; id < 16 * 4 * (DM / 64); id += NGW) {
        const int rt = id & 15, ksp = (id >> 4) & 3, cg = id >> 6, m0 = MP + 32 * rt, n0 = 64 * cg;
        f32x16 acc[2];
        int brow[2][4];
#pragma unroll
        for (int nb = 0; nb < 2; ++nb)
#pragma unroll
            for (int i = 0; i < 4; ++i) brow[nb][i] = dst_row(WOUT_MODE, n0 + 32 * nb + 8 * i + (lane >> 3));
        wave_mm<2>(acc, F.lds + F.wave * 12288, H + (size_t)m0 * DFF, DFF, Wdn, DFF, brow, ksp * (DFF / 4), (ksp + 1) * (DFF / 4), lane);
        const float* mb = mod + (size_t)(NBP + rt) * 6 * DM + 5 * DM;
#pragma unroll
        for (int nb = 0; nb < 2; ++nb) { const int col = n0 + 32 * nb + r32; const float gt = mb[col];
#pragma unroll
            for (int r = 0; r < 16; ++r) atomicAdd(F.out + OFF_Y + (size_t)(m0 + crow(r, hi)) * DM + col, gt * acc[nb][r]); }
    }
}
}

__global__ void __launch_bounds__(NWAVES * 64, 2) fwd_megakernel(Args args) {
    extern __shared__ __attribute__((aligned(16))) unsigned char lds[];
    Frame F;
    F.lds = (LAS unsigned char*)lds; F.MISC = (volatile LAS unsigned*)(F.lds + MISC_OFF);
    F.tid = threadIdx.x; F.lane = F.tid & 63; F.wave = __builtin_amdgcn_readfirstlane(F.tid >> 6); F.G = gridDim.x;
    F.A = &args;
    F.out = args.out; F.ws = args.ws; F.ctl = (gu32*)(args.ws + WS_CTL);
    for (int u = F.tid; u < (LDS_BYTES - LDSCTL_OFF) / 4; u += NWAVES * 64) ((LAS unsigned*)(F.lds + LDSCTL_OFF))[u] = 0u;
    __syncthreads();
    XcdBarrier bar = xcd_barrier_post((unsigned*)(F.ctl + CW_BAR), F.MISC + 8);

    bf16* act = (bf16*)(F.ws + WS_ACT); bf16* XN = (bf16*)(F.ws + WS_XN); bf16* OB = (bf16*)(F.ws + WS_OB); bf16* HB = (bf16*)(F.ws + WS_H);
    float* mod = (float*)(F.ws + WS_MOD); float* rowss = (float*)(F.ws + WS_ROWSS); float* sb2 = (float*)(F.ws + WS_SB2);

#ifndef PHM
#define PHM 127
#endif
    if (PHM & 1) p0a(F);
#ifdef PROBE_P0A
    xcd_barrier(bar); p0a(F, false);
#endif
    xcd_barrier(bar);
    if (PHM & 2) p0b(F);
#ifdef PROBE_P0B
    xcd_barrier(bar); p0b(F, false);
#endif
    xcd_barrier(bar);
    if (PHM & 4) {
        pg8::Gemm g{XN, (const bf16*)(F.ws + WS_WIN), MP, DIN, DM}; pg8::StaticOrder S; S.init(MP, DIN, F.G, (int)blockIdx.x);
        pg8::EpiIn E{act, F.out, F.A->in[12], F.A->in[13], (const float*)(F.ws + WS_ROT)};
        if (blockIdx.x & 1) { sg::p1_sample(F, XN, (const bf16*)(F.ws + WS_WIN), act); __syncthreads(); }
        pg8::gemm_phase<pg8::EpiIn, pg8::StaticOrder, true, true>(F.lds, g, S, E);
        if (!(blockIdx.x & 1)) sg::p1_sample(F, XN, (const bf16*)(F.ws + WS_WIN), act);
#ifdef PROBE_S
        __syncthreads(); sg::p1_sample(F, XN, (const bf16*)(F.ws + WS_WIN), act);
#endif
#ifdef PROBE_P1
        xcd_barrier(bar);
        pg8::gemm_phase<pg8::EpiIn, pg8::StaticOrder, true, true>(F.lds, g, S, E);
#endif
#ifdef PROBE_P1N
        xcd_barrier(bar);
        { pg8::EpiNull EN; pg8::gemm_phase<pg8::EpiNull, pg8::StaticOrder, true, true>(F.lds, g, S, EN); }
#endif
    }
    xcd_barrier(bar);
    if (PHM & 8) p2::phase2(F);
#ifdef PROBE_P2
    xcd_barrier(bar);
    p2::phase2(F, 1, PROBE_P2);
#endif
    xcd_barrier(bar);
    if (PHM & 16) {
        pg8::Gemm g{OB, (const bf16*)(F.ws + WS_WOUT), MP, DM, DM}; pg8::StaticOrder S; S.init(MP, DM, F.G, (int)blockIdx.x);
        pg8::EpiOut E{F.A->in[0], F.A->in[1], (bf16*)(F.ws + WS_X1B), XN, mod, (const float*)(F.ws + WS_GMOD2), rowss, 1.f};
        if (blockIdx.x & 1) { sg::p3_sample(F, OB, (const bf16*)(F.ws + WS_WOUT), XN, mod, rowss); __syncthreads(); }
        pg8::gemm_phase<pg8::EpiOut, pg8::StaticOrder, false, true>(F.lds, g, S, E);
#ifdef PROBE_P3
        xcd_barrier(bar);
        { pg8::EpiOut E2{F.A->in[0], F.A->in[1], (bf16*)(F.ws + WS_X1B), XN, mod, (const float*)(F.ws + WS_GMOD2), rowss, 0.f}; pg8::gemm_phase<pg8::EpiOut, pg8::StaticOrder, true, true>(F.lds, g, S, E2); }
#endif
        if (!(blockIdx.x & 1)) sg::p3_sample(F, OB, (const bf16*)(F.ws + WS_WOUT), XN, mod, rowss);
    }
    xcd_barrier(bar);
    if (PHM & 32) {
        pg8::Gemm g{XN, (const bf16*)(F.ws + WS_WGU), MP, NGU, DM}; pg8::StaticOrder S; S.init(MP, NGU, F.G, (int)blockIdx.x);
        pg8::EpiFF1 E{rowss, sb2, sb2 + (size_t)NBT * DFF, HB};
        if (blockIdx.x & 1) { sg::p4_sample(F, XN, (const bf16*)(F.ws + WS_WGU), rowss, sb2, sb2 + (size_t)NBT * DFF, HB); __syncthreads(); }
        pg8::gemm_phase<pg8::EpiFF1, pg8::StaticOrder, true, true>(F.lds, g, S, E);
        if (!(blockIdx.x & 1)) sg::p4_sample(F, XN, (const bf16*)(F.ws + WS_WGU), rowss, sb2, sb2 + (size_t)NBT * DFF, HB);
#ifdef PROBE_S
        __syncthreads(); sg::p4_sample(F, XN, (const bf16*)(F.ws + WS_WGU), rowss, sb2, sb2 + (size_t)NBT * DFF, HB);
#endif
#ifdef PROBE_P4
        xcd_barrier(bar);
        pg8::gemm_phase<pg8::EpiFF1, pg8::StaticOrder, true, true>(F.lds, g, S, E);
#endif
    }
    xcd_barrier(bar);
    if (PHM & 64) {
        pg8::Gemm g{HB, (const bf16*)(F.ws + WS_WDN), MP, DM, DFF}; pg8::StaticOrder S; S.init(MP, DM, F.G, (int)blockIdx.x);
        pg8::EpiFF2 E{F.out + OFF_Y, (const bf16*)(F.ws + WS_X1B), mod, 1.f};
        if (blockIdx.x & 1) { sg::p5_sample(F, HB, (const bf16*)(F.ws + WS_WDN), mod); __syncthreads(); }
        pg8::gemm_phase<pg8::EpiFF2, pg8::StaticOrder, false, true>(F.lds, g, S, E);
#ifdef PROBE_P5
        xcd_barrier(bar);
        { pg8::EpiFF2 E2{F.out + OFF_Y, (const bf16*)(F.ws + WS_X1B), mod, 1.f}; pg8::gemm_phase<pg8::EpiFF2, pg8::StaticOrder, true, true>(F.lds, g, S, E2); }
#endif
        if (!(blockIdx.x & 1)) sg::p5_sample(F, HB, (const bf16*)(F.ws + WS_WDN), mod);
    }
}

extern "C" void kernel_launch(void* const* d_in, const int* in_sizes, int n_in, void* d_out, int out_size, void* d_ws, size_t ws_size, hipStream_t stream) {
    static int grid = 0;
    if (grid == 0) {
        if (n_in != 24 || in_sizes[0] != MP * DM || (size_t)out_size != OUT_TOTAL || ws_size < WS_END) {
            fprintf(stderr, "kernel_launch: unexpected shapes: n_in %d in0 %d out %d ws %zu (need >= %zu)\n", n_in, n_in > 0 ? in_sizes[0] : -1, out_size, ws_size, (size_t)WS_END); grid = -1; return; }
        int dev = 0, cus = 0, per_cu = 0;
        if (hipGetDevice(&dev) != hipSuccess || hipDeviceGetAttribute(&cus, hipDeviceAttributeMultiprocessorCount, dev) != hipSuccess) { fprintf(stderr, "kernel_launch: device query failed\n"); grid = -1; return; }
        if (hipFuncSetAttribute((const void*)fwd_megakernel, hipFuncAttributeMaxDynamicSharedMemorySize, LDS_BYTES) != hipSuccess) { fprintf(stderr, "kernel_launch: hipFuncSetAttribute failed\n"); grid = -1; return; }
        if (hipOccupancyMaxActiveBlocksPerMultiprocessor(&per_cu, (const void*)fwd_megakernel, NWAVES * 64, LDS_BYTES) != hipSuccess || per_cu < 1) { fprintf(stderr, "kernel_launch: occupancy query says %d blocks/CU\n", per_cu); per_cu = 1; }
        (void)hipGetLastError();
        grid = cus;
    }
    if (grid < 0) return;
    if (hipMemsetAsync((char*)d_ws + WS_CTL, 0, CTL_ZERO_BYTES, stream) != hipSuccess) { fprintf(stderr, "kernel_launch: memset failed\n"); return; }
    Args a{};
    for (int i = 0; i < 24; ++i) a.in[i] = (const float*)d_in[i];
    a.out = (float*)d_out; a.ws = (unsigned char*)d_ws;
    void* kargs[] = {&a};
    hipError_t e = hipLaunchCooperativeKernel((const void*)fwd_megakernel, dim3(grid), dim3(NWAVES * 64), kargs, LDS_BYTES, stream);
    if (e != hipSuccess) fprintf(stderr, "kernel_launch: cooperative launch failed: %s (grid %d)\n", hipGetErrorString(e), grid);
}
```

```cpp
#include <hip/hip_runtime.h>
#include <hip/hip_bf16.h>
#include <cstdio>
#include <cstdint>
#include <cmath>

constexpr int DM = 1024, NBP = 4, SEQ = 8192, NBS = 16, LS = 32, PAST = 2048;
constexpr int MP = NBP * SEQ, MS = NBS * LS, MT = MP + MS;
constexpr int DIN = 3584, DFF = 2816, NGU = 2 * DFF, NBT = NBP + NBS;
constexpr float EPSN = 1e-6f;
constexpr float LOG2E = 1.4426950408889634f;
constexpr float QSCALE = 0.125f * LOG2E;
constexpr float LAM_INIT = 0.2f;
constexpr size_t OFF_Y = 0, OFF_KP = (size_t)MT * DM, OFF_VP = OFF_KP + (size_t)MP * 512, OFF_RP = OFF_VP + (size_t)MP * 512,
                 OFF_KS = OFF_RP + (size_t)NBP * 4 * 128 * 128, OFF_VS = OFF_KS + (size_t)MS * 512, OFF_RS = OFF_VS + (size_t)MS * 512,
                 OUT_TOTAL = OFF_RS + (size_t)NBS * 4 * 128 * 128;
__device__ __forceinline__ int row_batch(int row) { return row < MP ? (row >> 13) : NBP + ((row - MP) >> 5); }
__device__ __forceinline__ int row_pos(int row) { return row < MP ? (row & 8191) : PAST + ((row - MP) & 31); }

namespace pg8 {
#define PG8_LAS __attribute__((address_space(3)))
typedef unsigned short bf16_t;
typedef short bf16x8 __attribute__((ext_vector_type(8)));
typedef float f32x4 __attribute__((ext_vector_type(4)));
typedef unsigned u32x4 __attribute__((ext_vector_type(4)));
constexpr int BM = 256, BK = 64, HALF = 128, HTB = HALF * BK * 2  , STAGE_BYTES = 8 * HTB, NXCD = 8, WGM = 8;

__host__ __device__ __forceinline__ int lds_byte(int r, int c) { const int st = (r >> 4) * 2 + (c >> 5), rr = r & 15, cc = c & 31, ob = rr * 64 + cc * 2; return st * 1024 + (ob ^ (((ob >> 9) & 1) << 5)); }
__host__ __device__ __forceinline__ void stage_rc(int b, int& R, int& C) { const int st = b / 1024, sb = b % 1024, swz = sb ^ (((sb >> 9) & 1) << 5); R = (st >> 1) * 16 + swz / 64; C = (st & 1) * 32 + (swz % 64) / 2; }
__host__ __device__ __forceinline__ int perm32(int rho) { const int n = rho >> 4, i = rho & 15; return 8 * (i >> 2) + 4 * n + (i & 3); }

struct Unit { int pm, pn; };
struct Gemm { const bf16_t* A; const bf16_t* Bt; int M, N, K; };

struct StaticOrder {
    int nM, nN, nwg, G, c;
    __host__ __device__ void init(int M, int N, int G_, int c_) { nM = M / BM; nN = N / BM; nwg = nM * nN; G = G_; c = c_; }
    __host__ __device__ bool next(int i, Unit& u) const {
        const long L = (long)i * G + c; if (L >= nwg) return false;
        int wgid = (int)L; { const int q = nwg / NXCD, r = nwg % NXCD, xcd = wgid % NXCD, off = wgid / NXCD; wgid = (xcd < r ? xcd * (q + 1) : r * (q + 1) + (xcd - r) * q) + off; }
        const int nig = WGM * nN, gid = wgid / nig, fm = gid * WGM, gsz = (nM - fm) < WGM ? (nM - fm) : WGM;
        u.pm = fm + ((wgid % nig) % gsz); u.pn = (wgid % nig) / gsz; return true;
    }
    __device__ __forceinline__ void a_ready(const Unit&) const {}
    __device__ __forceinline__ void done(const Unit&) const {}
};

__device__ __forceinline__ unsigned cvt_pk_bf16(float lo, float hi) { unsigned r; asm volatile("v_cvt_pk_bf16_f32 %0, %1, %2" : "=v"(r) : "v"(lo), "v"(hi)); return r; }
typedef float f32x2 __attribute__((ext_vector_type(2)));
typedef unsigned u32x2 __attribute__((ext_vector_type(2)));
__device__ __forceinline__ void st_bf16x4(bf16_t* p, f32x4 v) { u32x2 w; w.x = cvt_pk_bf16(v[0], v[1]); w.y = cvt_pk_bf16(v[2], v[3]); *(u32x2*)p = w; }
__device__ __forceinline__ void st_bf16x8(bf16_t* p, f32x4 a, f32x4 c) { u32x4 w; w.x = cvt_pk_bf16(a[0], a[1]); w.y = cvt_pk_bf16(a[2], a[3]); w.z = cvt_pk_bf16(c[0], c[1]); w.w = cvt_pk_bf16(c[2], c[3]); *(u32x4*)p = w; }
__device__ __forceinline__ float silu_f(float z) { return z * __builtin_amdgcn_rcpf(1.f + __expf(-z)); }

struct EpiIn {
    static constexpr bool PERM = false, AFTER_DRAIN = false;
    bf16_t* act; float* out; const float* gq; const float* gk; const float* rot;
    __device__ __forceinline__ void operator()(const f32x4 (&acc)[2][2][4][2], const Unit& u, int wr, int wc, int fr, int fq) const {
        const int type = u.pn >> 1, half = u.pn & 1;
        const int lc0 = half * 256 + wc * 64 + fq * 8;
        bf16_t* dst = act + (size_t)type * ((size_t)MT * 512);
        const int rowb = u.pm * BM + wr * 64 + fr;
        if (type <= 1) {
            const float* g = type == 0 ? gq : gk; const float osc = type == 0 ? QSCALE : 1.f;
            f32x4 gv[2][2];
#pragma unroll
            for (int bj = 0; bj < 2; ++bj)
#pragma unroll
                for (int n = 0; n < 2; ++n) gv[bj][n] = *(const f32x4*)(g + bj * 32 + fq * 8 + n * 4);
#pragma unroll
            for (int ai = 0; ai < 2; ++ai)
#pragma unroll
                for (int m = 0; m < 4; ++m) {
                    const int row = rowb + ai * HALF + m * 16;
                    float ss = 0.f;
#pragma unroll
                    for (int bj = 0; bj < 2; ++bj)
#pragma unroll
                        for (int n = 0; n < 2; ++n) { const f32x4 v = acc[ai][bj][m][n]; ss += (v[0] * v[0] + v[1] * v[1]) + (v[2] * v[2] + v[3] * v[3]); }
                    ss += __shfl_xor(ss, 16); ss += __shfl_xor(ss, 32);
                    const float rinv = rsqrtf(ss * (1.f / 64.f) + EPSN);
                    float* ko = (row < MP ? out + OFF_KP + (size_t)row * 512 : out + OFF_KS + (size_t)(row - MP) * 512) + lc0;
                    bf16_t* bo = dst + (size_t)row * 512 + lc0;
#pragma unroll
                    for (int bj = 0; bj < 2; ++bj) { const f32x4 y0 = acc[ai][bj][m][0] * rinv * gv[bj][0], y1 = acc[ai][bj][m][1] * rinv * gv[bj][1];
                        if (type == 1) { __builtin_nontemporal_store(y0, (f32x4*)(ko + bj * 32)); __builtin_nontemporal_store(y1, (f32x4*)(ko + bj * 32 + 4));     }
                        st_bf16x8(bo + bj * 32, y0 * osc, y1 * osc); }
                }
        } else if (type == 2) {
#pragma unroll
            for (int ai = 0; ai < 2; ++ai)
#pragma unroll
                for (int m = 0; m < 4; ++m) {
                    const int row = rowb + ai * HALF + m * 16;
                    float* vo = (row < MP ? out + OFF_VP + (size_t)row * 512 : out + OFF_VS + (size_t)(row - MP) * 512) + lc0;
                    bf16_t* bo = dst + (size_t)row * 512 + lc0;
#pragma unroll
                    for (int bj = 0; bj < 2; ++bj) { const f32x4 y0 = acc[ai][bj][m][0], y1 = acc[ai][bj][m][1];
                        __builtin_nontemporal_store(y0, (f32x4*)(vo + bj * 32)); __builtin_nontemporal_store(y1, (f32x4*)(vo + bj * 32 + 4)); st_bf16x8(bo + bj * 32, y0, y1); }
                }
        } else if (type == 3 || type == 4) {
            const int h = half * 2 + (wc >> 1);
            const float l2g = __log2f(1.f - exp2f(-5.f - (float)h));
#pragma unroll
            for (int ai = 0; ai < 2; ++ai) {
                f32x4 cs[4][2][2];
#pragma unroll
                for (int m = 0; m < 4; ++m) { const float* rp = rot + (size_t)row_pos(rowb + ai * HALF + m * 16) * 128;
#pragma unroll
                    for (int bj = 0; bj < 2; ++bj)
#pragma unroll
                        for (int n = 0; n < 2; ++n) cs[m][bj][n] = *(const f32x4*)(rp + ((lc0 + bj * 32 + n * 4) & 127)); }
#pragma unroll
                for (int m = 0; m < 4; ++m) {
                    const int row = rowb + ai * HALF + m * 16;
                    float ksc = 1.f;
                    if (type == 4) { const int e = row < MP ? 63 - (row & 63) : 31 - ((row - MP) & 31); ksc = 0.08838834764831845f * exp2f((float)e * l2g); }
                    bf16_t* bo = dst + (size_t)row * 512 + lc0;
#pragma unroll
                    for (int bj = 0; bj < 2; ++bj) { f32x4 y[2];
#pragma unroll
                        for (int n = 0; n < 2; ++n) { const f32x4 c4 = cs[m][bj][n]; const f32x4 v = acc[ai][bj][m][n];
                            y[n][0] = v[0] * c4[0] - v[1] * c4[1]; y[n][1] = v[0] * c4[1] + v[1] * c4[0]; y[n][2] = v[2] * c4[2] - v[3] * c4[3]; y[n][3] = v[2] * c4[3] + v[3] * c4[2]; }
                        st_bf16x8(bo + bj * 32, y[0] * ksc, y[1] * ksc); }
                }
            }
        } else {
#pragma unroll
            for (int ai = 0; ai < 2; ++ai)
#pragma unroll
                for (int m = 0; m < 4; ++m) {
                    const int row = rowb + ai * HALF + m * 16;
                    bf16_t* bo = dst + (size_t)row * 512 + lc0;
#pragma unroll
                    for (int bj = 0; bj < 2; ++bj) { f32x4 y[2];
#pragma unroll
                        for (int n = 0; n < 2; ++n) { y[n] = acc[ai][bj][m][n];
                            if (type == 6) { y[n][0] = silu_f(y[n][0]); y[n][1] = silu_f(y[n][1]); y[n][2] = silu_f(y[n][2]); y[n][3] = silu_f(y[n][3]); } }
                        st_bf16x8(bo + bj * 32, y[0], y[1]); }
                }
        }
    }
};

struct EpiOut {
    static constexpr bool PERM = false, AFTER_DRAIN = false;
    const float* xp; const float* xs; bf16_t* x1b; bf16_t* xn2; const float* mod; const float* gmod2; float* rowss; float psc;
    __device__ __forceinline__ void operator()(const f32x4 (&acc)[2][2][4][2], const Unit& u, int wr, int wc, int fr, int fq) const {
        const int col0 = u.pn * BM + wc * 32 + 8 * fq, rowb = u.pm * BM + wr * 64 + fr;
        const int b = (u.pm * BM) >> 13;
        const float* mb = mod + (size_t)b * (6 * DM) + 2 * DM + col0; const float* gm = gmod2 + (size_t)b * DM + col0;
        f32x4 gt[2][2], gg[2][2];
#pragma unroll
        for (int bj = 0; bj < 2; ++bj)
#pragma unroll
            for (int n = 0; n < 2; ++n) { gt[bj][n] = *(const f32x4*)(mb + bj * HALF + n * 4); gg[bj][n] = *(const f32x4*)(gm + bj * HALF + n * 4); }
#pragma unroll
        for (int am = 0; am < 4; ++am) { const int ai = am >> 1;
            f32x4 xv[2][2][2];
#pragma unroll
            for (int mm = 0; mm < 2; ++mm) { const float* xr = xp + (size_t)(rowb + ai * HALF + ((am & 1) * 2 + mm) * 16) * DM + col0;
#pragma unroll
                for (int bj = 0; bj < 2; ++bj)
#pragma unroll
                    for (int n = 0; n < 2; ++n) xv[mm][bj][n] = __builtin_nontemporal_load((const f32x4*)(xr + bj * HALF + n * 4)); }
#pragma unroll
            for (int mm = 0; mm < 2; ++mm) { const int m = (am & 1) * 2 + mm;
                const int row = rowb + ai * HALF + m * 16;
                bf16_t* yo = x1b + (size_t)row * DM + col0; bf16_t* no = xn2 + (size_t)row * DM + col0;
                float ss = 0.f;
#pragma unroll
                for (int bj = 0; bj < 2; ++bj) { f32x4 x1[2];
#pragma unroll
                    for (int n = 0; n < 2; ++n) { const int o = bj * HALF + n * 4;
                        x1[n] = xv[mm][bj][n] + gt[bj][n] * acc[ai][bj][m][n];
                        ss += (x1[n][0] * x1[n][0] + x1[n][1] * x1[n][1]) + (x1[n][2] * x1[n][2] + x1[n][3] * x1[n][3]); }
                    { u32x4 w_; w_.x = cvt_pk_bf16(x1[0][0], x1[0][1]); w_.y = cvt_pk_bf16(x1[0][2], x1[0][3]); w_.z = cvt_pk_bf16(x1[1][0], x1[1][1]); w_.w = cvt_pk_bf16(x1[1][2], x1[1][3]); __builtin_nontemporal_store(w_, (u32x4*)(yo + bj * HALF)); }
                    st_bf16x8(no + bj * HALF, x1[0] * gg[bj][0], x1[1] * gg[bj][1]); }
                ss += __shfl_xor(ss, 16); ss += __shfl_xor(ss, 32);
                if (fq == 0) atomicAdd(rowss + row, ss * psc);
            }
            asm volatile("" ::: "memory");
        }
    }
};

struct EpiFF1 {
    static constexpr bool PERM = false, AFTER_DRAIN = false;
    const float* rowss; const float* sbg; const float* sbu; bf16_t* H;
    __device__ __forceinline__ void operator()(const f32x4 (&acc)[2][2][4][2], const Unit& u, int wr, int wc, int fr, int fq) const {
        const int f0 = u.pn * 128 + wc * 32 + fq * 8, rowb = u.pm * BM + wr * 64 + fr;
        const int b = (u.pm * BM) >> 13;
        f32x4 bg[2], bu[2]; float rs[2][4];
#pragma unroll
        for (int n = 0; n < 2; ++n) { bg[n] = *(const f32x4*)(sbg + (size_t)b * DFF + f0 + n * 4); bu[n] = *(const f32x4*)(sbu + (size_t)b * DFF + f0 + n * 4); }
#pragma unroll
        for (int ai = 0; ai < 2; ++ai)
#pragma unroll
            for (int m = 0; m < 4; ++m) rs[ai][m] = rowss[rowb + ai * HALF + m * 16];
#pragma unroll
        for (int ai = 0; ai < 2; ++ai)
#pragma unroll
            for (int m = 0; m < 4; ++m) {
                const int row = rowb + ai * HALF + m * 16;
                const float rstd = rsqrtf(rs[ai][m] * (1.f / (float)DM) + EPSN);
                u32x2 w2[2];
#pragma unroll
                for (int n = 0; n < 2; ++n) {
                    const f32x4 hg = acc[ai][0][m][n] * rstd + bg[n];
                    const f32x4 hu = acc[ai][1][m][n] * rstd + bu[n];
                    w2[n].x = cvt_pk_bf16(silu_f(hg[0]) * hu[0], silu_f(hg[1]) * hu[1]); w2[n].y = cvt_pk_bf16(silu_f(hg[2]) * hu[2], silu_f(hg[3]) * hu[3]); }
                u32x4 w4; w4.x = w2[0].x; w4.y = w2[0].y; w4.z = w2[1].x; w4.w = w2[1].y;
                *(u32x4*)(H + (size_t)row * DFF + f0) = w4;
            }
    }
};

struct EpiFF2 {
    static constexpr bool PERM = false, AFTER_DRAIN = false;
    float* y; const bf16_t* x1b; const float* mod; float psc;
    __device__ __forceinline__ void operator()(const f32x4 (&acc)[2][2][4][2], const Unit& u, int wr, int wc, int fr, int fq) const {
        const int col0 = u.pn * BM + wc * 32 + 8 * fq, rowb = u.pm * BM + wr * 64 + fr;
        const float* mb = mod + (size_t)((u.pm * BM) >> 13) * (6 * DM) + 5 * DM + col0;
        f32x4 gt[2][2];
#pragma unroll
        for (int bj = 0; bj < 2; ++bj)
#pragma unroll
            for (int n = 0; n < 2; ++n) gt[bj][n] = *(const f32x4*)(mb + bj * HALF + n * 4) * psc;
#pragma unroll
        for (int ai = 0; ai < 2; ++ai) {
            u32x4 xv[4][2];
#pragma unroll
            for (int m = 0; m < 4; ++m) { const bf16_t* xr = x1b + (size_t)(rowb + ai * HALF + m * 16) * DM + col0;
#pragma unroll
                for (int bj = 0; bj < 2; ++bj) xv[m][bj] = __builtin_nontemporal_load((const u32x4*)(xr + bj * HALF)); }
#pragma unroll
            for (int m = 0; m < 4; ++m) { float* yo = y + (size_t)(rowb + ai * HALF + m * 16) * DM + col0;
#pragma unroll
                for (int bj = 0; bj < 2; ++bj) { const u32x4 w = xv[m][bj];
                    f32x4 x0, x1;
                    x0[0] = __uint_as_float(w.x << 16); x0[1] = __uint_as_float(w.x & 0xffff0000u); x0[2] = __uint_as_float(w.y << 16); x0[3] = __uint_as_float(w.y & 0xffff0000u);
                    x1[0] = __uint_as_float(w.z << 16); x1[1] = __uint_as_float(w.z & 0xffff0000u); x1[2] = __uint_as_float(w.w << 16); x1[3] = __uint_as_float(w.w & 0xffff0000u);
                    __builtin_nontemporal_store(x0 + gt[bj][0] * acc[ai][bj][m][0], (f32x4*)(yo + bj * HALF));
                    __builtin_nontemporal_store(x1 + gt[bj][1] * acc[ai][bj][m][1], (f32x4*)(yo + bj * HALF + 4)); } }
            asm volatile("" ::: "memory");
        }
    }
};

struct EpiNull {
    static constexpr bool PERM = false, AFTER_DRAIN = false;
    __device__ __forceinline__ void operator()(const f32x4 (&acc)[2][2][4][2], const Unit& u, int wr, int wc, int fr, int fq) const {
#pragma unroll
        for (int ai = 0; ai < 2; ++ai)
#pragma unroll
            for (int bj = 0; bj < 2; ++bj)
#pragma unroll
                for (int m = 0; m < 4; ++m)
#pragma unroll
                    for (int n = 0; n < 2; ++n) asm volatile("" :: "v"(acc[ai][bj][m][n]));
    }
};
template <class Epi, class Sched, bool ALIGN_EPI = false, bool SP2 = false>
__device__ __forceinline__ void gemm_phase(PG8_LAS unsigned char* lds, const Gemm g, const Sched& S, const Epi& E) {
    int tid = threadIdx.x; asm volatile("" : "+v"(tid));
    const int wid = __builtin_amdgcn_readfirstlane(tid >> 6), lane = tid & 63, wr = wid >> 2, wc = wid & 3, fr = lane & 15, fq = lane >> 4;
    const int K = g.K, nt = K / BK;
    unsigned voffA[2], voffB[2];
#pragma unroll
    for (int i = 0; i < 2; ++i) { int R, C; stage_rc(tid * 16 + i * 8192, R, C); const int Rb = Epi::PERM ? ((R & ~31) + perm32(R & 31)) : R;
        voffA[i] = (unsigned)(R * K + C) * 2u; voffB[i] = (unsigned)(Rb * K + C) * 2u; }
    const size_t kstep = (size_t)(BK * 2);
    const size_t hstep = (size_t)HALF * K * 2;
    const size_t tstep = 2 * hstep;
    const unsigned ldsw = (unsigned)wid * 1024u;
    const int aoff = lds_byte(wr * 64 + fr, fq * 8), boff = lds_byte(wc * 32 + fr, fq * 8);
#define PG8_SA(b, h) (((b) * 2 + (h)) * HTB)
#define PG8_SB(b, h) ((4 + (b) * 2 + (h)) * HTB)
#define PG8_STAGE(bufoff, gbase, voff) do { _Pragma("unroll") for (int _i = 0; _i < 2; ++_i) \
        __builtin_amdgcn_global_load_lds((const unsigned*)((const char*)(gbase) + (voff)[_i]), (PG8_LAS unsigned*)(lds + (bufoff) + ldsw + _i * 8192), 16, 0, 0); } while (0)
#define PG8_LDA(dst, b, h) do { _Pragma("unroll") for (int m = 0; m < 4; ++m) _Pragma("unroll") for (int k = 0; k < 2; ++k) dst[m][k] = *(const PG8_LAS bf16x8*)(lds + PG8_SA(b, h) + aoff + m * 2048 + k * 1024); } while (0)
#define PG8_LDB(dst, b, h) do { _Pragma("unroll") for (int n = 0; n < 2; ++n) _Pragma("unroll") for (int k = 0; k < 2; ++k) dst[n][k] = *(const PG8_LAS bf16x8*)(lds + PG8_SB(b, h) + boff + n * 2048 + k * 1024); } while (0)
#define PG8_MMA(ai, bj, At, Bt) do { __builtin_amdgcn_s_setprio(1); _Pragma("unroll") for (int m = 0; m < 4; ++m) _Pragma("unroll") for (int n = 0; n < 2; ++n) _Pragma("unroll") for (int k = 0; k < 2; ++k) \
        acc[ai][bj][m][n] = __builtin_amdgcn_mfma_f32_16x16x32_bf16(Bt[n][k], At[m][k], acc[ai][bj][m][n], 0, 0, 0); __builtin_amdgcn_s_setprio(0); } while (0)
#define PG8_WAIT_V(n) asm volatile("s_waitcnt vmcnt(" #n ")" ::: "memory")
#define PG8_WAIT_L(n) asm volatile("s_waitcnt lgkmcnt(" #n ")" ::: "memory")
#define PG8_BAR __builtin_amdgcn_s_barrier()
#define PG8_SCHED __builtin_amdgcn_sched_barrier(0)
    Unit cur, nxt; int ui = 0;
    if (!S.next(0, cur)) return;
    f32x4 acc[2][2][4][2];
#pragma unroll
    for (int a = 0; a < 2; ++a)
#pragma unroll
        for (int b = 0; b < 2; ++b)
#pragma unroll
            for (int m = 0; m < 4; ++m)
#pragma unroll
                for (int n = 0; n < 2; ++n) acc[a][b][m][n] = (f32x4){0.f, 0.f, 0.f, 0.f};
    bf16x8 At[4][2], B0[2][2], B1[2][2];
    const char* cA = (const char*)g.A + (size_t)cur.pm * tstep; const char* cB = (const char*)g.Bt + (size_t)cur.pn * tstep;
    S.a_ready(cur);
    if constexpr (SP2) {
        PG8_STAGE(PG8_SB(0, 0), cB, voffB); PG8_STAGE(PG8_SB(0, 1), cB + hstep, voffB); PG8_STAGE(PG8_SA(0, 0), cA, voffA); PG8_STAGE(PG8_SA(0, 1), cA + hstep, voffA);
        if (wr == 1) PG8_BAR;
        PG8_WAIT_V(2); PG8_BAR;
        PG8_STAGE(PG8_SB(1, 0), cB + kstep, voffB); PG8_STAGE(PG8_SA(1, 0), cA + kstep, voffA); PG8_STAGE(PG8_SB(1, 1), cB + hstep + kstep, voffB);
        PG8_WAIT_V(6); PG8_BAR;
    } else {
        PG8_STAGE(PG8_SB(0, 0), cB, voffB); PG8_STAGE(PG8_SA(0, 0), cA, voffA); PG8_STAGE(PG8_SB(0, 1), cB + hstep, voffB); PG8_STAGE(PG8_SA(0, 1), cA + hstep, voffA);
        if (wr == 1) PG8_BAR;
        PG8_WAIT_V(4); PG8_BAR;
        PG8_STAGE(PG8_SB(1, 0), cB + kstep, voffB); PG8_STAGE(PG8_SA(1, 0), cA + kstep, voffA); PG8_STAGE(PG8_SB(1, 1), cB + hstep + kstep, voffB);
        PG8_WAIT_V(6); PG8_BAR;
    }
    for (;;) {
        const bool has_next = S.next(ui + 1, nxt);
        const char* nA = has_next ? (const char*)g.A + (size_t)nxt.pm * tstep : cA; const char* nB = has_next ? (const char*)g.Bt + (size_t)nxt.pn * tstep : cB;
        for (int t = 0; t < nt; t += 2) {
            const bool last = (t == nt - 2);
            const char* a1 = cA + (size_t)(t + 1) * kstep;
            const char* a2 = last ? nA : cA + (size_t)(t + 2) * kstep; const char* b2 = last ? nB : cB + (size_t)(t + 2) * kstep;
            const char* a3 = a2 + kstep; const char* b3 = b2 + kstep;
            if (last && has_next) S.a_ready(nxt);
            if constexpr (SP2) {
            PG8_LDB(B0, 0, 0); PG8_LDB(B1, 0, 1); PG8_SCHED; PG8_LDA(At, 0, 0); PG8_STAGE(PG8_SA(1, 1), a1 + hstep, voffA);
            PG8_WAIT_V(8); PG8_WAIT_L(0); PG8_BAR; PG8_MMA(0, 0, At, B0); PG8_MMA(0, 1, At, B1); PG8_BAR; PG8_SCHED;
            PG8_LDA(At, 0, 1); PG8_STAGE(PG8_SB(0, 0), b2, voffB); PG8_STAGE(PG8_SB(0, 1), b2 + hstep, voffB); PG8_STAGE(PG8_SA(0, 0), a2, voffA);
            PG8_WAIT_V(8); PG8_WAIT_L(0); PG8_BAR; PG8_MMA(1, 0, At, B0); PG8_MMA(1, 1, At, B1); PG8_BAR; PG8_SCHED;
            PG8_LDB(B0, 1, 0); PG8_LDB(B1, 1, 1); PG8_SCHED; PG8_LDA(At, 1, 0); PG8_STAGE(PG8_SA(0, 1), a2 + hstep, voffA);
            PG8_WAIT_V(8); PG8_WAIT_L(0); PG8_BAR; PG8_MMA(0, 0, At, B0); PG8_MMA(0, 1, At, B1); PG8_BAR; PG8_SCHED;
            PG8_LDA(At, 1, 1); PG8_STAGE(PG8_SB(1, 0), b3, voffB); PG8_STAGE(PG8_SB(1, 1), b3 + hstep, voffB); PG8_STAGE(PG8_SA(1, 0), a3, voffA);
            PG8_WAIT_V(8); PG8_WAIT_L(0); PG8_BAR; PG8_MMA(1, 0, At, B0); PG8_MMA(1, 1, At, B1); PG8_BAR; PG8_SCHED;
            } else {
            PG8_LDB(B0, 0, 0); PG8_SCHED; PG8_LDA(At, 0, 0); PG8_STAGE(PG8_SA(1, 1), a1 + hstep, voffA);
            PG8_WAIT_L(8); PG8_BAR; PG8_WAIT_L(0); PG8_MMA(0, 0, At, B0); PG8_BAR; PG8_SCHED;
            PG8_LDB(B1, 0, 1); PG8_STAGE(PG8_SB(0, 0), b2, voffB);
            PG8_BAR; PG8_WAIT_L(0); PG8_MMA(0, 1, At, B1); PG8_BAR;
            PG8_LDA(At, 0, 1); PG8_STAGE(PG8_SA(0, 0), a2, voffA);
            PG8_BAR; PG8_WAIT_L(0); PG8_MMA(1, 0, At, B0); PG8_BAR; PG8_SCHED;
            PG8_STAGE(PG8_SB(0, 1), b2 + hstep, voffB);
            PG8_WAIT_V(6); PG8_BAR; PG8_MMA(1, 1, At, B1); PG8_BAR;
            PG8_LDB(B0, 1, 0); PG8_SCHED; PG8_LDA(At, 1, 0); PG8_STAGE(PG8_SA(0, 1), a2 + hstep, voffA);
            PG8_WAIT_L(8); PG8_BAR; PG8_WAIT_L(0); PG8_MMA(0, 0, At, B0); PG8_BAR; PG8_SCHED;
            PG8_LDB(B1, 1, 1); PG8_STAGE(PG8_SB(1, 0), b3, voffB);
            PG8_BAR; PG8_WAIT_L(0); PG8_MMA(0, 1, At, B1); PG8_BAR;
            PG8_LDA(At, 1, 1); PG8_STAGE(PG8_SA(1, 0), a3, voffA);
            PG8_BAR; PG8_WAIT_L(0); PG8_MMA(1, 0, At, B0); PG8_BAR; PG8_SCHED;
            PG8_STAGE(PG8_SB(1, 1), b3 + hstep, voffB);
            PG8_WAIT_V(6); PG8_BAR; PG8_MMA(1, 1, At, B1); PG8_BAR;
            }
        }
        if constexpr (ALIGN_EPI) { if (wr == 0) PG8_BAR; }
        if constexpr (!Epi::AFTER_DRAIN) { E(acc, cur, wr, wc, fr, fq); S.done(cur); }
        if (!has_next) break;
#pragma unroll
        for (int a = 0; a < 2; ++a)
#pragma unroll
            for (int b = 0; b < 2; ++b)
#pragma unroll
                for (int m = 0; m < 4; ++m)
#pragma unroll
                    for (int n = 0; n < 2; ++n) acc[a][b][m][n] = (f32x4){0.f, 0.f, 0.f, 0.f};
        cur = nxt; cA = nA; cB = nB; ++ui;
        if constexpr (ALIGN_EPI) { if (wr == 1) PG8_BAR; }
    }
    PG8_WAIT_V(0);
    if constexpr (!ALIGN_EPI) { if (wr == 0) PG8_BAR; }
    PG8_BAR;
    if constexpr (Epi::AFTER_DRAIN) { E.fused(acc, cur, wr, wc, fr, fq, lds, wid, lane); S.done(cur); }
#undef PG8_SA
#undef PG8_SB
#undef PG8_STAGE
#undef PG8_LDA
#undef PG8_LDB
#undef PG8_MMA
#undef PG8_WAIT_V
#undef PG8_WAIT_L
#undef PG8_BAR
#undef PG8_SCHED
}
}
#define GAS __attribute__((address_space(1)))
#define LAS __attribute__((address_space(3)))
typedef unsigned short bf16;
typedef unsigned v4u __attribute__((ext_vector_type(4)));
typedef float f32x4 __attribute__((ext_vector_type(4)));
typedef short bf16x8 __attribute__((ext_vector_type(8)));
typedef GAS unsigned gu32;
typedef GAS unsigned long long gu64;
#define RLX_AGENT __ATOMIC_RELAXED, __HIP_MEMORY_SCOPE_AGENT
#define LDS_WAIT() asm volatile("s_waitcnt lgkmcnt(0)" ::: "memory")
#define VM_WAIT() asm volatile("s_waitcnt vmcnt(0)" ::: "memory")
__device__ __forceinline__ unsigned long long rt() { return __builtin_amdgcn_s_memrealtime(); }
__device__ __forceinline__ unsigned f2bf(float f) { unsigned u = __builtin_bit_cast(unsigned, f); return (u + 0x7fffu + ((u >> 16) & 1u)) >> 16; }
__device__ __forceinline__ unsigned pk2(float lo, float hi) { return f2bf(lo) | (f2bf(hi) << 16); }

#define XB_TMO      128
#define XB_XCNT(j)  (256  + 64 * (j))
#define XB_XSUB(j)  (1280 + 64 * (j))
#define XB_XGEN(j)  (2304 + 64 * (j))
#define XB_TOP      3328
#define XB_TOPGEN   3392
#define XCD_BAR_WORDS 3456
#define XB_SPIN_CAP (1u << 18)

__device__ __forceinline__ unsigned xb_ld(unsigned* p)              { return __hip_atomic_load(p, __ATOMIC_RELAXED, __HIP_MEMORY_SCOPE_AGENT); }
__device__ __forceinline__ unsigned xb_add(unsigned* p, unsigned v) { return __hip_atomic_fetch_add(p, v, __ATOMIC_RELAXED, __HIP_MEMORY_SCOPE_AGENT); }
__device__ __forceinline__ unsigned xb_xcc_id() { return (unsigned)__builtin_amdgcn_s_getreg((3 << 11) | 20) & 0xFu; }
#define XB_SPIN(cond, bar) do { unsigned _sp = 0; while (cond) { __builtin_amdgcn_s_sleep(1); \
    if ((++_sp & 255u) == 0u) { if (xb_ld(&(bar)[XB_TMO])) break; if (_sp > XB_SPIN_CAP) { atomicAdd(&(bar)[XB_TMO], 1u); break; } } } } while (0)

struct XcdBarrier {
    unsigned* bar; unsigned x;
    volatile LAS unsigned* st;
};

__device__ __forceinline__ XcdBarrier xcd_barrier_post(unsigned* bar, volatile LAS unsigned* st) {
    XcdBarrier b; b.bar = bar; b.x = xb_xcc_id(); b.st = st;
    if (threadIdx.x == 0) (void)xb_add(&bar[XB_XCNT(b.x)], 1u);
    return b;
}
__device__ __forceinline__ void xcd_barrier_complete(unsigned* bar, unsigned x, unsigned& nloc, unsigned& nx) {
    const unsigned G = gridDim.x * gridDim.y * gridDim.z;
    unsigned sum, cnt, mine, sp = 0u;
    for (;;) {
        sum = 0u; cnt = 0u; mine = 0u;
#pragma unroll
        for (unsigned j = 0; j < 16; ++j) { const unsigned c = xb_ld(&bar[XB_XCNT(j)]); sum += c; cnt += (c > 0u) ? 1u : 0u; mine = (j == x) ? c : mine; }
        if (sum == G) break;
        __builtin_amdgcn_s_sleep(1);
        if ((++sp & 255u) == 0u) { if (xb_ld(&bar[XB_TMO])) break; if (sp > XB_SPIN_CAP) { atomicAdd(&bar[XB_TMO], 1u); break; } }
    }
    nloc = mine > 0u ? mine : 1u; nx = cnt > 0u ? cnt : 1u;
}

__device__ __forceinline__ void xcd_barrier(const XcdBarrier& b) {
    asm volatile("s_waitcnt vmcnt(0)" ::: "memory");
    __syncthreads();
    if (threadIdx.x == 0) {
        unsigned* bar = b.bar;
        __builtin_amdgcn_s_waitcnt(0);
        unsigned nloc = b.st[0], nx = b.st[1];
        if (nloc == 0u) { xcd_barrier_complete(bar, b.x, nloc, nx); b.st[0] = nloc; b.st[1] = nx; }
        const unsigned old = xb_add(&bar[XB_XSUB(b.x)], 1u);
        const unsigned gen = old / nloc;
        if (old + 1u == (gen + 1u) * nloc) {
            __builtin_amdgcn_fence(__ATOMIC_RELEASE, "agent");
            asm volatile("s_waitcnt vmcnt(0)" ::: "memory");
            const unsigned og = xb_add(&bar[XB_TOP], 1u);
            const unsigned tg = og / nx;
            if (og + 1u == (tg + 1u) * nx) xb_add(&bar[XB_TOPGEN], 1u);
            else XB_SPIN(xb_ld(&bar[XB_TOPGEN]) == tg, bar);
            __builtin_amdgcn_fence(__ATOMIC_ACQUIRE, "agent");
            xb_add(&bar[XB_XGEN(b.x)], 1u);
            asm volatile("s_waitcnt vmcnt(0)" ::: "memory");
        } else {
            XB_SPIN(xb_ld(&bar[XB_XGEN(b.x)]) == gen, bar);
            __builtin_amdgcn_fence(__ATOMIC_ACQUIRE, "agent");
            asm volatile("s_waitcnt vmcnt(0)" ::: "memory");
        }
    }
    __syncthreads();
}

constexpr size_t MiB = 1u << 20;
constexpr size_t WS_CTL = 0, CTL_ZERO_BYTES = 2 * MiB;
constexpr size_t WS_ROWSS = 256 * 1024, WS_MOD = 512 * 1024, WS_SB2 = 1 * MiB, WS_GMOD2 = 1536 * 1024;
constexpr size_t WS_ROT = 2 * MiB, WS_WIN = 6 * MiB, WS_WOUT = 13 * MiB, WS_WGU = 15 * MiB, WS_WDN = 26 * MiB;
constexpr size_t WS_XN = 32 * MiB, WS_OB = 97 * MiB, WS_ACT = 162 * MiB, WS_H = WS_ACT, WS_E = 390 * MiB, WS_X1B = 398 * MiB, WS_END = 463 * MiB;
constexpr size_t ACT_STRIDE = (size_t)MT * 512;
static_assert(WS_ROWSS + (size_t)MT * 4 <= WS_MOD && WS_MOD + (size_t)NBT * 6 * DM * 4 <= WS_SB2 && WS_SB2 + (size_t)2 * NBT * DFF * 4 <= WS_GMOD2 && WS_GMOD2 + (size_t)NBT * DM * 4 <= CTL_ZERO_BYTES, "ctl map");
static_assert(WS_WIN + (size_t)DIN * DM * 2 <= WS_WOUT && WS_WGU + (size_t)NGU * DM * 2 <= WS_WDN && WS_WDN + (size_t)DM * DFF * 2 <= WS_XN, "weights map");
static_assert(WS_XN + (size_t)MT * DM * 2 <= WS_OB && WS_OB + (size_t)MT * DM * 2 <= WS_ACT && WS_ACT + 7 * ACT_STRIDE * 2 <= WS_E && WS_X1B + (size_t)MP * DM * 2 <= WS_END && WS_H + (size_t)MT * DFF * 2 <= WS_END, "act map");
constexpr int CW_BAR = 4096;
constexpr int CW_QUEUE = 16384;
constexpr int CW_CNTA = 20480;
constexpr int RING_BYTES = 131072, LDSCTL_OFF = RING_BYTES, MISC_OFF = LDSCTL_OFF + 320;
constexpr int TAB_OFF = 132096, CB_OFF = TAB_OFF + 4096, WSC_OFF = CB_OFF + 64, QSLOT_OFF = WSC_OFF + 8 * 256, LDS_BYTES = 147456;
static_assert(QSLOT_OFF + 64 <= LDS_BYTES && MISC_OFF + 128 <= TAB_OFF, "LDS map");
constexpr int NWAVES = 8;
constexpr int WOUT_MODE = 4;

struct Args { const float* in[24]; float* out; unsigned char* ws; };
struct Frame {
    LAS unsigned char* lds; volatile LAS unsigned* MISC; gu32* ctl; int tid, lane, wave, G;
    const Args* A; float* out; unsigned char* ws;
};

__device__ __forceinline__ int dst_row(int mode, int n) {
    if (mode == 0) return n;
    if (mode == 1) { const int l = n & 255;
        return (n & ~255) + 128 * ((l >> 5) & 1) + 32 * (l >> 6) + 16 * ((l >> 2) & 1) + 4 * ((l >> 3) & 3) + (l & 3); }
    if (mode == 4) { const int l = n & 127;
        return (n & ~127) + 32 * (l >> 5) + 16 * ((l >> 2) & 1) + 4 * ((l >> 3) & 3) + (l & 3); }
    const int fl = n & 127;
    return (n >> 7) * 256 + 128 * (mode - 2) + 32 * (fl >> 5) + 16 * ((fl >> 2) & 1) + 4 * ((fl >> 3) & 3) + (fl & 3);
}
__device__ __forceinline__ void p0_transpose_item(const float* W, int K, int N, bf16* WT, int mode, LAS float* scr, int item, int lane) {
    const int nblk = N / 32, kb = item / nblk, nb = item % nblk, k0 = 64 * kb, n0 = 32 * nb;
#pragma unroll
    for (int i = 0; i < 32; ++i) { const int kk = 2 * i + (lane >> 5); scr[kk * 33 + (lane & 31)] = __builtin_nontemporal_load(W + (size_t)(k0 + kk) * N + n0 + (lane & 31)); }
    LDS_WAIT(); asm volatile("" ::: "memory");
    const int c = lane & 7;
#pragma unroll
    for (int j = 0; j < 4; ++j) { const int n = (lane >> 3) + 8 * j; const LAS float* s = scr + (8 * c) * 33 + n;
        v4u o; o.x = pk2(s[0 * 33], s[1 * 33]); o.y = pk2(s[2 * 33], s[3 * 33]); o.z = pk2(s[4 * 33], s[5 * 33]); o.w = pk2(s[6 * 33], s[7 * 33]);
        *(GAS v4u*)(WT + (size_t)dst_row(mode, n0 + n) * K + k0 + 8 * c) = o; }
    LDS_WAIT(); asm volatile("" ::: "memory");
}
__device__ __forceinline__ float wave_sum(float v) {
#pragma unroll
    for (int o = 1; o < 64; o <<= 1) v += __shfl_xor(v, o);
    return v;
}
__device__ __forceinline__ void gemv20_item(Frame& F, const float* W, int N, int e, bool valid, int kc, float* outp, int ostride, const float* bias) {
    LAS const float* sc = (LAS const float*)F.lds;
    float acc[NBT];
#pragma unroll
    for (int b = 0; b < NBT; ++b) acc[b] = 0.f;
    if (valid) {
#pragma unroll 16
        for (int d = 0; d < 64; ++d) { const float w = __builtin_nontemporal_load(W + (size_t)(kc * 64 + d) * N + e);
#pragma unroll
            for (int b = 0; b < NBT; ++b) acc[b] += sc[b * 64 + d] * w; }
        const float bb = (bias && kc == 0) ? bias[e] : 0.f;
#pragma unroll
        for (int b = 0; b < NBT; ++b) atomicAdd(outp + (size_t)b * ostride + e, acc[b] + bb);
    }
}
__device__ __forceinline__ void p0a(Frame& F, bool gemv = true) {
    const float* cp = F.A->in[2]; const float* cs = F.A->in[3]; const float* w_ada = F.A->in[7]; const float* b_ada = F.A->in[8];
    float* mod = (float*)(F.ws + WS_MOD);
    if (gemv) for (int it = blockIdx.x; it < 256; it += F.G) {
        const int cg = it & 15, kc = it >> 4;
        LAS float* sc = (LAS float*)F.lds;
        for (int idx = F.tid; idx < NBT * 64; idx += 512) { const int b = idx >> 6, d = idx & 63;
            const float c = b < NBP ? cp[b * DM + kc * 64 + d] : cs[(b - NBP) * DM + kc * 64 + d]; sc[idx] = c / (1.f + __expf(-c)); }
        __syncthreads();
        gemv20_item(F, w_ada, 6 * DM, cg * 384 + (F.tid < 384 ? F.tid : 0), F.tid < 384, kc, mod, 6 * DM, b_ada);
        __syncthreads();
    }
    LAS float* scr = (LAS float*)(F.lds + F.wave * 16384);
    const int gw = blockIdx.x * NWAVES + F.wave, NGW = F.G * NWAVES;
    constexpr int I_IN = (DM / 64) * (DIN / 32), I_O = (DM / 64) * (DM / 32), I_G = (DM / 64) * (DFF / 32), I_D = (DFF / 64) * (DM / 32);
    constexpr int NITEMS = I_IN + I_O + 2 * I_G + I_D;
    bf16* win = (bf16*)(F.ws + WS_WIN); bf16* wout = (bf16*)(F.ws + WS_WOUT); bf16* wgu = (bf16*)(F.ws + WS_WGU); bf16* wdn = (bf16*)(F.ws + WS_WDN);
    for (int i = gw; i < NITEMS; i += NGW) {
        int r = i;
        if (r < I_IN) { p0_transpose_item(F.A->in[11], DM, DIN, win, 1, scr, r, F.lane); continue; } r -= I_IN;
        if (r < I_O) { p0_transpose_item(F.A->in[19], DM, DM, wout, WOUT_MODE, scr, r, F.lane); continue; } r -= I_O;
        if (r < I_G) { p0_transpose_item(F.A->in[20], DM, DFF, wgu, 2, scr, r, F.lane); continue; } r -= I_G;
        if (r < I_G) { p0_transpose_item(F.A->in[21], DM, DFF, wgu, 3, scr, r, F.lane); continue; } r -= I_G;
        p0_transpose_item(F.A->in[22], DFF, DM, wdn, WOUT_MODE, scr, r, F.lane);
    }
    float* rot = (float*)(F.ws + WS_ROT);
    for (int idx = blockIdx.x * 512 + F.tid; idx < 8192 * 64; idx += F.G * 512) {
        const int pos = idx >> 6, ip = idx & 63;
        const float inv = 1.0f / exp2f(((float)ip * (1.0f / 63.0f)) * 13.287712379549449f);
        const float ang = (float)pos * inv;
        const double rev = (double)ang * 0.15915494309189535; const float fr = (float)(rev - __builtin_rint(rev));
        float2 o; o.x = __builtin_amdgcn_cosf(fr); o.y = __builtin_amdgcn_sinf(fr);
        ((float2*)rot)[idx] = o;
    }
}
__device__ __forceinline__ void p0b(Frame& F, bool gemv = true) {
    const float* mod = (const float*)(F.ws + WS_MOD);
    const int it = blockIdx.x;
    if (it < 192 && gemv) {
        const int mat = it & 1, rest = it >> 1, cg = rest % 6, kc = rest / 6;
        LAS float* sc = (LAS float*)F.lds;
        for (int idx = F.tid; idx < NBT * 64; idx += 512) { const int b = idx >> 6, d = idx & 63; sc[idx] = mod[(size_t)b * 6 * DM + 3 * DM + kc * 64 + d]; }
        __syncthreads();
        const int f = cg * 512 + F.tid;
        gemv20_item(F, (mat ? F.A->in[21] : F.A->in[20]), DFF, f, f < DFF, kc, (float*)(F.ws + WS_SB2) + (size_t)mat * NBT * DFF, DFF, nullptr);
        __syncthreads();
    }
    { float* gm2 = (float*)(F.ws + WS_GMOD2);
      for (int idx = blockIdx.x * 512 + F.tid; idx < NBT * DM; idx += F.G * 512) { const int b = idx >> 10, c = idx & 1023; gm2[idx] = F.A->in[10][c] * (1.f + mod[(size_t)b * 6 * DM + 4 * DM + c]); } }
    const float* g1 = F.A->in[9]; bf16* xn = (bf16*)(F.ws + WS_XN);
    const int gw = blockIdx.x * NWAVES + F.wave, NGW = F.G * NWAVES;
    for (int m0 = gw; m0 < MT; m0 += 4 * NGW) {
        f32x4 v[4][4];
#pragma unroll
        for (int q = 0; q < 4; ++q) { const int m = m0 + q * NGW; if (m < MT) {
            const GAS f32x4* xr = (const GAS f32x4*)(m < MP ? F.A->in[0] + (size_t)m * DM : F.A->in[1] + (size_t)(m - MP) * DM) + F.lane;
#pragma unroll
            for (int j = 0; j < 4; ++j) v[q][j] = __builtin_nontemporal_load((const f32x4*)(xr + 64 * j)); } }
#pragma unroll
        for (int q = 0; q < 4; ++q) { const int m = m0 + q * NGW; if (m < MT) {
            const float* mb = mod + (size_t)row_batch(m) * 6 * DM; float s = 0.f;
#pragma unroll
            for (int j = 0; j < 4; ++j) s += (v[q][j].x * v[q][j].x + v[q][j].y * v[q][j].y) + (v[q][j].z * v[q][j].z + v[q][j].w * v[q][j].w);
            const float rstd = rsqrtf(wave_sum(s) * (1.f / DM) + EPSN);
            GAS unsigned long long* o8 = (GAS unsigned long long*)(xn + (size_t)m * DM) + F.lane;
#pragma unroll
            for (int j = 0; j < 4; ++j) { const int c = 4 * F.lane + 256 * j;
                const f32x4 g = *(const f32x4*)(g1 + c), sc1 = *(const f32x4*)(mb + DM + c), sh1 = *(const f32x4*)(mb + c);
                const f32x4 h = v[q][j] * rstd * g * (sc1 + 1.f) + sh1;
                o8[64 * j] = (unsigned long long)pk2(h.x, h.y) | ((unsigned long long)pk2(h.z, h.w) << 32); } } }
    }
}


namespace p2 {
typedef short bf16x8 __attribute__((ext_vector_type(8)));
typedef short s16x4 __attribute__((ext_vector_type(4)));
typedef float f32x16 __attribute__((ext_vector_type(16)));
typedef float f32x4 __attribute__((ext_vector_type(4)));
typedef unsigned u32x4 __attribute__((ext_vector_type(4)));
typedef unsigned u32x2 __attribute__((ext_vector_type(2)));
typedef float f32x2_t __attribute__((ext_vector_type(2))); typedef __bf16 bf16x2_t __attribute__((ext_vector_type(2)));
__device__ __forceinline__ unsigned cvtpk(float lo, float hi) { f32x2_t v = {lo, hi}; bf16x2_t b = __builtin_convertvector(v, bf16x2_t); return __builtin_bit_cast(unsigned, b); }
__device__ __forceinline__ int crow(int r, int hi) { return (r & 3) + 8 * (r >> 2) + 4 * hi; }
__device__ __forceinline__ s16x4 vtr(LAS const unsigned char* p) { return __builtin_bit_cast(s16x4, __builtin_amdgcn_ds_read_tr16_b64_v4i16((LAS s16x4*)p)); }
__device__ __forceinline__ bf16x8 cat8(s16x4 l, s16x4 h) { return (bf16x8){l[0], l[1], l[2], l[3], h[0], h[1], h[2], h[3]}; }
__device__ __forceinline__ bf16x8 pack8(f32x4 a, f32x4 b) { u32x4 w = {cvtpk(a[0], a[1]), cvtpk(a[2], a[3]), cvtpk(b[0], b[1]), cvtpk(b[2], b[3])}; return __builtin_bit_cast(bf16x8, w); }
__device__ __forceinline__ int v_st(int k, int c) { const int kk = (k & ~0xC) | ((k & 4) << 1) | ((k & 8) >> 1); return ((kk >> 3) * 4 + (c >> 5)) * 512 + ((kk & 7) * 32 + (c & 31)) * 2; }
__device__ __forceinline__ int v_rd_base(int lane) { return ((lane & 3) << 3) | (((lane >> 2) & 3) << 6) | (((lane >> 4) & 1) << 5) | (((lane >> 5) & 1) << 8); }
#define PK4(P, BASE, OUT) do { unsigned a0_ = cvtpk(P[BASE + 0], P[BASE + 1]), a1_ = cvtpk(P[BASE + 2], P[BASE + 3]);   \
    unsigned b0_ = cvtpk(P[BASE + 4], P[BASE + 5]), b1_ = cvtpk(P[BASE + 6], P[BASE + 7]);                              \
    auto r0_ = __builtin_amdgcn_permlane32_swap(a0_, b0_, false, false); auto r1_ = __builtin_amdgcn_permlane32_swap(a1_, b1_, false, false); \
    u32x4 w_ = {r0_[0], r1_[0], r0_[1], r1_[1]}; OUT = __builtin_bit_cast(bf16x8, w_); } while (0)

__device__ __forceinline__ int t5_bucket(int rel) {
    const int n = rel < 0 ? -rel : rel; const int ret = rel > 0 ? 16 : 0;
    const int large = n < 12 ? 8 : n < 16 ? 9 : n < 23 ? 10 : n < 32 ? 11 : n < 46 ? 12 : n < 64 ? 13 : n < 91 ? 14 : 15;
    return ret + (n < 8 ? n : large);
}
__device__ __forceinline__ void p2_setup(Frame& F) {
    const float* gq = F.A->in[12]; const float* gk = F.A->in[13]; const float* rb = F.A->in[23];
    float gqm = 0.f, gkm = 0.f, s1 = 0.f, s2 = 0.f;
    for (int d = 0; d < 64; ++d) { gqm = fmaxf(gqm, fabsf(gq[d])); gkm = fmaxf(gkm, fabsf(gk[d])); s1 += F.A->in[14][d] * F.A->in[15][d]; s2 += F.A->in[16][d] * F.A->in[17][d]; }
    LAS float* tab = (LAS float*)(F.lds + TAB_OFF); LAS float* cb = (LAS float*)(F.lds + CB_OFF);
    if (F.tid < 256) {
        const int rel = F.tid - 192; const int bk = t5_bucket(rel);
        for (int h = 0; h < 4; ++h) { float bm = -1e30f; for (int k = 0; k < 32; ++k) bm = fmaxf(bm, rb[k * 4 + h]);
            float bn = 1e30f; for (int k = 0; k < 32; ++k) bn = fminf(bn, rb[k * 4 + h]);
            const float bound = (8.f * gqm * gkm * 1.02f + (bm - bn)) * LOG2E;
            const float ch = rb[15 * 4 + h] + fmaxf(0.f, bound - 100.f) / LOG2E;
            tab[h * 256 + F.tid] = (rb[bk * 4 + h] - ch) * LOG2E;
            if (F.tid == 0) cb[h] = (rb[15 * 4 + h] - ch) * LOG2E; }
        if (F.tid == 0) cb[4] = __expf(s1) - __expf(s2) + LAM_INIT;
    }
    __syncthreads();
}

template <bool DVP = false>
__device__ __forceinline__ void attn_finish(LAS unsigned char* lds, f32x16 (&o)[4], const float (&rl)[16], bool active, int mp, int rg, float lam, const float* gs, bf16* orow0, int lane) {
    const int r32 = lane & 31, hi = lane >> 5;
    LAS float* ex = (LAS float*)lds + rg * 4096;
    if (active && mp == 1) {
#pragma unroll
        for (int d0 = 0; d0 < 4; ++d0)
#pragma unroll
            for (int r = 0; r < 16; ++r) ex[(d0 * 16 + r) * 64 + lane] = o[d0][r] * rl[r];
    }
    __syncthreads();
    if (active && mp == 0) {
#pragma unroll
        for (int d0 = 0; d0 < 4; ++d0)
#pragma unroll
            for (int r = 0; r < 16; ++r) o[d0][r] = o[d0][r] * rl[r] - lam * ex[(d0 * 16 + r) * 64 + lane];
        float gsv[4];
#pragma unroll
        for (int d0 = 0; d0 < 4; ++d0) gsv[d0] = gs[DVP ? 4 * r32 + d0 : 32 * d0 + r32] * (1.f - LAM_INIT);
        LAS bf16* st = (LAS bf16*)ex;
#pragma unroll
        for (int r = 0; r < 16; ++r) {
            float s = (o[0][r] * o[0][r] + o[1][r] * o[1][r]) + (o[2][r] * o[2][r] + o[3][r] * o[3][r]);
            s += __shfl_xor(s, 1); s += __shfl_xor(s, 2); s += __shfl_xor(s, 4); s += __shfl_xor(s, 8); s += __shfl_xor(s, 16);
            const float rn = rsqrtf(s * (1.f / 128.f) + EPSN);
#pragma unroll
            for (int d0 = 0; d0 < 4; ++d0) st[crow(r, hi) * 136 + (DVP ? 4 * r32 + d0 : d0 * 32 + r32)] = (bf16)f2bf(o[d0][r] * rn * gsv[d0]);
        }
#pragma unroll
        for (int i = 0; i < 8; ++i) { const int pi = i * 64 + lane, row = pi >> 4, ch = pi & 15;
            const u32x4 v = *(LAS const u32x4*)(st + row * 136 + ch * 8); *(u32x4*)(orow0 + (size_t)row * DM + ch * 8) = v; }
    }
    __syncthreads();
}

#ifndef ATT_VAR
#define ATT_VAR 0
#endif
template <int VAR>
__device__ __forceinline__ void attn_unit(Frame& F, const bf16* QA, const bf16* KA, const bf16* VA, bf16* OB, int b, int h, int qblk, float lam) {
    LAS unsigned char* lds = F.lds; int tid = F.tid; asm volatile("" : "+v"(tid)); const int wid = F.wave, lane = tid & 63;
    const int r32 = lane & 31, hi = lane >> 5, mp = wid >> 2, rg = wid & 3;
    const int q0 = qblk * 128, qw0 = q0 + rg * 32; const size_t rowbase = (size_t)b * SEQ;
    bf16x8 qr[4];
    { const bf16* qp = QA + (rowbase + qw0 + r32) * 512 + h * 128 + mp * 64 + hi * 8;
#pragma unroll
      for (int d0 = 0; d0 < 4; ++d0) qr[d0] = __builtin_nontemporal_load((const bf16x8*)(qp + d0 * 16)); }
    f32x16 o[4];
#pragma unroll
    for (int d0 = 0; d0 < 4; ++d0)
#pragma unroll
        for (int r = 0; r < 16; ++r) o[d0][r] = 0.f;
    float lsum = 0.f;
    const int NTw = (qw0 >> 6) + 1, NTu = (q0 >> 6) + 2, far_max = qw0 - 154;
    const float cbh = ((LAS const float*)(lds + CB_OFF))[h];
    LAS const float* tab = (LAS const float*)(lds + TAB_OFF) + h * 256;
    const bf16* kbu = KA + rowbase * 512 + h * 128; const bf16* vbu = VA + rowbase * 512 + h * 128;
    unsigned kofs[2], vofs[2];
#pragma unroll
    for (int i = 0; i < 2; ++i) { const int d = wid + 8 * i;
        const int key = 4 * d + (lane >> 4);
        kofs[i] = (unsigned)(key * 512 + (((lane & 15) ^ (key & 15)) * 8));
        const int kk = (d >> 1) * 8 + ((lane >> 2) & 7), kv = (kk & ~0xC) | ((kk & 4) << 1) | ((kk & 8) >> 1);
        vofs[i] = (unsigned)(kv * 512 + (2 * (d & 1) + (lane >> 5)) * 32 + (lane & 3) * 8); }
    int ka[4];
#pragma unroll
    for (int d0 = 0; d0 < 4; ++d0) ka[d0] = r32 * 256 + (((mp * 8 + 2 * d0 + hi) ^ (r32 & 15)) * 16);
    const int vrb = v_rd_base(lane);
    constexpr int VRING = 32768;
    const unsigned ldsbase = (unsigned)(size_t)lds;
#ifndef ATT_STAGGER
#define ATT_STAGGER 1
#endif
#ifndef ATT_DMA
#define ATT_DMA 1
#endif
#if ATT_DMA
#define DMA16(ldsa, voff, sbase) asm volatile("s_mov_b32 m0, %0\n\ts_nop 0\n\tglobal_load_lds_dwordx4 %1, %2" :: "s"(ldsa), "v"(voff), "s"(sbase) : "memory", "m0")
#define LOADS(S, t) do { if (VAR & 1) break; const size_t go_ = (size_t)(t) * 64 * 512; const int ko_ = ((t) & 1) * 16384, vo_ = VRING + ((t) & 3) * 16384; \
        const bf16* kb_ = kbu + go_; const bf16* vb2_ = vbu + go_; const unsigned lb_ = ldsbase + wid * 1024; \
        DMA16(lb_ + ko_, kofs[0] * 2u, kb_); DMA16(lb_ + ko_ + 8192, kofs[1] * 2u, kb_); DMA16(lb_ + vo_, vofs[0] * 2u, vb2_); DMA16(lb_ + vo_ + 8192, vofs[1] * 2u, vb2_); } while (0)
#define WRITES(S, ko, vo) do { } while (0)
#define STAGE_WAIT() asm volatile("s_waitcnt vmcnt(0)" ::: "memory")
#else
    u32x4 sa0, sa1, sa2, sa3, sb0, sb1, sb2, sb3;
#define LOADS(S, t) do { if (VAR & 1) break; const size_t go_ = (size_t)(t) * 64 * 512; S##0 = *(const u32x4*)(kbu + go_ + kofs[0]); S##1 = *(const u32x4*)(kbu + go_ + kofs[1]); S##2 = *(const u32x4*)(vbu + go_ + vofs[0]); S##3 = *(const u32x4*)(vbu + go_ + vofs[1]); } while (0)
#define WRITES(S, ko, vo) do { if (VAR & 1) break; *(LAS u32x4*)(lds + (ko) + wid * 1024 + lane * 16) = S##0; *(LAS u32x4*)(lds + (ko) + 8192 + wid * 1024 + lane * 16) = S##1; \
        *(LAS u32x4*)(lds + (vo) + wid * 1024 + lane * 16) = S##2; *(LAS u32x4*)(lds + (vo) + 8192 + wid * 1024 + lane * 16) = S##3; } while (0)
#define STAGE_WAIT() do { } while (0)
#endif
    bf16x8 pa0, pa1, pa2, pa3;
    { const u32x4 z4 = {0u, 0u, 0u, 0u}; pa0 = __builtin_bit_cast(bf16x8, z4); pa1 = pa0; pa2 = pa0; pa3 = pa0; }
    f32x16 p0, p1, lacc;
#pragma unroll
    for (int r = 0; r < 16; ++r) { p0[r] = 0.f; p1[r] = 0.f; lacc[r] = 0.f; }
    const bf16x8 ones = {(short)0x3F80, (short)0x3F80, (short)0x3F80, (short)0x3F80, (short)0x3F80, (short)0x3F80, (short)0x3F80, (short)0x3F80};
#define SBAR() __builtin_amdgcn_sched_barrier(0)
#define QK(ko, t) do { \
        f32x16 z_; _Pragma("unroll") for (int r = 0; r < 16; ++r) z_[r] = 0.f; \
        if (VAR & 8) { p0 = z_; p1 = z_; asm volatile("" : "+v"(p0), "+v"(p1)); } else { \
        bf16x8 kb_[8];                                        \
        _Pragma("unroll") for (int d0 = 0; d0 < 4; ++d0) { kb_[2 * d0] = (VAR & 32) ? pa0 : *(LAS const bf16x8*)(lds + (ko) + ka[d0]); kb_[2 * d0 + 1] = (VAR & 32) ? pa1 : *(LAS const bf16x8*)(lds + (ko) + ka[d0] + 8192); } \
        SBAR(); \
        _Pragma("unroll") for (int d0 = 0; d0 < 4; ++d0) { const bf16x8 qf = qr[d0]; \
            p0 = __builtin_amdgcn_mfma_f32_32x32x16_bf16(kb_[2 * d0], qf, d0 == 0 ? z_ : p0, 0, 0, 0); \
            p1 = __builtin_amdgcn_mfma_f32_32x32x16_bf16(kb_[2 * d0 + 1], qf, d0 == 0 ? z_ : p1, 0, 0, 0); } } \
        if (64 * (t) > far_max || cbh != 0.f) {        \
            const int bi_ = 64 * (t) - qw0 - r32 + 4 * hi + 192; \
            _Pragma("unroll") for (int r = 0; r < 16; ++r) { const int i0_ = bi_ + (r & 3) + 8 * (r >> 2), i1_ = i0_ + 32; \
                p0[r] += tab[i0_ < 0 ? 0 : i0_]; p1[r] += tab[i1_ < 0 ? 0 : i1_]; } \
        } } while (0)
#define EX2(P, B) do { if (!(VAR & 2)) { P[B] = __builtin_amdgcn_exp2f(P[B]); P[B + 1] = __builtin_amdgcn_exp2f(P[B + 1]); } asm volatile("" : "+v"(P)); } while (0)
#define EXG(g) do { if ((g) < 8) EX2(p0, 2 * (g)); else EX2(p1, 2 * ((g) - 8)); } while (0)
#define VFR(d0, ks) ((VAR & 32) ? pa0 : cat8(vtr(vb_ + (d0) * 512 + (ks) * 4096), vtr(vb_ + (d0) * 512 + (ks) * 4096 + 2048)))
#define PVX(vo, DOEXP) do { if (VAR & 4) { if (DOEXP) { _Pragma("unroll") for (int g_ = 0; g_ < 16; ++g_) EXG(g_); } break; } \
        LAS const unsigned char* vb_ = lds + (vo) + vrb; \
        bf16x8 vf0 = VFR(0, 0), vf1 = VFR(0, 1), vf2; \
        SBAR(); \
        o[0] = __builtin_amdgcn_mfma_f32_32x32x16_bf16(pa0, vf0, o[0], 0, 0, 0); vf2 = VFR(0, 2); if (DOEXP) EXG(0); SBAR(); \
        o[0] = __builtin_amdgcn_mfma_f32_32x32x16_bf16(pa1, vf1, o[0], 0, 0, 0); vf0 = VFR(0, 3); if (DOEXP) EXG(1); SBAR(); \
        o[0] = __builtin_amdgcn_mfma_f32_32x32x16_bf16(pa2, vf2, o[0], 0, 0, 0); vf1 = VFR(1, 0); if (DOEXP) EXG(2); SBAR(); \
        o[0] = __builtin_amdgcn_mfma_f32_32x32x16_bf16(pa3, vf0, o[0], 0, 0, 0); vf2 = VFR(1, 1); if (DOEXP) EXG(3); SBAR(); \
        o[1] = __builtin_amdgcn_mfma_f32_32x32x16_bf16(pa0, vf1, o[1], 0, 0, 0); vf0 = VFR(1, 2); if (DOEXP) EXG(4); SBAR(); \
        o[1] = __builtin_amdgcn_mfma_f32_32x32x16_bf16(pa1, vf2, o[1], 0, 0, 0); vf1 = VFR(1, 3); if (DOEXP) EXG(5); SBAR(); \
        o[1] = __builtin_amdgcn_mfma_f32_32x32x16_bf16(pa2, vf0, o[1], 0, 0, 0); vf2 = VFR(2, 0); if (DOEXP) EXG(6); SBAR(); \
        o[1] = __builtin_amdgcn_mfma_f32_32x32x16_bf16(pa3, vf1, o[1], 0, 0, 0); vf0 = VFR(2, 1); if (DOEXP) EXG(7); SBAR(); \
        o[2] = __builtin_amdgcn_mfma_f32_32x32x16_bf16(pa0, vf2, o[2], 0, 0, 0); vf1 = VFR(2, 2); if (DOEXP) EXG(8); SBAR(); \
        o[2] = __builtin_amdgcn_mfma_f32_32x32x16_bf16(pa1, vf0, o[2], 0, 0, 0); vf2 = VFR(2, 3); if (DOEXP) EXG(9); SBAR(); \
        o[2] = __builtin_amdgcn_mfma_f32_32x32x16_bf16(pa2, vf1, o[2], 0, 0, 0); vf0 = VFR(3, 0); if (DOEXP) EXG(10); SBAR(); \
        o[2] = __builtin_amdgcn_mfma_f32_32x32x16_bf16(pa3, vf2, o[2], 0, 0, 0); vf1 = VFR(3, 1); if (DOEXP) EXG(11); SBAR(); \
        o[3] = __builtin_amdgcn_mfma_f32_32x32x16_bf16(pa0, vf0, o[3], 0, 0, 0); lacc = __builtin_amdgcn_mfma_f32_32x32x16_bf16(pa0, ones, lacc, 0, 0, 0); vf2 = VFR(3, 2); if (DOEXP) EXG(12); SBAR(); \
        o[3] = __builtin_amdgcn_mfma_f32_32x32x16_bf16(pa1, vf1, o[3], 0, 0, 0); lacc = __builtin_amdgcn_mfma_f32_32x32x16_bf16(pa1, ones, lacc, 0, 0, 0); vf0 = VFR(3, 3); if (DOEXP) EXG(13); SBAR(); \
        o[3] = __builtin_amdgcn_mfma_f32_32x32x16_bf16(pa2, vf2, o[3], 0, 0, 0); lacc = __builtin_amdgcn_mfma_f32_32x32x16_bf16(pa2, ones, lacc, 0, 0, 0); if (DOEXP) EXG(14); SBAR(); \
        o[3] = __builtin_amdgcn_mfma_f32_32x32x16_bf16(pa3, vf0, o[3], 0, 0, 0); lacc = __builtin_amdgcn_mfma_f32_32x32x16_bf16(pa3, ones, lacc, 0, 0, 0); if (DOEXP) EXG(15); SBAR(); } while (0)
    LOADS(sa, 0); WRITES(sa, 0, VRING); STAGE_WAIT();
    asm volatile("" :: "v"(qr[0]), "v"(qr[1]), "v"(qr[2]), "v"(qr[3]));
    __syncthreads();
#if !ATT_DMA
    if (1 < NTu) LOADS(sa, 1);
#endif
#ifndef ATT_LAG
#define ATT_LAG 0
#endif
    const int NSTEP = NTu + 1 + ATT_LAG;
#define PVPART(jt) do { const int j_ = (jt); \
        PVX(VRING + ((j_ > 0 ? j_ : 0) & 3) * 16384, 1); \
        if (j_ + 1 >= 0 && j_ + 1 < NTw) { PK4(p0, 0, pa0); PK4(p0, 8, pa1); PK4(p1, 0, pa2); PK4(p1, 8, pa3); } } while (0)
#define STEP(tt, LS, WS) do { const int kcur = ((tt) & 1) * 16384; \
        if (ATT_DMA) { if ((tt) + 1 < NTu) LOADS(LS, (tt) + 1); } else { if ((tt) + 2 < NTu) LOADS(LS, (tt) + 2); } \
        if (ATT_LAG && mp == 1 && (tt) >= 1 && (tt) <= NTw + 1) PVPART((tt) - 2);            \
        if ((tt) < NTw) QK(kcur, (tt)); \
        if ((tt) + 1 < NTu) WRITES(WS, kcur ^ 16384, VRING + (((tt) + 1) & 3) * 16384); \
        if ((!ATT_LAG || mp == 0) && (tt) <= NTw) PVPART((tt) - 1); \
        STAGE_WAIT(); \
        if (!(VAR & 16)) __syncthreads(); } while (0)
    for (int t = 0; t < NSTEP; t += 2) {
        STEP(t, sb, sa);
        if (t + 1 >= NSTEP) break;
        STEP(t + 1, sa, sb);
    }
#undef PVPART
#undef STEP
#undef LOADS
#undef WRITES
#undef STAGE_WAIT
#undef QK
#undef EX2
#undef EXG
#undef VFR
#undef PVX
#undef SBAR
    float rl[16];
#pragma unroll
    for (int r = 0; r < 16; ++r) rl[r] = 1.f / lacc[r];
    attn_finish(lds, o, rl, true, mp, rg, lam, F.A->in[18], OB + (rowbase + qw0) * DM + h * 128, lane);
}

__device__ __forceinline__ void sattn_unit(Frame& F, const bf16* QA, bf16* OB, int bs, int h, float lam) {
    LAS unsigned char* lds = F.lds; int tid = F.tid; asm volatile("" : "+v"(tid)); const int wid = F.wave, lane = tid & 63;
    const int r32 = lane & 31, hi = lane >> 5, mp = wid >> 2, sp = wid & 3;
    const size_t row0 = (size_t)MP + (size_t)bs * LS;
    bf16x8 qr[4];
    { const bf16* qp = QA + (row0 + r32) * 512 + h * 128 + mp * 64 + hi * 8;
#pragma unroll
      for (int d0 = 0; d0 < 4; ++d0) qr[d0] = *(const bf16x8*)(qp + d0 * 16); }
    f32x16 o[4];
#pragma unroll
    for (int d0 = 0; d0 < 4; ++d0)
#pragma unroll
        for (int r = 0; r < 16; ++r) o[d0][r] = 0.f;
    float lsum = 0.f;
    LAS const float* tab = (LAS const float*)(lds + TAB_OFF) + h * 256;
    f32x4 kl[8], vl[16];
    LAS unsigned char* kst = lds + wid * 8192; const int kkey = lane >> 4, kpc = lane & 15;
#define SA_BASE(tt_, kp_, vp_) const float* kp_; const float* vp_; \
        if ((tt_) < 64) { const size_t off_ = ((size_t)(bs * PAST + (tt_) * 32) * 4 + h) * 128; kp_ = F.A->in[4] + off_; vp_ = F.A->in[5] + off_; } \
        else { const size_t off_ = ((size_t)(bs * LS) * 4 + h) * 128; kp_ = F.out + OFF_KS + off_; vp_ = F.out + OFF_VS + off_; }
#define SA_KLOAD(tt_) do { SA_BASE(tt_, kp_, vp_) (void)vp_; const float* a_ = kp_ + (size_t)kkey * 512 + mp * 64 + kpc * 4; \
        _Pragma("unroll") for (int i_ = 0; i_ < 8; ++i_) kl[i_] = __builtin_nontemporal_load((const f32x4*)(a_ + (size_t)i_ * 4 * 512)); } while (0)
#define SA_VLOAD(tt_) do { SA_BASE(tt_, kp_, vp_) (void)kp_; const float* v0p_ = vp_ + (size_t)(8 * hi) * 512 + 4 * r32; \
        _Pragma("unroll") for (int j = 0; j < 8; ++j) { vl[j] = __builtin_nontemporal_load((const f32x4*)(v0p_ + j * 512)); vl[8 + j] = __builtin_nontemporal_load((const f32x4*)(v0p_ + (16 + j) * 512)); } } while (0)
    SA_KLOAD(sp); SA_VLOAD(sp);
    for (int tt = sp; tt < 65; tt += 4) {
#pragma unroll
        for (int i = 0; i < 8; ++i) { u32x2 wv; wv.x = cvtpk(kl[i][0], kl[i][1]); wv.y = cvtpk(kl[i][2], kl[i][3]); *(LAS u32x2*)(kst + (4 * i + kkey) * 144 + kpc * 8) = wv; }
        if (tt + 4 < 65) SA_KLOAD(tt + 4);
        bf16x8 kf[4];
#pragma unroll
        for (int d0 = 0; d0 < 4; ++d0) kf[d0] = *(LAS const bf16x8*)(kst + r32 * 144 + d0 * 32 + hi * 16);
        f32x16 p;
#pragma unroll
        for (int r = 0; r < 16; ++r) p[r] = 0.f;
#pragma unroll
        for (int d0 = 0; d0 < 4; ++d0) p = __builtin_amdgcn_mfma_f32_32x32x16_bf16(kf[d0], qr[d0], p, 0, 0, 0);
        const int relb = tt * 32 - PAST - r32 + 4 * hi;
        float ps = 0.f;
#pragma unroll
        for (int r = 0; r < 16; ++r) { int rel = relb + (r & 3) + 8 * (r >> 2); rel = rel < -192 ? -192 : rel; p[r] = __builtin_amdgcn_exp2f(p[r] + tab[rel + 192]); ps += p[r]; }
        lsum += ps;
        bf16x8 pa0, pa1;
        PK4(p, 0, pa0); PK4(p, 8, pa1);
#pragma unroll
        for (int d0 = 0; d0 < 4; ++d0) {
            f32x4 a, c, e, g;
            a[0] = vl[0][d0]; a[1] = vl[1][d0]; a[2] = vl[2][d0]; a[3] = vl[3][d0]; c[0] = vl[4][d0]; c[1] = vl[5][d0]; c[2] = vl[6][d0]; c[3] = vl[7][d0];
            e[0] = vl[8][d0]; e[1] = vl[9][d0]; e[2] = vl[10][d0]; e[3] = vl[11][d0]; g[0] = vl[12][d0]; g[1] = vl[13][d0]; g[2] = vl[14][d0]; g[3] = vl[15][d0];
            o[d0] = __builtin_amdgcn_mfma_f32_32x32x16_bf16(pa0, pack8(a, c), o[d0], 0, 0, 0);
            o[d0] = __builtin_amdgcn_mfma_f32_32x32x16_bf16(pa1, pack8(e, g), o[d0], 0, 0, 0);
        }
        if (tt + 4 < 65) SA_VLOAD(tt + 4);
    }
#undef SA_BASE
#undef SA_KLOAD
#undef SA_VLOAD
    __syncthreads();
    { auto rr = __builtin_amdgcn_permlane32_swap(__float_as_uint(lsum), __float_as_uint(lsum), false, false); lsum = __uint_as_float(rr[0]) + __uint_as_float(rr[1]); }
    LAS float* exb = (LAS float*)lds; LAS float* wsc = (LAS float*)(lds + WSC_OFF);
    if (hi == 0) wsc[wid * 64 + r32] = lsum;
    if (sp > 0) { LAS float* e = exb + (mp * 3 + sp - 1) * 4096;
#pragma unroll
        for (int d0 = 0; d0 < 4; ++d0)
#pragma unroll
            for (int r = 0; r < 16; ++r) e[(d0 * 16 + r) * 64 + lane] = o[d0][r]; }
    __syncthreads();
    float rl[16];
    if (sp == 0) {
#pragma unroll
        for (int k = 0; k < 3; ++k) { LAS const float* e = exb + (mp * 3 + k) * 4096;
#pragma unroll
            for (int d0 = 0; d0 < 4; ++d0)
#pragma unroll
                for (int r = 0; r < 16; ++r) o[d0][r] += e[(d0 * 16 + r) * 64 + lane]; }
#pragma unroll
        for (int r = 0; r < 16; ++r) { const int q = crow(r, hi); rl[r] = 1.f / ((wsc[(mp * 4 + 0) * 64 + q] + wsc[(mp * 4 + 1) * 64 + q]) + (wsc[(mp * 4 + 2) * 64 + q] + wsc[(mp * 4 + 3) * 64 + q])); }
    } else {
#pragma unroll
        for (int r = 0; r < 16; ++r) rl[r] = 0.f;
    }
    __syncthreads();
    attn_finish<true>(lds, o, rl, sp == 0, mp, 0, lam, F.A->in[18], OB + row0 * DM + h * 128, lane);
}

#define RSB() __builtin_amdgcn_sched_barrier(0)
constexpr int RT_ROW = 288, RT_TILE = 64 * RT_ROW, RT_BUF = 3 * RT_TILE, RT_P = 2 * RT_BUF, RT_PROW = 144, RT_RED = RT_P + 64 * RT_PROW;
static_assert(RT_RED + 8 * 64 * 4 <= RING_BYTES, "retention LDS");
__device__ __forceinline__ bf16x8 rt_qfrag(LAS const unsigned char* Qt, int it, int s, int fr, int g) {
    LAS const unsigned char* qa = Qt + (16 * it + fr) * RT_ROW + (32 * s + 4 * g) * 2; return cat8(*(LAS const s16x4*)qa, *(LAS const s16x4*)(qa + 32)); }
__device__ __forceinline__ bf16x8 rt_kfrag(LAS const unsigned char* Kt, int kt, int ks, int g, int q4, int p4) {
    LAS const unsigned char* ka_ = Kt + (32 * ks + 8 * g + q4) * RT_ROW + (16 * kt + 4 * p4) * 2; return cat8(vtr(ka_), vtr(ka_ + 4 * RT_ROW)); }
constexpr int RG_CH = 16, RG_N = (SEQ / 64) / RG_CH;
__device__ __forceinline__ void ret_groupA(Frame& F, const bf16* KR, const bf16* VR, float* E, int b, int h, int grp) {
    LAS unsigned char* lds = F.lds; int tid = F.tid; asm volatile("" : "+v"(tid)); const int w = F.wave, lane = tid & 63;
    const int fr = lane & 15, g = lane >> 4, q4 = fr >> 2, p4 = fr & 3;
    const float l2g = __log2f(1.f - exp2f(-5.f - (float)h)); const float g64 = exp2f(64.f * l2g);
    f32x4 S[8];
#pragma unroll
    for (int kt = 0; kt < 8; ++kt) S[kt] = (f32x4){0.f, 0.f, 0.f, 0.f};
    const size_t rowbase = (size_t)b * SEQ + (size_t)grp * RG_CH * 64;
    const int srow = tid >> 4, sc16 = tid & 15;
    const size_t gofs = (rowbase + srow) * 512 + h * 128 + sc16 * 8;
    const int lofs = srow * RT_ROW + sc16 * 16;
    u32x4 st[4];
#define ALOAD(c) do { const size_t go_ = gofs + (size_t)(c) * 64 * 512; st[0] = *(const u32x4*)(KR + go_); st[1] = *(const u32x4*)(KR + go_ + 32 * 512); st[2] = *(const u32x4*)(VR + go_); st[3] = *(const u32x4*)(VR + go_ + 32 * 512); } while (0)
#define AWRITE(bo) do { _Pragma("unroll") for (int j_ = 0; j_ < 4; ++j_) *(LAS u32x4*)(lds + (bo) + (1 + (j_ >> 1)) * RT_TILE + (j_ & 1) * 32 * RT_ROW + lofs) = st[j_]; } while (0)
    ALOAD(0); AWRITE(0); __syncthreads();
    for (int c = 0; c < RG_CH; ++c) {
        const int cur = (c & 1) * RT_BUF;
        LAS const unsigned char* Kt = lds + cur + RT_TILE; LAS const unsigned char* Vt = lds + cur + 2 * RT_TILE;
        if (c + 1 < RG_CH) ALOAD(c + 1);
        bf16x8 vf[2];
#pragma unroll
        for (int ks = 0; ks < 2; ++ks) { LAS const unsigned char* va = Vt + (32 * ks + 8 * g + q4) * RT_ROW + (16 * w + 4 * p4) * 2; vf[ks] = cat8(vtr(va), vtr(va + 4 * RT_ROW)); }
#pragma unroll
        for (int kt = 0; kt < 8; ++kt) S[kt] = S[kt] * g64;
        { bf16x8 fg[4];
          fg[0] = rt_kfrag(Kt, 0, 0, g, q4, p4); fg[1] = rt_kfrag(Kt, 0, 1, g, q4, p4); fg[2] = rt_kfrag(Kt, 1, 0, g, q4, p4); RSB();
#pragma unroll
          for (int n = 0; n < 16; ++n) { if (n + 3 < 16) fg[(n + 3) & 3] = rt_kfrag(Kt, (n + 3) >> 1, (n + 3) & 1, g, q4, p4);
              S[n >> 1] = __builtin_amdgcn_mfma_f32_16x16x32_bf16(fg[n & 3], vf[n & 1], S[n >> 1], 0, 0, 0); RSB(); } }
        if (c + 1 < RG_CH) AWRITE(cur ^ RT_BUF);
        __syncthreads();
    }
#undef ALOAD
#undef AWRITE
    float* ep = E + ((size_t)((b * 4 + h) * RG_N + grp) * 128) * 128;
#pragma unroll
    for (int kt = 0; kt < 8; ++kt)
#pragma unroll
        for (int r = 0; r < 4; ++r) ep[(size_t)(16 * kt + 4 * g + r) * 128 + 16 * w + fr] = S[kt][r];
    asm volatile("s_waitcnt vmcnt(0)" ::: "memory");
    __syncthreads();
    if (tid == 0) { __builtin_amdgcn_fence(__ATOMIC_RELEASE, "agent"); asm volatile("s_waitcnt vmcnt(0)" ::: "memory");
        __hip_atomic_fetch_add((unsigned*)(F.ctl + CW_CNTA + 64 * (b * 4 + h)), 1u, __ATOMIC_RELAXED, __HIP_MEMORY_SCOPE_AGENT); }
    __syncthreads();
}
__device__ __forceinline__ void ret_groupB(Frame& F, const bf16* QR, const bf16* KR, const bf16* VR, const bf16* GR, bf16* OB, const float* E, int b, int h, int grp) {
    LAS unsigned char* lds = F.lds; int tid = F.tid; asm volatile("" : "+v"(tid)); const int w = F.wave, lane = tid & 63;
    const int fr = lane & 15, g = lane >> 4, q4 = fr >> 2, p4 = fr & 3;
    const float l2g = __log2f(1.f - exp2f(-5.f - (float)h)); const float g64 = exp2f(64.f * l2g);
    float cs[4];
#pragma unroll
    for (int it = 0; it < 4; ++it) { const int i = 16 * it + fr; cs[it] = exp2f((float)(i + 1) * l2g); }
    const size_t rowbase = (size_t)b * SEQ + (size_t)grp * RG_CH * 64;
    const int srow = tid >> 4, sc16 = tid & 15;
    const size_t gofs = (rowbase + srow) * 512 + h * 128 + sc16 * 8;
    const int lofs = srow * RT_ROW + sc16 * 16;
    u32x4 st[6]; u32x2 gpre[4];
    const size_t grow0 = (rowbase + fr) * 512 + h * 128 + 16 * w + 4 * g;
#define NTL_(p) __builtin_nontemporal_load((const u32x4*)(p))
#define RLOAD(c) do { const size_t go_ = gofs + (size_t)(c) * 64 * 512; st[0] = NTL_(QR + go_); st[1] = NTL_(QR + go_ + 32 * 512); \
        st[2] = NTL_(KR + go_); st[3] = NTL_(KR + go_ + 32 * 512); st[4] = NTL_(VR + go_); st[5] = NTL_(VR + go_ + 32 * 512); } while (0)
#define RWRITE(bo) do { _Pragma("unroll") for (int j_ = 0; j_ < 6; ++j_) *(LAS u32x4*)(lds + (bo) + (j_ >> 1) * RT_TILE + (j_ & 1) * 32 * RT_ROW + lofs) = st[j_]; } while (0)
    RLOAD(0);
    if (tid == 0) { unsigned sp_ = 0; gu32* cp = F.ctl + CW_CNTA + 64 * (b * 4 + h);
        while (__hip_atomic_load(cp, __ATOMIC_RELAXED, __HIP_MEMORY_SCOPE_AGENT) < (unsigned)RG_N) { __builtin_amdgcn_s_sleep(4); if (++sp_ > (1u << 22)) break; }
        __builtin_amdgcn_fence(__ATOMIC_ACQUIRE, "agent"); asm volatile("s_waitcnt vmcnt(0)" ::: "memory"); }
    RWRITE(0);
    __syncthreads();
    f32x4 S[8];
#pragma unroll
    for (int kt = 0; kt < 8; ++kt) S[kt] = (f32x4){0.f, 0.f, 0.f, 0.f};
    for (int gp = 0; gp < grp; ++gp) {
        const float wgt = exp2f((float)(1024 * (grp - 1 - gp)) * l2g);
        const float* ep = E + ((size_t)((b * 4 + h) * RG_N + gp) * 128) * 128;
#pragma unroll
        for (int kt = 0; kt < 8; ++kt)
#pragma unroll
            for (int r = 0; r < 4; ++r) S[kt][r] += wgt * ep[(size_t)(16 * kt + 4 * g + r) * 128 + 16 * w + fr];
    }
    LAS float* red = (LAS float*)(lds + RT_RED);
    for (int c = 0; c < RG_CH; ++c) {
        const int cur = (c & 1) * RT_BUF;
        LAS const unsigned char* Qt = lds + cur; LAS const unsigned char* Kt = lds + cur + RT_TILE; LAS const unsigned char* Vt = lds + cur + 2 * RT_TILE;
        if (c + 1 < RG_CH) RLOAD(c + 1);
#pragma unroll
        for (int it = 0; it < 4; ++it) gpre[it] = __builtin_nontemporal_load((const u32x2*)(GR + grow0 + (size_t)(c * 64 + 16 * it) * 512));
        { const int it = w >> 1; const int i = 16 * it + fr; const float ps_ = exp2f((float)(i - 63) * l2g);
#pragma unroll
          for (int jj = 0; jj < 2; ++jj) { const int jt = 2 * (w & 1) + jj;
            f32x4 acc = (f32x4){0.f, 0.f, 0.f, 0.f};
            if (jt <= it) {
                bf16x8 ka_[4], qb_[4];
#pragma unroll
                for (int ks = 0; ks < 4; ++ks) { ka_[ks] = *(LAS const bf16x8*)(Kt + (16 * jt + fr) * RT_ROW + (32 * ks + 8 * g) * 2); qb_[ks] = *(LAS const bf16x8*)(Qt + (16 * it + fr) * RT_ROW + (32 * ks + 8 * g) * 2); }
                RSB();
#pragma unroll
                for (int ks = 0; ks < 4; ++ks) acc = __builtin_amdgcn_mfma_f32_16x16x32_bf16(ka_[ks], qb_[ks], acc, 0, 0, 0);
            }
            const int j0 = 16 * jt + 4 * g; u32x2 wv;
            wv.x = cvtpk(j0 + 0 <= i ? acc[0] * ps_ : 0.f, j0 + 1 <= i ? acc[1] * ps_ : 0.f); wv.y = cvtpk(j0 + 2 <= i ? acc[2] * ps_ : 0.f, j0 + 3 <= i ? acc[3] * ps_ : 0.f);
            *(LAS u32x2*)(lds + RT_P + i * RT_PROW + j0 * 2) = wv; } }
        f32x4 X[4];
        { bf16x8 af[4], qf[4];
#pragma unroll
          for (int s = 0; s < 4; ++s) af[s] = pack8(S[2 * s], S[2 * s + 1]);
#pragma unroll
          for (int it = 0; it < 4; ++it) X[it] = (f32x4){0.f, 0.f, 0.f, 0.f};
          qf[0] = rt_qfrag(Qt, 0, 0, fr, g); qf[1] = rt_qfrag(Qt, 0, 1, fr, g); qf[2] = rt_qfrag(Qt, 0, 2, fr, g); RSB();
#pragma unroll
          for (int n = 0; n < 16; ++n) { if (n + 3 < 16) qf[(n + 3) & 3] = rt_qfrag(Qt, (n + 3) >> 2, (n + 3) & 3, fr, g);
              X[n >> 2] = __builtin_amdgcn_mfma_f32_16x16x32_bf16(af[n & 3], qf[n & 3], X[n >> 2], 0, 0, 0); RSB(); } }
        __syncthreads();
        bf16x8 vf[2];
#pragma unroll
        for (int ks = 0; ks < 2; ++ks) { LAS const unsigned char* va = Vt + (32 * ks + 8 * g + q4) * RT_ROW + (16 * w + 4 * p4) * 2; vf[ks] = cat8(vtr(va), vtr(va + 4 * RT_ROW)); }
        f32x4 Y[4];
#pragma unroll
        for (int it = 0; it < 4; ++it) Y[it] = (f32x4){0.f, 0.f, 0.f, 0.f};
#pragma unroll
        for (int kt = 0; kt < 8; ++kt) S[kt] = S[kt] * g64;
        { bf16x8 fg[4];
#define BFRAG(n_) ((n_) < 8 ? *(LAS const bf16x8*)(lds + RT_P + (16 * ((n_) >> 1) + fr) * RT_PROW + (32 * ((n_) & 1) + 8 * g) * 2) : rt_kfrag(Kt, ((n_) - 8) >> 1, (n_) & 1, g, q4, p4))
          fg[0] = BFRAG(0); fg[1] = BFRAG(1); fg[2] = BFRAG(2); RSB();
#pragma unroll
          for (int n = 0; n < 24; ++n) { if (n + 3 < 24) fg[(n + 3) & 3] = BFRAG(n + 3);
              if (n < 8) Y[n >> 1] = __builtin_amdgcn_mfma_f32_16x16x32_bf16(vf[n & 1], fg[n & 3], Y[n >> 1], 0, 0, 0);
              else S[(n - 8) >> 1] = __builtin_amdgcn_mfma_f32_16x16x32_bf16(fg[n & 3], vf[n & 1], S[(n - 8) >> 1], 0, 0, 0);
              RSB(); }
#undef BFRAG
        }
        f32x4 ov[4];
#pragma unroll
        for (int it = 0; it < 4; ++it) { ov[it] = Y[it] + X[it] * cs[it];
            float sq = (ov[it][0] * ov[it][0] + ov[it][1] * ov[it][1]) + (ov[it][2] * ov[it][2] + ov[it][3] * ov[it][3]);
            sq += __shfl_xor(sq, 16); sq += __shfl_xor(sq, 32);
            if (g == 0) red[w * 64 + 16 * it + fr] = sq; }
        if (c + 1 < RG_CH) RWRITE(cur ^ RT_BUF);
        __syncthreads();
#pragma unroll
        for (int it = 0; it < 4; ++it) { const int i = 16 * it + fr; float tot = 0.f;
#pragma unroll
            for (int ww = 0; ww < 8; ++ww) tot += red[ww * 64 + i];
            const float rstd = rsqrtf(tot * (1.f / 128.f) + EPSN);
            const size_t row = rowbase + (size_t)c * 64 + i;
            const u32x2 gv = gpre[it];
            const float g0 = __uint_as_float(gv.x << 16), g1 = __uint_as_float(gv.x & 0xffff0000u), g2 = __uint_as_float(gv.y << 16), g3 = __uint_as_float(gv.y & 0xffff0000u);
            u32x2 ow; ow.x = cvtpk(ov[it][0] * rstd * g0, ov[it][1] * rstd * g1); ow.y = cvtpk(ov[it][2] * rstd * g2, ov[it][3] * rstd * g3);
            *(u32x2*)(OB + row * DM + 512 + h * 128 + 16 * w + 4 * g) = ow; }
    }
#undef RLOAD
#undef RWRITE
#undef NTL_
    if (grp == RG_N - 1) {
        float* rp = F.out + OFF_RP + ((size_t)(b * 4 + h) * 128) * 128;
#pragma unroll
        for (int kt = 0; kt < 8; ++kt)
#pragma unroll
            for (int r = 0; r < 4; ++r) rp[(size_t)(16 * kt + 4 * g + r) * 128 + 16 * w + fr] = S[kt][r];
    }
    __syncthreads();
}

__device__ __forceinline__ void ret_sample(Frame& F, const bf16* QR, const bf16* KR, const bf16* VR, const bf16* GR, bf16* OB, int bs, int h) {
    LAS unsigned char* lds = F.lds; int tid = F.tid; asm volatile("" : "+v"(tid)); const int w = F.wave, lane = tid & 63;
    const int fr = lane & 15, g = lane >> 4, q4 = fr >> 2, p4 = fr & 3;
    const float l2g = __log2f(1.f - exp2f(-5.f - (float)h)); const float g32 = exp2f(32.f * l2g);
    const size_t row0 = (size_t)MP + (size_t)bs * LS;
    LAS const unsigned char* Qt = lds; LAS const unsigned char* Kt = lds + RT_TILE; LAS const unsigned char* Vt = lds + 2 * RT_TILE;
    { const int srow = tid >> 4, sc16 = tid & 15; const size_t go_ = (row0 + srow) * 512 + h * 128 + sc16 * 8; const int lofs = srow * RT_ROW + sc16 * 16;
      const u32x4 a = *(const u32x4*)(QR + go_), b = *(const u32x4*)(KR + go_), c = *(const u32x4*)(VR + go_);
      *(LAS u32x4*)(lds + lofs) = a; *(LAS u32x4*)(lds + RT_TILE + lofs) = b; *(LAS u32x4*)(lds + 2 * RT_TILE + lofs) = c; }
    const float* S0 = F.A->in[6] + ((size_t)(bs * 4 + h) * 128) * 128;
    f32x4 S[8];
#pragma unroll
    for (int kt = 0; kt < 8; ++kt)
#pragma unroll
        for (int r = 0; r < 4; ++r) S[kt][r] = __builtin_nontemporal_load(S0 + (size_t)(16 * kt + 4 * g + r) * 128 + 16 * w + fr);
    u32x2 gpre[2];
#pragma unroll
    for (int it = 0; it < 2; ++it) gpre[it] = __builtin_nontemporal_load((const u32x2*)(GR + (row0 + 16 * it + fr) * 512 + h * 128 + 16 * w + 4 * g));
    __syncthreads();
    if (w < 4) { const int it = w >> 1, jt = w & 1; const int i = 16 * it + fr; const float ps_ = exp2f((float)(i - 31) * l2g);
        f32x4 acc = (f32x4){0.f, 0.f, 0.f, 0.f};
        if (jt <= it) {
#pragma unroll
            for (int ks = 0; ks < 4; ++ks) { const bf16x8 a = *(LAS const bf16x8*)(Kt + (16 * jt + fr) * RT_ROW + (32 * ks + 8 * g) * 2);
                const bf16x8 bq = *(LAS const bf16x8*)(Qt + (16 * it + fr) * RT_ROW + (32 * ks + 8 * g) * 2);
                acc = __builtin_amdgcn_mfma_f32_16x16x32_bf16(a, bq, acc, 0, 0, 0); }
        }
        const int j0 = 16 * jt + 4 * g; u32x2 wv;
        wv.x = cvtpk(j0 + 0 <= i ? acc[0] * ps_ : 0.f, j0 + 1 <= i ? acc[1] * ps_ : 0.f); wv.y = cvtpk(j0 + 2 <= i ? acc[2] * ps_ : 0.f, j0 + 3 <= i ? acc[3] * ps_ : 0.f);
        *(LAS u32x2*)(lds + RT_P + i * RT_PROW + j0 * 2) = wv; }
    f32x4 X[2];
    { bf16x8 af[4];
#pragma unroll
      for (int s = 0; s < 4; ++s) af[s] = pack8(S[2 * s], S[2 * s + 1]);
#pragma unroll
      for (int it = 0; it < 2; ++it) { X[it] = (f32x4){0.f, 0.f, 0.f, 0.f};
#pragma unroll
        for (int s = 0; s < 4; ++s) { LAS const unsigned char* qa = Qt + (16 * it + fr) * RT_ROW + (32 * s + 4 * g) * 2;
            const s16x4 lo = *(LAS const s16x4*)qa, hi4 = *(LAS const s16x4*)(qa + 32);
            X[it] = __builtin_amdgcn_mfma_f32_16x16x32_bf16(af[s], cat8(lo, hi4), X[it], 0, 0, 0); } } }
    __syncthreads();
    bf16x8 vf;
    { LAS const unsigned char* va = Vt + (8 * g + q4) * RT_ROW + (16 * w + 4 * p4) * 2; vf = cat8(vtr(va), vtr(va + 4 * RT_ROW)); }
    f32x4 Y[2];
#pragma unroll
    for (int it = 0; it < 2; ++it) { const bf16x8 pb = *(LAS const bf16x8*)(lds + RT_P + (16 * it + fr) * RT_PROW + (8 * g) * 2);
        Y[it] = __builtin_amdgcn_mfma_f32_16x16x32_bf16(vf, pb, (f32x4){0.f, 0.f, 0.f, 0.f}, 0, 0, 0); }
#pragma unroll
    for (int kt = 0; kt < 8; ++kt) { S[kt] = S[kt] * g32;
        LAS const unsigned char* ka_ = Kt + (8 * g + q4) * RT_ROW + (16 * kt + 4 * p4) * 2;
        S[kt] = __builtin_amdgcn_mfma_f32_16x16x32_bf16(cat8(vtr(ka_), vtr(ka_ + 4 * RT_ROW)), vf, S[kt], 0, 0, 0); }
    { float* rp = F.out + OFF_RS + ((size_t)(bs * 4 + h) * 128) * 128;
#pragma unroll
      for (int kt = 0; kt < 8; ++kt)
#pragma unroll
        for (int r = 0; r < 4; ++r) rp[(size_t)(16 * kt + 4 * g + r) * 128 + 16 * w + fr] = S[kt][r]; }
    LAS float* red = (LAS float*)(lds + RT_RED);
    f32x4 ov[2];
#pragma unroll
    for (int it = 0; it < 2; ++it) { const float cs_ = exp2f((float)(16 * it + fr + 1) * l2g); ov[it] = Y[it] + X[it] * cs_;
        float sq = (ov[it][0] * ov[it][0] + ov[it][1] * ov[it][1]) + (ov[it][2] * ov[it][2] + ov[it][3] * ov[it][3]);
        sq += __shfl_xor(sq, 16); sq += __shfl_xor(sq, 32);
        if (g == 0) red[w * 64 + 16 * it + fr] = sq; }
    __syncthreads();
#pragma unroll
    for (int it = 0; it < 2; ++it) { const int i = 16 * it + fr; float tot = 0.f;
#pragma unroll
        for (int ww = 0; ww < 8; ++ww) tot += red[ww * 64 + i];
        const float rstd = rsqrtf(tot * (1.f / 128.f) + EPSN);
        const u32x2 gv = gpre[it];
        const float g0 = __uint_as_float(gv.x << 16), g1 = __uint_as_float(gv.x & 0xffff0000u), g2 = __uint_as_float(gv.y << 16), g3 = __uint_as_float(gv.y & 0xffff0000u);
        u32x2 ow; ow.x = cvtpk(ov[it][0] * rstd * g0, ov[it][1] * rstd * g1); ow.y = cvtpk(ov[it][2] * rstd * g2, ov[it][3] * rstd * g3);
        *(u32x2*)(OB + (row0 + i) * DM + 512 + h * 128 + 16 * w + 4 * g) = ow; }
    __syncthreads();
}

__device__ __forceinline__ int q_next(Frame& F, int q, int rep = 0) {
    volatile LAS int* slot = (volatile LAS int*)(F.lds + QSLOT_OFF);
    if (F.tid == 0) *slot = (int)__hip_atomic_fetch_add((unsigned*)(F.ctl + CW_QUEUE + 64 * (q + 8 * rep)), 1u, __ATOMIC_RELAXED, __HIP_MEMORY_SCOPE_AGENT);
    __syncthreads();
    const int v = *slot;
    __syncthreads();
    return v;
}
#ifndef P2M
#define P2M 31
#endif
constexpr int Q_ITEMS = 16 + 128 + 16 + 8 + 8;
__device__ __forceinline__ void phase2(Frame& F, int rep = 0, int mask = 31) {
    p2_setup(F);
    const float lam = ((LAS const float*)(F.lds + CB_OFF))[4];
    bf16* act = (bf16*)(F.ws + WS_ACT);
    const bf16* QA = act, *KA = act + ACT_STRIDE, *VA = act + 2 * ACT_STRIDE, *QR = act + 3 * ACT_STRIDE, *KR = act + 4 * ACT_STRIDE, *VR = act + 5 * ACT_STRIDE, *GR = act + 6 * ACT_STRIDE;
    bf16* OB = (bf16*)(F.ws + WS_OB); float* E = (float*)(F.ws + WS_E);
    const int xcc = (int)(xb_xcc_id() & 7u);
    for (int k = 0; k < 8; ++k) {
        const int q = (xcc + k) & 7;
        for (;;) {
            const int i = q_next(F, q, rep);
            if (i >= Q_ITEMS) break;
            if (i < 16) { if (mask & P2M & 1) { const int bh = 2 * q + (i >> 3); ret_groupA(F, KR, VR, E, bh >> 2, bh & 3, i & 7); } }
            else if (i >= 48 && i < 64) { if (mask & P2M & 16) { const int bh = 2 * q + ((i - 48) >> 3); ret_groupB(F, QR, KR, VR, GR, OB, E, bh >> 2, bh & 3, (i - 48) & 7); } }
            else if (i >= 64 && i < 72) { if (mask & P2M & 4) { const int id = 8 * q + (i - 64); sattn_unit(F, QA, OB, id >> 2, id & 3, lam); } }
            else if (i >= 72 && i < 80) { if (mask & P2M & 8) { const int id = 8 * q + (i - 72); ret_sample(F, QR, KR, VR, GR, OB, id >> 2, id & 3); } }
            else { if (mask & P2M & 2) { const int j = i < 48 ? i - 16 : i - 48, bh = 2 * q + (j & 1); if (rep == 0) attn_unit<0>(F, QA, KA, VA, OB, bh >> 2, bh & 3, 63 - (j >> 1), lam); else attn_unit<ATT_VAR>(F, QA, KA, VA, (bf16*)(F.ws + WS_XN), bh >> 2, bh & 3, 63 - (j >> 1), lam); } }
        }
    }
}
}


namespace sg {
using p2::bf16x8; using p2::f32x16; using p2::crow;
template <int NB>
__device__ __forceinline__ void wave_mm(f32x16 (&acc)[NB], LAS unsigned char* wl, const bf16* A, int lda, const bf16* Bm, int ldb, const int (&brow)[NB][4], int k0, int k1, int lane) {
#pragma unroll
    for (int nb = 0; nb < NB; ++nb)
#pragma unroll
        for (int r = 0; r < 16; ++r) acc[nb][r] = 0.f;
    const int r32 = lane & 31, hi = lane >> 5, lrow = lane >> 3, lpc = lane & 7;
    p2::u32x4 st[1 + NB][4];
#define SG_LOAD(ks) do { _Pragma("unroll") for (int i = 0; i < 4; ++i) { st[0][i] = *(const p2::u32x4*)(A + (size_t)(8 * i + lrow) * lda + (ks) + lpc * 8); \
        _Pragma("unroll") for (int nb = 0; nb < NB; ++nb) st[1 + nb][i] = *(const p2::u32x4*)(Bm + (size_t)brow[nb][i] * ldb + (ks) + lpc * 8); } } while (0)
    SG_LOAD(k0);
    for (int ks = k0; ks < k1; ks += 64) {
#pragma unroll
        for (int t = 0; t < 1 + NB; ++t)
#pragma unroll
            for (int i = 0; i < 4; ++i) { const int row = 8 * i + lrow; *(LAS p2::u32x4*)(wl + t * 4096 + row * 128 + ((lpc ^ ((row >> 1) & 7)) * 16)) = st[t][i]; }
        if (ks + 64 < k1) SG_LOAD(ks + 64);
#pragma unroll
        for (int u = 0; u < 4; ++u) { const int po = ((2 * u + hi) ^ ((r32 >> 1) & 7)) * 16;
            const bf16x8 a = *(LAS const bf16x8*)(wl + r32 * 128 + po);
#pragma unroll
            for (int nb = 0; nb < NB; ++nb) { const bf16x8 b = *(LAS const bf16x8*)(wl + (1 + nb) * 4096 + r32 * 128 + po); acc[nb] = __builtin_amdgcn_mfma_f32_32x32x16_bf16(a, b, acc[nb], 0, 0, 0); } }
    }
#undef SG_LOAD
}
__device__ __forceinline__ float half_sum(float s) { s += __shfl_xor(s, 1); s += __shfl_xor(s, 2); s += __shfl_xor(s, 4); s += __shfl_xor(s, 8); s += __shfl_xor(s, 16); return s; }
__device__ __forceinline__ float bf2f(bf16 v) { return __uint_as_float((unsigned)v << 16); }

__device__ __forceinline__ void p1_sample(Frame& F, const bf16* XN, const bf16* Win, bf16* act) {
    int tid = F.tid; asm volatile("" : "+v"(tid)); const int lane = tid & 63, r32 = lane & 31, hi = lane >> 5;
    const int gw = blockIdx.x + F.G * F.wave, NGW = F.G * NWAVES;
    const float* rot = (const float*)(F.ws + WS_ROT);
    for (int id = gw; id < 16 * (DIN / 64); id += NGW) {
        const int cg = id >> 4, rt = id & 15, m0 = MP + 32 * rt, n0 = 64 * cg;
        f32x16 acc[2];
        int brow[2][4];
#pragma unroll
        for (int nb = 0; nb < 2; ++nb)
#pragma unroll
            for (int i = 0; i < 4; ++i) brow[nb][i] = dst_row(1, n0 + 32 * nb + 8 * i + (lane >> 3));
        wave_mm<2>(acc, F.lds + F.wave * 12288, XN + (size_t)m0 * DM, DM, Win, DM, brow, 0, DM, lane);
        const int type = n0 >> 9, lc = (n0 & 511) + r32;
        bf16* dst = act + (size_t)type * ACT_STRIDE;
        if (type <= 1) {
            const float* g = type == 0 ? F.A->in[12] : F.A->in[13]; const float g0 = g[r32], g1 = g[32 + r32], osc = type == 0 ? QSCALE : 1.f;
#pragma unroll
            for (int r = 0; r < 16; ++r) { const int m = m0 + crow(r, hi);
                const float rinv = rsqrtf(half_sum(acc[0][r] * acc[0][r] + acc[1][r] * acc[1][r]) * (1.f / 64.f) + EPSN);
                const float y0 = acc[0][r] * rinv * g0, y1 = acc[1][r] * rinv * g1;
                if (type == 1) { float* ko = F.out + OFF_KS + (size_t)(m - MP) * 512 + lc; ko[0] = y0; ko[32] = y1; }
                dst[(size_t)m * 512 + lc] = (bf16)f2bf(y0 * osc); dst[(size_t)m * 512 + lc + 32] = (bf16)f2bf(y1 * osc); }
        } else if (type == 3 || type == 4) {
            const int h = (n0 & 511) >> 7; const float l2g = __log2f(1.f - exp2f(-5.f - (float)h));
            float2 cs[16][2];
#pragma unroll
            for (int r = 0; r < 16; ++r) { const int ts = crow(r, hi);
#pragma unroll
                for (int nb = 0; nb < 2; ++nb) cs[r][nb] = *(const float2*)(rot + (size_t)(PAST + ts) * 128 + (((lc + 32 * nb) & 127) & ~1)); }
#pragma unroll
            for (int r = 0; r < 16; ++r) { const int m = m0 + crow(r, hi), ts = crow(r, hi);
                const float ksc = type == 4 ? 0.08838834764831845f * exp2f((float)(31 - ts) * l2g) : 1.f;
#pragma unroll
                for (int nb = 0; nb < 2; ++nb) { const float v = acc[nb][r], pv = __shfl_xor(v, 1);
                    const float c = cs[r][nb].x, sn = cs[r][nb].y;
                    const float y = (lane & 1) ? (pv * sn + v * c) : (v * c - pv * sn);
                    dst[(size_t)m * 512 + lc + 32 * nb] = (bf16)f2bf(y * ksc); } }
        } else {
#pragma unroll
            for (int r = 0; r < 16; ++r) { const int m = m0 + crow(r, hi);
#pragma unroll
                for (int nb = 0; nb < 2; ++nb) { float y = acc[nb][r];
                    if (type == 2) F.out[OFF_VS + (size_t)(m - MP) * 512 + lc + 32 * nb] = y;
                    if (type == 6) y = pg8::silu_f(y);
                    dst[(size_t)m * 512 + lc + 32 * nb] = (bf16)f2bf(y); } }
        }
    }
}
__device__ __forceinline__ void p3_sample(Frame& F, const bf16* OB, const bf16* Wout, bf16* XN2, const float* mod, float* rowss) {
    int tid = F.tid; asm volatile("" : "+v"(tid)); const int lane = tid & 63, r32 = lane & 31, hi = lane >> 5;
    const int gw = blockIdx.x + F.G * F.wave, NGW = F.G * NWAVES;
    for (int id = gw; id < 16 * (DM / 64); id += NGW) {
        const int cg = id >> 4, rt = id & 15, m0 = MP + 32 * rt, n0 = 64 * cg;
        f32x16 acc[2];
        int brow[2][4];
#pragma unroll
        for (int nb = 0; nb < 2; ++nb)
#pragma unroll
            for (int i = 0; i < 4; ++i) brow[nb][i] = dst_row(WOUT_MODE, n0 + 32 * nb + 8 * i + (lane >> 3));
        wave_mm<2>(acc, F.lds + F.wave * 12288, OB + (size_t)m0 * DM, DM, Wout, DM, brow, 0, DM, lane);
        const float* mb = mod + (size_t)(NBP + rt) * 6 * DM;
        float gt[2], gm[2];
#pragma unroll
        for (int nb = 0; nb < 2; ++nb) { const int col = n0 + 32 * nb + r32; gt[nb] = mb[2 * DM + col]; gm[nb] = F.A->in[10][col] * (1.f + mb[4 * DM + col]); }
        float xin[16][2];
#pragma unroll
        for (int r = 0; r < 16; ++r)
#pragma unroll
            for (int nb = 0; nb < 2; ++nb) xin[r][nb] = F.A->in[1][(size_t)(m0 + crow(r, hi) - MP) * DM + n0 + 32 * nb + r32];
#pragma unroll
        for (int r = 0; r < 16; ++r) { const int m = m0 + crow(r, hi); float ss = 0.f;
#pragma unroll
            for (int nb = 0; nb < 2; ++nb) { const int col = n0 + 32 * nb + r32;
                const float x1 = xin[r][nb] + gt[nb] * acc[nb][r];
                F.out[OFF_Y + (size_t)m * DM + col] = x1; XN2[(size_t)m * DM + col] = (bf16)f2bf(x1 * gm[nb]); ss += x1 * x1; }
            ss = half_sum(ss);
            if (r32 == 0) atomicAdd(rowss + m, ss); }
    }
}
__device__ __forceinline__ void p4_sample(Frame& F, const bf16* XN2, const bf16* Wgu, const float* rowss, const float* sbg, const float* sbu, bf16* H) {
    int tid = F.tid; asm volatile("" : "+v"(tid)); const int lane = tid & 63, r32 = lane & 31, hi = lane >> 5;
    const int gw = blockIdx.x + F.G * F.wave, NGW = F.G * NWAVES;
    for (int id = gw; id < 16 * (DFF / 32); id += NGW) {
        const int fg = id >> 4, rt = id & 15, m0 = MP + 32 * rt, f = 32 * fg + r32;
        f32x16 acc[2];
        int brow[2][4];
#pragma unroll
        for (int nb = 0; nb < 2; ++nb)
#pragma unroll
            for (int i = 0; i < 4; ++i) brow[nb][i] = dst_row(2 + nb, 32 * fg + 8 * i + (lane >> 3));
        wave_mm<2>(acc, F.lds + F.wave * 12288, XN2 + (size_t)m0 * DM, DM, Wgu, DM, brow, 0, DM, lane);
        const float bg = sbg[(size_t)(NBP + rt) * DFF + f], bu = sbu[(size_t)(NBP + rt) * DFF + f];
        float rsv[16];
#pragma unroll
        for (int r = 0; r < 16; ++r) rsv[r] = rowss[m0 + crow(r, hi)];
#pragma unroll
        for (int r = 0; r < 16; ++r) { const int m = m0 + crow(r, hi); const float rstd = rsqrtf(rsv[r] * (1.f / (float)DM) + EPSN);
            H[(size_t)m * DFF + f] = (bf16)f2bf(pg8::silu_f(acc[0][r] * rstd + bg) * (acc[1][r] * rstd + bu)); }
    }
}
__device__ __forceinline__ void p5_sample(Frame& F, const bf16* H, const bf16* Wdn, const float* mod) {
    int tid = F.tid; asm volatile("" : "+v"(tid)); const int lane = tid & 63, r32 = lane & 31, hi = lane >> 5;
    const int gw = blockIdx.x + F.G * F.wave, NGW = F.G * NWAVES;
    for (int id = gw; id < 16 * 4 * (DM / 64); id += NGW) {
        const int rt = id & 15, ksp = (id >> 4) & 3, cg = id >> 6, m0 = MP + 32 * rt, n0 = 64 * cg;
        f32x16 acc[2];
        int brow[2][4];
#pragma unroll
        for (int nb = 0; nb < 2; ++nb)
#pragma unroll
            for (int i = 0; i < 4; ++i) brow[nb][i] = dst_row(WOUT_MODE, n0 + 32 * nb + 8 * i + (lane >> 3));
        wave_mm<2>(acc, F.lds + F.wave * 12288, H + (size_t)m0 * DFF, DFF, Wdn, DFF, brow, ksp * (DFF / 4), (ksp + 1) * (DFF / 4), lane);
        const float* mb = mod + (size_t)(NBP + rt) * 6 * DM + 5 * DM;
#pragma unroll
        for (int nb = 0; nb < 2; ++nb) { const int col = n0 + 32 * nb + r32; const float gt = mb[col];
#pragma unroll
            for (int r = 0; r < 16; ++r) atomicAdd(F.out + OFF_Y + (size_t)(m0 + crow(r, hi)) * DM + col, gt * acc[nb][r]); }
    }
}
}

__global__ void __launch_bounds__(NWAVES * 64, 2) fwd_megakernel(Args args) {
    extern __shared__ __attribute__((aligned(16))) unsigned char lds[];
    Frame F;
    F.lds = (LAS unsigned char*)lds; F.MISC = (volatile LAS unsigned*)(F.lds + MISC_OFF);
    F.tid = threadIdx.x; F.lane = F.tid & 63; F.wave = __builtin_amdgcn_readfirstlane(F.tid >> 6); F.G = gridDim.x;
    F.A = &args;
    F.out = args.out; F.ws = args.ws; F.ctl = (gu32*)(args.ws + WS_CTL);
    for (int u = F.tid; u < (LDS_BYTES - LDSCTL_OFF) / 4; u += NWAVES * 64) ((LAS unsigned*)(F.lds + LDSCTL_OFF))[u] = 0u;
    __syncthreads();
    XcdBarrier bar = xcd_barrier_post((unsigned*)(F.ctl + CW_BAR), F.MISC + 8);

    bf16* act = (bf16*)(F.ws + WS_ACT); bf16* XN = (bf16*)(F.ws + WS_XN); bf16* OB = (bf16*)(F.ws + WS_OB); bf16* HB = (bf16*)(F.ws + WS_H);
    float* mod = (float*)(F.ws + WS_MOD); float* rowss = (float*)(F.ws + WS_ROWSS); float* sb2 = (float*)(F.ws + WS_SB2);

#ifndef PHM
#define PHM 127
#endif
    if (PHM & 1) p0a(F);
#ifdef PROBE_P0A
    xcd_barrier(bar); p0a(F, false);
#endif
    xcd_barrier(bar);
    if (PHM & 2) p0b(F);
#ifdef PROBE_P0B
    xcd_barrier(bar); p0b(F, false);
#endif
    xcd_barrier(bar);
    if (PHM & 4) {
        pg8::Gemm g{XN, (const bf16*)(F.ws + WS_WIN), MP, DIN, DM}; pg8::StaticOrder S; S.init(MP, DIN, F.G, (int)blockIdx.x);
        pg8::EpiIn E{act, F.out, F.A->in[12], F.A->in[13], (const float*)(F.ws + WS_ROT)};
        if (blockIdx.x & 1) { sg::p1_sample(F, XN, (const bf16*)(F.ws + WS_WIN), act); __syncthreads(); }
        pg8::gemm_phase<pg8::EpiIn, pg8::StaticOrder, true, true>(F.lds, g, S, E);
        if (!(blockIdx.x & 1)) sg::p1_sample(F, XN, (const bf16*)(F.ws + WS_WIN), act);
#ifdef PROBE_S
        __syncthreads(); sg::p1_sample(F, XN, (const bf16*)(F.ws + WS_WIN), act);
#endif
#ifdef PROBE_P1
        xcd_barrier(bar);
        pg8::gemm_phase<pg8::EpiIn, pg8::StaticOrder, true, true>(F.lds, g, S, E);
#endif
#ifdef PROBE_P1N
        xcd_barrier(bar);
        { pg8::EpiNull EN; pg8::gemm_phase<pg8::EpiNull, pg8::StaticOrder, true, true>(F.lds, g, S, EN); }
#endif
    }
    xcd_barrier(bar);
    if (PHM & 8) p2::phase2(F);
#ifdef PROBE_P2
    xcd_barrier(bar);
    p2::phase2(F, 1, PROBE_P2);
#endif
    xcd_barrier(bar);
    if (PHM & 16) {
        pg8::Gemm g{OB, (const bf16*)(F.ws + WS_WOUT), MP, DM, DM}; pg8::StaticOrder S; S.init(MP, DM, F.G, (int)blockIdx.x);
        pg8::EpiOut E{F.A->in[0], F.A->in[1], (bf16*)(F.ws + WS_X1B), XN, mod, (const float*)(F.ws + WS_GMOD2), rowss, 1.f};
        if (blockIdx.x & 1) { sg::p3_sample(F, OB, (const bf16*)(F.ws + WS_WOUT), XN, mod, rowss); __syncthreads(); }
        pg8::gemm_phase<pg8::EpiOut, pg8::StaticOrder, false, true>(F.lds, g, S, E);
#ifdef PROBE_P3
        xcd_barrier(bar);
        { pg8::EpiOut E2{F.A->in[0], F.A->in[1], (bf16*)(F.ws + WS_X1B), XN, mod, (const float*)(F.ws + WS_GMOD2), rowss, 0.f}; pg8::gemm_phase<pg8::EpiOut, pg8::StaticOrder, true, true>(F.lds, g, S, E2); }
#endif
        if (!(blockIdx.x & 1)) sg::p3_sample(F, OB, (const bf16*)(F.ws + WS_WOUT), XN, mod, rowss);
    }
    xcd_barrier(bar);
    if (PHM & 32) {
        pg8::Gemm g{XN, (const bf16*)(F.ws + WS_WGU), MP, NGU, DM}; pg8::StaticOrder S; S.init(MP, NGU, F.G, (int)blockIdx.x);
        pg8::EpiFF1 E{rowss, sb2, sb2 + (size_t)NBT * DFF, HB};
        if (blockIdx.x & 1) { sg::p4_sample(F, XN, (const bf16*)(F.ws + WS_WGU), rowss, sb2, sb2 + (size_t)NBT * DFF, HB); __syncthreads(); }
        pg8::gemm_phase<pg8::EpiFF1, pg8::StaticOrder, true, true>(F.lds, g, S, E);
        if (!(blockIdx.x & 1)) sg::p4_sample(F, XN, (const bf16*)(F.ws + WS_WGU), rowss, sb2, sb2 + (size_t)NBT * DFF, HB);
#ifdef PROBE_S
        __syncthreads(); sg::p4_sample(F, XN, (const bf16*)(F.ws + WS_WGU), rowss, sb2, sb2 + (size_t)NBT * DFF, HB);
#endif
#ifdef PROBE_P4
        xcd_barrier(bar);
        pg8::gemm_phase<pg8::EpiFF1, pg8::StaticOrder, true, true>(F.lds, g, S, E);
#endif
    }
    xcd_barrier(bar);
    if (PHM & 64) {
        pg8::Gemm g{HB, (const bf16*)(F.ws + WS_WDN), MP, DM, DFF}; pg8::StaticOrder S; S.init(MP, DM, F.G, (int)blockIdx.x);
        pg8::EpiFF2 E{F.out + OFF_Y, (const bf16*)(F.ws + WS_X1B), mod, 1.f};
        if (blockIdx.x & 1) { sg::p5_sample(F, HB, (const bf16*)(F.ws + WS_WDN), mod); __syncthreads(); }
        pg8::gemm_phase<pg8::EpiFF2, pg8::StaticOrder, false, true>(F.lds, g, S, E);
#ifdef PROBE_P5
        xcd_barrier(bar);
        { pg8::EpiFF2 E2{F.out + OFF_Y, (const bf16*)(F.ws + WS_X1B), mod, 1.f}; pg8::gemm_phase<pg8::EpiFF2, pg8::StaticOrder, true, true>(F.lds, g, S, E2); }
#endif
        if (!(blockIdx.x & 1)) sg::p5_sample(F, HB, (const bf16*)(F.ws + WS_WDN), mod);
    }
}

extern "C" void kernel_launch(void* const* d_in, const int* in_sizes, int n_in, void* d_out, int out_size, void* d_ws, size_t ws_size, hipStream_t stream) {
    static int grid = 0;
    if (grid == 0) {
        if (n_in != 24 || in_sizes[0] != MP * DM || (size_t)out_size != OUT_TOTAL || ws_size < WS_END) {
            fprintf(stderr, "kernel_launch: unexpected shapes: n_in %d in0 %d out %d ws %zu (need >= %zu)\n", n_in, n_in > 0 ? in_sizes[0] : -1, out_size, ws_size, (size_t)WS_END); grid = -1; return; }
        int dev = 0, cus = 0, per_cu = 0;
        if (hipGetDevice(&dev) != hipSuccess || hipDeviceGetAttribute(&cus, hipDeviceAttributeMultiprocessorCount, dev) != hipSuccess) { fprintf(stderr, "kernel_launch: device query failed\n"); grid = -1; return; }
        if (hipFuncSetAttribute((const void*)fwd_megakernel, hipFuncAttributeMaxDynamicSharedMemorySize, LDS_BYTES) != hipSuccess) { fprintf(stderr, "kernel_launch: hipFuncSetAttribute failed\n"); grid = -1; return; }
        if (hipOccupancyMaxActiveBlocksPerMultiprocessor(&per_cu, (const void*)fwd_megakernel, NWAVES * 64, LDS_BYTES) != hipSuccess || per_cu < 1) { fprintf(stderr, "kernel_launch: occupancy query says %d blocks/CU\n", per_cu); per_cu = 1; }
        (void)hipGetLastError();
        grid = cus;
    }
    if (grid < 0) return;
    if (hipMemsetAsync((char*)d_ws + WS_CTL, 0, CTL_ZERO_BYTES, stream) != hipSuccess) { fprintf(stderr, "kernel_launch: memset failed\n"); return; }
    Args a{};
    for (int i = 0; i < 24; ++i) a.in[i] = (const float*)d_in[i];
    a.out = (float*)d_out; a.ws = (unsigned char*)d_ws;
    void* kargs[] = {&a};
    hipError_t e = hipLaunchCooperativeKernel((const void*)fwd_megakernel, dim3(grid), dim3(NWAVES * 64), kargs, LDS_BYTES, stream);
    if (e != hipSuccess) fprintf(stderr, "kernel_launch: cooperative launch failed: %s (grid %d)\n", hipGetErrorString(e), grid);
}
```

```cpp
#include <hip/hip_runtime.h>
#include <hip/hip_bf16.h>
#include <cstdio>
#include <cstdint>
#include <cmath>

constexpr int DM = 1024, NBP = 4, SEQ = 8192, NBS = 16, LS = 32, PAST = 2048;
constexpr int MP = NBP * SEQ, MS = NBS * LS, MT = MP + MS;
constexpr int DIN = 3584, DFF = 2816, NGU = 2 * DFF, NBT = NBP + NBS;
constexpr float EPSN = 1e-6f;
constexpr float LOG2E = 1.4426950408889634f;
constexpr float QSCALE = 0.125f * LOG2E;
constexpr float LAM_INIT = 0.2f;
constexpr size_t OFF_Y = 0, OFF_KP = (size_t)MT * DM, OFF_VP = OFF_KP + (size_t)MP * 512, OFF_RP = OFF_VP + (size_t)MP * 512,
                 OFF_KS = OFF_RP + (size_t)NBP * 4 * 128 * 128, OFF_VS = OFF_KS + (size_t)MS * 512, OFF_RS = OFF_VS + (size_t)MS * 512,
                 OUT_TOTAL = OFF_RS + (size_t)NBS * 4 * 128 * 128;
__device__ __forceinline__ int row_batch(int row) { return row < MP ? (row >> 13) : NBP + ((row - MP) >> 5); }
__device__ __forceinline__ int row_pos(int row) { return row < MP ? (row & 8191) : PAST + ((row - MP) & 31); }

namespace pg8 {
#define PG8_LAS __attribute__((address_space(3)))
typedef unsigned short bf16_t;
typedef short bf16x8 __attribute__((ext_vector_type(8)));
typedef float f32x4 __attribute__((ext_vector_type(4)));
typedef unsigned u32x4 __attribute__((ext_vector_type(4)));
constexpr int BM = 256, BK = 64, HALF = 128, HTB = HALF * BK * 2  , STAGE_BYTES = 8 * HTB, NXCD = 8, WGM = 8;

__host__ __device__ __forceinline__ int lds_byte(int r, int c) { const int st = (r >> 4) * 2 + (c >> 5), rr = r & 15, cc = c & 31, ob = rr * 64 + cc * 2; return st * 1024 + (ob ^ (((ob >> 9) & 1) << 5)); }
__host__ __device__ __forceinline__ void stage_rc(int b, int& R, int& C) { const int st = b / 1024, sb = b % 1024, swz = sb ^ (((sb >> 9) & 1) << 5); R = (st >> 1) * 16 + swz / 64; C = (st & 1) * 32 + (swz % 64) / 2; }
__host__ __device__ __forceinline__ int perm32(int rho) { const int n = rho >> 4, i = rho & 15; return 8 * (i >> 2) + 4 * n + (i & 3); }

struct Unit { int pm, pn; };
struct Gemm { const bf16_t* A; const bf16_t* Bt; int M, N, K; };

struct StaticOrder {
    int nM, nN, nwg, G, c;
    __host__ __device__ void init(int M, int N, int G_, int c_) { nM = M / BM; nN = N / BM; nwg = nM * nN; G = G_; c = c_; }
    __host__ __device__ bool next(int i, Unit& u) const {
        const long L = (long)i * G + c; if (L >= nwg) return false;
        int wgid = (int)L; { const int q = nwg / NXCD, r = nwg % NXCD, xcd = wgid % NXCD, off = wgid / NXCD; wgid = (xcd < r ? xcd * (q + 1) : r * (q + 1) + (xcd - r) * q) + off; }
        const int nig = WGM * nN, gid = wgid / nig, fm = gid * WGM, gsz = (nM - fm) < WGM ? (nM - fm) : WGM;
        u.pm = fm + ((wgid % nig) % gsz); u.pn = (wgid % nig) / gsz; return true;
    }
    __device__ __forceinline__ void a_ready(const Unit&) const {}
    __device__ __forceinline__ void done(const Unit&) const {}
};

__device__ __forceinline__ unsigned cvt_pk_bf16(float lo, float hi) { unsigned r; asm volatile("v_cvt_pk_bf16_f32 %0, %1, %2" : "=v"(r) : "v"(lo), "v"(hi)); return r; }
typedef float f32x2 __attribute__((ext_vector_type(2)));
typedef unsigned u32x2 __attribute__((ext_vector_type(2)));
__device__ __forceinline__ void st_bf16x4(bf16_t* p, f32x4 v) { u32x2 w; w.x = cvt_pk_bf16(v[0], v[1]); w.y = cvt_pk_bf16(v[2], v[3]); *(u32x2*)p = w; }
__device__ __forceinline__ void st_bf16x8(bf16_t* p, f32x4 a, f32x4 c) { u32x4 w; w.x = cvt_pk_bf16(a[0], a[1]); w.y = cvt_pk_bf16(a[2], a[3]); w.z = cvt_pk_bf16(c[0], c[1]); w.w = cvt_pk_bf16(c[2], c[3]); *(u32x4*)p = w; }
__device__ __forceinline__ float silu_f(float z) { return z * __builtin_amdgcn_rcpf(1.f + __expf(-z)); }

struct EpiIn {
    static constexpr bool PERM = false, AFTER_DRAIN = false;
    bf16_t* act; float* out; const float* gq; const float* gk; const float* rot;
    __device__ __forceinline__ void operator()(const f32x4 (&acc)[2][2][4][2], const Unit& u, int wr, int wc, int fr, int fq) const {
        const int type = u.pn >> 1, half = u.pn & 1;
        const int lc0 = half * 256 + wc * 64 + fq * 8;
        bf16_t* dst = act + (size_t)type * ((size_t)MT * 512);
        const int rowb = u.pm * BM + wr * 64 + fr;
        if (type <= 1) {
            const float* g = type == 0 ? gq : gk; const float osc = type == 0 ? QSCALE : 1.f;
            f32x4 gv[2][2];
#pragma unroll
            for (int bj = 0; bj < 2; ++bj)
#pragma unroll
                for (int n = 0; n < 2; ++n) gv[bj][n] = *(const f32x4*)(g + bj * 32 + fq * 8 + n * 4);
#pragma unroll
            for (int ai = 0; ai < 2; ++ai)
#pragma unroll
                for (int m = 0; m < 4; ++m) {
                    const int row = rowb + ai * HALF + m * 16;
                    float ss = 0.f;
#pragma unroll
                    for (int bj = 0; bj < 2; ++bj)
#pragma unroll
                        for (int n = 0; n < 2; ++n) { const f32x4 v = acc[ai][bj][m][n]; ss += (v[0] * v[0] + v[1] * v[1]) + (v[2] * v[2] + v[3] * v[3]); }
                    ss += __shfl_xor(ss, 16); ss += __shfl_xor(ss, 32);
                    const float rinv = rsqrtf(ss * (1.f / 64.f) + EPSN);
                    float* ko = (row < MP ? out + OFF_KP + (size_t)row * 512 : out + OFF_KS + (size_t)(row - MP) * 512) + lc0;
                    bf16_t* bo = dst + (size_t)row * 512 + lc0;
#pragma unroll
                    for (int bj = 0; bj < 2; ++bj) { const f32x4 y0 = acc[ai][bj][m][0] * rinv * gv[bj][0], y1 = acc[ai][bj][m][1] * rinv * gv[bj][1];
                        if (type == 1) { __builtin_nontemporal_store(y0, (f32x4*)(ko + bj * 32)); __builtin_nontemporal_store(y1, (f32x4*)(ko + bj * 32 + 4));     }
                        st_bf16x8(bo + bj * 32, y0 * osc, y1 * osc); }
                }
        } else if (type == 2) {
#pragma unroll
            for (int ai = 0; ai < 2; ++ai)
#pragma unroll
                for (int m = 0; m < 4; ++m) {
                    const int row = rowb + ai * HALF + m * 16;
                    float* vo = (row < MP ? out + OFF_VP + (size_t)row * 512 : out + OFF_VS + (size_t)(row - MP) * 512) + lc0;
                    bf16_t* bo = dst + (size_t)row * 512 + lc0;
#pragma unroll
                    for (int bj = 0; bj < 2; ++bj) { const f32x4 y0 = acc[ai][bj][m][0], y1 = acc[ai][bj][m][1];
                        __builtin_nontemporal_store(y0, (f32x4*)(vo + bj * 32)); __builtin_nontemporal_store(y1, (f32x4*)(vo + bj * 32 + 4)); st_bf16x8(bo + bj * 32, y0, y1); }
                }
        } else if (type == 3 || type == 4) {
            const int h = half * 2 + (wc >> 1);
            const float l2g = __log2f(1.f - exp2f(-5.f - (float)h));
#pragma unroll
            for (int ai = 0; ai < 2; ++ai) {
                f32x4 cs[4][2][2];
#pragma unroll
                for (int m = 0; m < 4; ++m) { const float* rp = rot + (size_t)row_pos(rowb + ai * HALF + m * 16) * 128;
#pragma unroll
                    for (int bj = 0; bj < 2; ++bj)
#pragma unroll
                        for (int n = 0; n < 2; ++n) cs[m][bj][n] = *(const f32x4*)(rp + ((lc0 + bj * 32 + n * 4) & 127)); }
#pragma unroll
                for (int m = 0; m < 4; ++m) {
                    const int row = rowb + ai * HALF + m * 16;
                    float ksc = 1.f;
                    if (type == 4) { const int e = row < MP ? 63 - (row & 63) : 31 - ((row - MP) & 31); ksc = 0.08838834764831845f * exp2f((float)e * l2g); }
                    bf16_t* bo = dst + (size_t)row * 512 + lc0;
#pragma unroll
                    for (int bj = 0; bj < 2; ++bj) { f32x4 y[2];
#pragma unroll
                        for (int n = 0; n < 2; ++n) { const f32x4 c4 = cs[m][bj][n]; const f32x4 v = acc[ai][bj][m][n];
                            y[n][0] = v[0] * c4[0] - v[1] * c4[1]; y[n][1] = v[0] * c4[1] + v[1] * c4[0]; y[n][2] = v[2] * c4[2] - v[3] * c4[3]; y[n][3] = v[2] * c4[3] + v[3] * c4[2]; }
                        st_bf16x8(bo + bj * 32, y[0] * ksc, y[1] * ksc); }
                }
            }
        } else {
#pragma unroll
            for (int ai = 0; ai < 2; ++ai)
#pragma unroll
                for (int m = 0; m < 4; ++m) {
                    const int row = rowb + ai * HALF + m * 16;
                    bf16_t* bo = dst + (size_t)row * 512 + lc0;
#pragma unroll
                    for (int bj = 0; bj < 2; ++bj) { f32x4 y[2];
#pragma unroll
                        for (int n = 0; n < 2; ++n) { y[n] = acc[ai][bj][m][n];
                            if (type == 6) { y[n][0] = silu_f(y[n][0]); y[n][1] = silu_f(y[n][1]); y[n][2] = silu_f(y[n][2]); y[n][3] = silu_f(y[n][3]); } }
                        st_bf16x8(bo + bj * 32, y[0], y[1]); }
                }
        }
    }
};

struct EpiOut {
    static constexpr bool PERM = false, AFTER_DRAIN = false;
    const float* xp; const float* xs; bf16_t* x1b; bf16_t* xn2; const float* mod; const float* gmod2; float* rowss; float psc;
    __device__ __forceinline__ void operator()(const f32x4 (&acc)[2][2][4][2], const Unit& u, int wr, int wc, int fr, int fq) const {
        const int col0 = u.pn * BM + wc * 32 + 8 * fq, rowb = u.pm * BM + wr * 64 + fr;
        const int b = (u.pm * BM) >> 13;
        const float* mb = mod + (size_t)b * (6 * DM) + 2 * DM + col0; const float* gm = gmod2 + (size_t)b * DM + col0;
        f32x4 gt[2][2], gg[2][2];
#pragma unroll
        for (int bj = 0; bj < 2; ++bj)
#pragma unroll
            for (int n = 0; n < 2; ++n) { gt[bj][n] = *(const f32x4*)(mb + bj * HALF + n * 4); gg[bj][n] = *(const f32x4*)(gm + bj * HALF + n * 4); }
#pragma unroll
        for (int am = 0; am < 4; ++am) { const int ai = am >> 1;
            f32x4 xv[2][2][2];
#pragma unroll
            for (int mm = 0; mm < 2; ++mm) { const float* xr = xp + (size_t)(rowb + ai * HALF + ((am & 1) * 2 + mm) * 16) * DM + col0;
#pragma unroll
                for (int bj = 0; bj < 2; ++bj)
#pragma unroll
                    for (int n = 0; n < 2; ++n) xv[mm][bj][n] = __builtin_nontemporal_load((const f32x4*)(xr + bj * HALF + n * 4)); }
#pragma unroll
            for (int mm = 0; mm < 2; ++mm) { const int m = (am & 1) * 2 + mm;
                const int row = rowb + ai * HALF + m * 16;
                bf16_t* yo = x1b + (size_t)row * DM + col0; bf16_t* no = xn2 + (size_t)row * DM + col0;
                float ss = 0.f;
#pragma unroll
                for (int bj = 0; bj < 2; ++bj) { f32x4 x1[2];
#pragma unroll
                    for (int n = 0; n < 2; ++n) { const int o = bj * HALF + n * 4;
                        x1[n] = xv[mm][bj][n] + gt[bj][n] * acc[ai][bj][m][n];
                        ss += (x1[n][0] * x1[n][0] + x1[n][1] * x1[n][1]) + (x1[n][2] * x1[n][2] + x1[n][3] * x1[n][3]); }
                    { u32x4 w_; w_.x = cvt_pk_bf16(x1[0][0], x1[0][1]); w_.y = cvt_pk_bf16(x1[0][2], x1[0][3]); w_.z = cvt_pk_bf16(x1[1][0], x1[1][1]); w_.w = cvt_pk_bf16(x1[1][2], x1[1][3]); __builtin_nontemporal_store(w_, (u32x4*)(yo + bj * HALF)); }
                    st_bf16x8(no + bj * HALF, x1[0] * gg[bj][0], x1[1] * gg[bj][1]); }
                ss += __shfl_xor(ss, 16); ss += __shfl_xor(ss, 32);
                if (fq == 0) atomicAdd(rowss + row, ss * psc);
            }
            asm volatile("" ::: "memory");
        }
    }
};

struct EpiFF1 {
    static constexpr bool PERM = false, AFTER_DRAIN = false;
    const float* rowss; const float* sbg; const float* sbu; bf16_t* H;
    __device__ __forceinline__ void operator()(const f32x4 (&acc)[2][2][4][2], const Unit& u, int wr, int wc, int fr, int fq) const {
        const int f0 = u.pn * 128 + wc * 32 + fq * 8, rowb = u.pm * BM + wr * 64 + fr;
        const int b = (u.pm * BM) >> 13;
        f32x4 bg[2], bu[2]; float rs[2][4];
#pragma unroll
        for (int n = 0; n < 2; ++n) { bg[n] = *(const f32x4*)(sbg + (size_t)b * DFF + f0 + n * 4); bu[n] = *(const f32x4*)(sbu + (size_t)b * DFF + f0 + n * 4); }
#pragma unroll
        for (int ai = 0; ai < 2; ++ai)
#pragma unroll
            for (int m = 0; m < 4; ++m) rs[ai][m] = rowss[rowb + ai * HALF + m * 16];
#pragma unroll
        for (int ai = 0; ai < 2; ++ai)
#pragma unroll
            for (int m = 0; m < 4; ++m) {
                const int row = rowb + ai * HALF + m * 16;
                const float rstd = rsqrtf(rs[ai][m] * (1.f / (float)DM) + EPSN);
                u32x2 w2[2];
#pragma unroll
                for (int n = 0; n < 2; ++n) {
                    const f32x4 hg = acc[ai][0][m][n] * rstd + bg[n];
                    const f32x4 hu = acc[ai][1][m][n] * rstd + bu[n];
                    w2[n].x = cvt_pk_bf16(silu_f(hg[0]) * hu[0], silu_f(hg[1]) * hu[1]); w2[n].y = cvt_pk_bf16(silu_f(hg[2]) * hu[2], silu_f(hg[3]) * hu[3]); }
                u32x4 w4; w4.x = w2[0].x; w4.y = w2[0].y; w4.z = w2[1].x; w4.w = w2[1].y;
                *(u32x4*)(H + (size_t)row * DFF + f0) = w4;
            }
    }
};

struct EpiFF2 {
    static constexpr bool PERM = false, AFTER_DRAIN = false;
    float* y; const bf16_t* x1b; const float* mod; float psc;
    __device__ __forceinline__ void operator()(const f32x4 (&acc)[2][2][4][2], const Unit& u, int wr, int wc, int fr, int fq) const {
        const int col0 = u.pn * BM + wc * 32 + 8 * fq, rowb = u.pm * BM + wr * 64 + fr;
        const float* mb = mod + (size_t)((u.pm * BM) >> 13) * (6 * DM) + 5 * DM + col0;
        f32x4 gt[2][2];
#pragma unroll
        for (int bj = 0; bj < 2; ++bj)
#pragma unroll
            for (int n = 0; n < 2; ++n) gt[bj][n] = *(const f32x4*)(mb + bj * HALF + n * 4) * psc;
#pragma unroll
        for (int ai = 0; ai < 2; ++ai) {
            u32x4 xv[4][2];
#pragma unroll
            for (int m = 0; m < 4; ++m) { const bf16_t* xr = x1b + (size_t)(rowb + ai * HALF + m * 16) * DM + col0;
#pragma unroll
                for (int bj = 0; bj < 2; ++bj) xv[m][bj] = __builtin_nontemporal_load((const u32x4*)(xr + bj * HALF)); }
#pragma unroll
            for (int m = 0; m < 4; ++m) { float* yo = y + (size_t)(rowb + ai * HALF + m * 16) * DM + col0;
#pragma unroll
                for (int bj = 0; bj < 2; ++bj) { const u32x4 w = xv[m][bj];
                    f32x4 x0, x1;
                    x0[0] = __uint_as_float(w.x << 16); x0[1] = __uint_as_float(w.x & 0xffff0000u); x0[2] = __uint_as_float(w.y << 16); x0[3] = __uint_as_float(w.y & 0xffff0000u);
                    x1[0] = __uint_as_float(w.z << 16); x1[1] = __uint_as_float(w.z & 0xffff0000u); x1[2] = __uint_as_float(w.w << 16); x1[3] = __uint_as_float(w.w & 0xffff0000u);
                    __builtin_nontemporal_store(x0 + gt[bj][0] * acc[ai][bj][m][0], (f32x4*)(yo + bj * HALF));
                    __builtin_nontemporal_store(x1 + gt[bj][1] * acc[ai][bj][m][1], (f32x4*)(yo + bj * HALF + 4)); } }
            asm volatile("" ::: "memory");
        }
    }
};

struct EpiNull {
    static constexpr bool PERM = false, AFTER_DRAIN = false;
    __device__ __forceinline__ void operator()(const f32x4 (&acc)[2][2][4][2], const Unit& u, int wr, int wc, int fr, int fq) const {
#pragma unroll
        for (int ai = 0; ai < 2; ++ai)
#pragma unroll
            for (int bj = 0; bj < 2; ++bj)
#pragma unroll
                for (int m = 0; m < 4; ++m)
#pragma unroll
                    for (int n = 0; n < 2; ++n) asm volatile("" :: "v"(acc[ai][bj][m][n]));
    }
};
template <class Epi, class Sched, bool ALIGN_EPI = false, bool SP2 = false>
__device__ __forceinline__ void gemm_phase(PG8_LAS unsigned char* lds, const Gemm g, const Sched& S, const Epi& E) {
    int tid = threadIdx.x; asm volatile("" : "+v"(tid));
    const int wid = __builtin_amdgcn_readfirstlane(tid >> 6), lane = tid & 63, wr = wid >> 2, wc = wid & 3, fr = lane & 15, fq = lane >> 4;
    const int K = g.K, nt = K / BK;
    unsigned voffA[2], voffB[2];
#pragma unroll
    for (int i = 0; i < 2; ++i) { int R, C; stage_rc(tid * 16 + i * 8192, R, C); const int Rb = Epi::PERM ? ((R & ~31) + perm32(R & 31)) : R;
        voffA[i] = (unsigned)(R * K + C) * 2u; voffB[i] = (unsigned)(Rb * K + C) * 2u; }
    const size_t kstep = (size_t)(BK * 2);
    const size_t hstep = (size_t)HALF * K * 2;
    const size_t tstep = 2 * hstep;
    const unsigned ldsw = (unsigned)wid * 1024u;
    const int aoff = lds_byte(wr * 64 + fr, fq * 8), boff = lds_byte(wc * 32 + fr, fq * 8);
#define PG8_SA(b, h) (((b) * 2 + (h)) * HTB)
#define PG8_SB(b, h) ((4 + (b) * 2 + (h)) * HTB)
#define PG8_STAGE(bufoff, gbase, voff) do { _Pragma("unroll") for (int _i = 0; _i < 2; ++_i) \
        __builtin_amdgcn_global_load_lds((const unsigned*)((const char*)(gbase) + (voff)[_i]), (PG8_LAS unsigned*)(lds + (bufoff) + ldsw + _i * 8192), 16, 0, 0); } while (0)
#define PG8_LDA(dst, b, h) do { _Pragma("unroll") for (int m = 0; m < 4; ++m) _Pragma("unroll") for (int k = 0; k < 2; ++k) dst[m][k] = *(const PG8_LAS bf16x8*)(lds + PG8_SA(b, h) + aoff + m * 2048 + k * 1024); } while (0)
#define PG8_LDB(dst, b, h) do { _Pragma("unroll") for (int n = 0; n < 2; ++n) _Pragma("unroll") for (int k = 0; k < 2; ++k) dst[n][k] = *(const PG8_LAS bf16x8*)(lds + PG8_SB(b, h) + boff + n * 2048 + k * 1024); } while (0)
#define PG8_MMA(ai, bj, At, Bt) do { __builtin_amdgcn_s_setprio(1); _Pragma("unroll") for (int m = 0; m < 4; ++m) _Pragma("unroll") for (int n = 0; n < 2; ++n) _Pragma("unroll") for (int k = 0; k < 2; ++k) \
        acc[ai][bj][m][n] = __builtin_amdgcn_mfma_f32_16x16x32_bf16(Bt[n][k], At[m][k], acc[ai][bj][m][n], 0, 0, 0); __builtin_amdgcn_s_setprio(0); } while (0)
#define PG8_WAIT_V(n) asm volatile("s_waitcnt vmcnt(" #n ")" ::: "memory")
#define PG8_WAIT_L(n) asm volatile("s_waitcnt lgkmcnt(" #n ")" ::: "memory")
#define PG8_BAR __builtin_amdgcn_s_barrier()
#define PG8_SCHED __builtin_amdgcn_sched_barrier(0)
    Unit cur, nxt; int ui = 0;
    if (!S.next(0, cur)) return;
    f32x4 acc[2][2][4][2];
#pragma unroll
    for (int a = 0; a < 2; ++a)
#pragma unroll
        for (int b = 0; b < 2; ++b)
#pragma unroll
            for (int m = 0; m < 4; ++m)
#pragma unroll
                for (int n = 0; n < 2; ++n) acc[a][b][m][n] = (f32x4){0.f, 0.f, 0.f, 0.f};
    bf16x8 At[4][2], B0[2][2], B1[2][2];
    const char* cA = (const char*)g.A + (size_t)cur.pm * tstep; const char* cB = (const char*)g.Bt + (size_t)cur.pn * tstep;
    S.a_ready(cur);
    if constexpr (SP2) {
        PG8_STAGE(PG8_SB(0, 0), cB, voffB); PG8_STAGE(PG8_SB(0, 1), cB + hstep, voffB); PG8_STAGE(PG8_SA(0, 0), cA, voffA); PG8_STAGE(PG8_SA(0, 1), cA + hstep, voffA);
        if (wr == 1) PG8_BAR;
        PG8_WAIT_V(2); PG8_BAR;
        PG8_STAGE(PG8_SB(1, 0), cB + kstep, voffB); PG8_STAGE(PG8_SA(1, 0), cA + kstep, voffA); PG8_STAGE(PG8_SB(1, 1), cB + hstep + kstep, voffB);
        PG8_WAIT_V(6); PG8_BAR;
    } else {
        PG8_STAGE(PG8_SB(0, 0), cB, voffB); PG8_STAGE(PG8_SA(0, 0), cA, voffA); PG8_STAGE(PG8_SB(0, 1), cB + hstep, voffB); PG8_STAGE(PG8_SA(0, 1), cA + hstep, voffA);
        if (wr == 1) PG8_BAR;
        PG8_WAIT_V(4); PG8_BAR;
        PG8_STAGE(PG8_SB(1, 0), cB + kstep, voffB); PG8_STAGE(PG8_SA(1, 0), cA + kstep, voffA); PG8_STAGE(PG8_SB(1, 1), cB + hstep + kstep, voffB);
        PG8_WAIT_V(6); PG8_BAR;
    }
    for (;;) {
        const bool has_next = S.next(ui + 1, nxt);
        const char* nA = has_next ? (const char*)g.A + (size_t)nxt.pm * tstep : cA; const char* nB = has_next ? (const char*)g.Bt + (size_t)nxt.pn * tstep : cB;
        for (int t = 0; t < nt; t += 2) {
            const bool last = (t == nt - 2);
            const char* a1 = cA + (size_t)(t + 1) * kstep;
            const char* a2 = last ? nA : cA + (size_t)(t + 2) * kstep; const char* b2 = last ? nB : cB + (size_t)(t + 2) * kstep;
            const char* a3 = a2 + kstep; const char* b3 = b2 + kstep;
            if (last && has_next) S.a_ready(nxt);
            if constexpr (SP2) {
            PG8_LDB(B0, 0, 0); PG8_LDB(B1, 0, 1); PG8_SCHED; PG8_LDA(At, 0, 0); PG8_STAGE(PG8_SA(1, 1), a1 + hstep, voffA);
            PG8_WAIT_V(8); PG8_WAIT_L(0); PG8_BAR; PG8_MMA(0, 0, At, B0); PG8_MMA(0, 1, At, B1); PG8_BAR; PG8_SCHED;
            PG8_LDA(At, 0, 1); PG8_STAGE(PG8_SB(0, 0), b2, voffB); PG8_STAGE(PG8_SB(0, 1), b2 + hstep, voffB); PG8_STAGE(PG8_SA(0, 0), a2, voffA);
            PG8_WAIT_V(8); PG8_WAIT_L(0); PG8_BAR; PG8_MMA(1, 0, At, B0); PG8_MMA(1, 1, At, B1); PG8_BAR; PG8_SCHED;
            PG8_LDB(B0, 1, 0); PG8_LDB(B1, 1, 1); PG8_SCHED; PG8_LDA(At, 1, 0); PG8_STAGE(PG8_SA(0, 1), a2 + hstep, voffA);
            PG8_WAIT_V(8); PG8_WAIT_L(0); PG8_BAR; PG8_MMA(0, 0, At, B0); PG8_MMA(0, 1, At, B1); PG8_BAR; PG8_SCHED;
            PG8_LDA(At, 1, 1); PG8_STAGE(PG8_SB(1, 0), b3, voffB); PG8_STAGE(PG8_SB(1, 1), b3 + hstep, voffB); PG8_STAGE(PG8_SA(1, 0), a3, voffA);
            PG8_WAIT_V(8); PG8_WAIT_L(0); PG8_BAR; PG8_MMA(1, 0, At, B0); PG8_MMA(1, 1, At, B1); PG8_BAR; PG8_SCHED;
            } else {
            PG8_LDB(B0, 0, 0); PG8_SCHED; PG8_LDA(At, 0, 0); PG8_STAGE(PG8_SA(1, 1), a1 + hstep, voffA);
            PG8_WAIT_L(8); PG8_BAR; PG8_WAIT_L(0); PG8_MMA(0, 0, At, B0); PG8_BAR; PG8_SCHED;
            PG8_LDB(B1, 0, 1); PG8_STAGE(PG8_SB(0, 0), b2, voffB);
            PG8_BAR; PG8_WAIT_L(0); PG8_MMA(0, 1, At, B1); PG8_BAR;
            PG8_LDA(At, 0, 1); PG8_STAGE(PG8_SA(0, 0), a2, voffA);
            PG8_BAR; PG8_WAIT_L(0); PG8_MMA(1, 0, At, B0); PG8_BAR; PG8_SCHED;
            PG8_STAGE(PG8_SB(0, 1), b2 + hstep, voffB);
            PG8_WAIT_V(6); PG8_BAR; PG8_MMA(1, 1, At, B1); PG8_BAR;
            PG8_LDB(B0, 1, 0); PG8_SCHED; PG8_LDA(At, 1, 0); PG8_STAGE(PG8_SA(0, 1), a2 + hstep, voffA);
            PG8_WAIT_L(8); PG8_BAR; PG8_WAIT_L(0); PG8_MMA(0, 0, At, B0); PG8_BAR; PG8_SCHED;
            PG8_LDB(B1, 1, 1); PG8_STAGE(PG8_SB(1, 0), b3, voffB);
            PG8_BAR; PG8_WAIT_L(0); PG8_MMA(0, 1, At, B1); PG8_BAR;
            PG8_LDA(At, 1, 1); PG8_STAGE(PG8_SA(1, 0), a3, voffA);
            PG8_BAR; PG8_WAIT_L(0); PG8_MMA(1, 0, At, B0); PG8_BAR; PG8_SCHED;
            PG8_STAGE(PG8_SB(1, 1), b3 + hstep, voffB);
            PG8_WAIT_V(6); PG8_BAR; PG8_MMA(1, 1, At, B1); PG8_BAR;
            }
        }
        if constexpr (ALIGN_EPI) { if (wr == 0) PG8_BAR; }
        if constexpr (!Epi::AFTER_DRAIN) { E(acc, cur, wr, wc, fr, fq); S.done(cur); }
        if (!has_next) break;
#pragma unroll
        for (int a = 0; a < 2; ++a)
#pragma unroll
            for (int b = 0; b < 2; ++b)
#pragma unroll
                for (int m = 0; m < 4; ++m)
#pragma unroll
                    for (int n = 0; n < 2; ++n) acc[a][b][m][n] = (f32x4){0.f, 0.f, 0.f, 0.f};
        cur = nxt; cA = nA; cB = nB; ++ui;
        if constexpr (ALIGN_EPI) { if (wr == 1) PG8_BAR; }
    }
    PG8_WAIT_V(0);
    if constexpr (!ALIGN_EPI) { if (wr == 0) PG8_BAR; }
    PG8_BAR;
    if constexpr (Epi::AFTER_DRAIN) { E.fused(acc, cur, wr, wc, fr, fq, lds, wid, lane); S.done(cur); }
#undef PG8_SA
#undef PG8_SB
#undef PG8_STAGE
#undef PG8_LDA
#undef PG8_LDB
#undef PG8_MMA
#undef PG8_WAIT_V
#undef PG8_WAIT_L
#undef PG8_BAR
#undef PG8_SCHED
}
}
#define GAS __attribute__((address_space(1)))
#define LAS __attribute__((address_space(3)))
typedef unsigned short bf16;
typedef unsigned v4u __attribute__((ext_vector_type(4)));
typedef float f32x4 __attribute__((ext_vector_type(4)));
typedef short bf16x8 __attribute__((ext_vector_type(8)));
typedef GAS unsigned gu32;
typedef GAS unsigned long long gu64;
#define RLX_AGENT __ATOMIC_RELAXED, __HIP_MEMORY_SCOPE_AGENT
#define LDS_WAIT() asm volatile("s_waitcnt lgkmcnt(0)" ::: "memory")
#define VM_WAIT() asm volatile("s_waitcnt vmcnt(0)" ::: "memory")
__device__ __forceinline__ unsigned long long rt() { return __builtin_amdgcn_s_memrealtime(); }
__device__ __forceinline__ unsigned f2bf(float f) { unsigned u = __builtin_bit_cast(unsigned, f); return (u + 0x7fffu + ((u >> 16) & 1u)) >> 16; }
__device__ __forceinline__ unsigned pk2(float lo, float hi) { return f2bf(lo) | (f2bf(hi) << 16); }

#define XB_TMO      128
#define XB_XCNT(j)  (256  + 64 * (j))
#define XB_XSUB(j)  (1280 + 64 * (j))
#define XB_XGEN(j)  (2304 + 64 * (j))
#define XB_TOP      3328
#define XB_TOPGEN   3392
#define XCD_BAR_WORDS 3456
#define XB_SPIN_CAP (1u << 18)

__device__ __forceinline__ unsigned xb_ld(unsigned* p)              { return __hip_atomic_load(p, __ATOMIC_RELAXED, __HIP_MEMORY_SCOPE_AGENT); }
__device__ __forceinline__ unsigned xb_add(unsigned* p, unsigned v) { return __hip_atomic_fetch_add(p, v, __ATOMIC_RELAXED, __HIP_MEMORY_SCOPE_AGENT); }
__device__ __forceinline__ unsigned xb_xcc_id() { return (unsigned)__builtin_amdgcn_s_getreg((3 << 11) | 20) & 0xFu; }
#define XB_SPIN(cond, bar) do { unsigned _sp = 0; while (cond) { __builtin_amdgcn_s_sleep(1); \
    if ((++_sp & 255u) == 0u) { if (xb_ld(&(bar)[XB_TMO])) break; if (_sp > XB_SPIN_CAP) { atomicAdd(&(bar)[XB_TMO], 1u); break; } } } } while (0)

struct XcdBarrier {
    unsigned* bar; unsigned x;
    volatile LAS unsigned* st;
};

__device__ __forceinline__ XcdBarrier xcd_barrier_post(unsigned* bar, volatile LAS unsigned* st) {
    XcdBarrier b; b.bar = bar; b.x = xb_xcc_id(); b.st = st;
    if (threadIdx.x == 0) (void)xb_add(&bar[XB_XCNT(b.x)], 1u);
    return b;
}
__device__ __forceinline__ void xcd_barrier_complete(unsigned* bar, unsigned x, unsigned& nloc, unsigned& nx) {
    const unsigned G = gridDim.x * gridDim.y * gridDim.z;
    unsigned sum, cnt, mine, sp = 0u;
    for (;;) {
        sum = 0u; cnt = 0u; mine = 0u;
#pragma unroll
        for (unsigned j = 0; j < 16; ++j) { const unsigned c = xb_ld(&bar[XB_XCNT(j)]); sum += c; cnt += (c > 0u) ? 1u : 0u; mine = (j == x) ? c : mine; }
        if (sum == G) break;
        __builtin_amdgcn_s_sleep(1);
        if ((++sp & 255u) == 0u) { if (xb_ld(&bar[XB_TMO])) break; if (sp > XB_SPIN_CAP) { atomicAdd(&bar[XB_TMO], 1u); break; } }
    }
    nloc = mine > 0u ? mine : 1u; nx = cnt > 0u ? cnt : 1u;
}

__device__ __forceinline__ void xcd_barrier(const XcdBarrier& b) {
    asm volatile("s_waitcnt vmcnt(0)" ::: "memory");
    __syncthreads();
    if (threadIdx.x == 0) {
        unsigned* bar = b.bar;
        __builtin_amdgcn_s_waitcnt(0);
        unsigned nloc = b.st[0], nx = b.st[1];
        if (nloc == 0u) { xcd_barrier_complete(bar, b.x, nloc, nx); b.st[0] = nloc; b.st[1] = nx; }
        const unsigned old = xb_add(&bar[XB_XSUB(b.x)], 1u);
        const unsigned gen = old / nloc;
        if (old + 1u == (gen + 1u) * nloc) {
            __builtin_amdgcn_fence(__ATOMIC_RELEASE, "agent");
            asm volatile("s_waitcnt vmcnt(0)" ::: "memory");
            const unsigned og = xb_add(&bar[XB_TOP], 1u);
            const unsigned tg = og / nx;
            if (og + 1u == (tg + 1u) * nx) xb_add(&bar[XB_TOPGEN], 1u);
            else XB_SPIN(xb_ld(&bar[XB_TOPGEN]) == tg, bar);
            __builtin_amdgcn_fence(__ATOMIC_ACQUIRE, "agent");
            xb_add(&bar[XB_XGEN(b.x)], 1u);
            asm volatile("s_waitcnt vmcnt(0)" ::: "memory");
        } else {
            XB_SPIN(xb_ld(&bar[XB_XGEN(b.x)]) == gen, bar);
            __builtin_amdgcn_fence(__ATOMIC_ACQUIRE, "agent");
            asm volatile("s_waitcnt vmcnt(0)" ::: "memory");
        }
    }
    __syncthreads();
}

constexpr size_t MiB = 1u << 20;
constexpr size_t WS_CTL = 0, CTL_ZERO_BYTES = 2 * MiB;
constexpr size_t WS_ROWSS = 256 * 1024, WS_MOD = 512 * 1024, WS_SB2 = 1 * MiB, WS_GMOD2 = 1536 * 1024;
constexpr size_t WS_ROT = 2 * MiB, WS_WIN = 6 * MiB, WS_WOUT = 13 * MiB, WS_WGU = 15 * MiB, WS_WDN = 26 * MiB;
constexpr size_t WS_XN = 32 * MiB, WS_OB = 97 * MiB, WS_ACT = 162 * MiB, WS_H = WS_ACT, WS_E = 390 * MiB, WS_X1B = 398 * MiB, WS_END = 463 * MiB;
constexpr size_t ACT_STRIDE = (size_t)MT * 512;
static_assert(WS_ROWSS + (size_t)MT * 4 <= WS_MOD && WS_MOD + (size_t)NBT * 6 * DM * 4 <= WS_SB2 && WS_SB2 + (size_t)2 * NBT * DFF * 4 <= WS_GMOD2 && WS_GMOD2 + (size_t)NBT * DM * 4 <= CTL_ZERO_BYTES, "ctl map");
static_assert(WS_WIN + (size_t)DIN * DM * 2 <= WS_WOUT && WS_WGU + (size_t)NGU * DM * 2 <= WS_WDN && WS_WDN + (size_t)DM * DFF * 2 <= WS_XN, "weights map");
static_assert(WS_XN + (size_t)MT * DM * 2 <= WS_OB && WS_OB + (size_t)MT * DM * 2 <= WS_ACT && WS_ACT + 7 * ACT_STRIDE * 2 <= WS_E && WS_X1B + (size_t)MP * DM * 2 <= WS_END && WS_H + (size_t)MT * DFF * 2 <= WS_END, "act map");
constexpr int CW_BAR = 4096;
constexpr int CW_QUEUE = 16384;
constexpr int CW_CNTA = 20480;
constexpr int RING_BYTES = 131072, LDSCTL_OFF = RING_BYTES, MISC_OFF = LDSCTL_OFF + 320;
constexpr int TAB_OFF = 132096, CB_OFF = TAB_OFF + 4096, WSC_OFF = CB_OFF + 64, QSLOT_OFF = WSC_OFF + 8 * 256, LDS_BYTES = 147456;
static_assert(QSLOT_OFF + 64 <= LDS_BYTES && MISC_OFF + 128 <= TAB_OFF, "LDS map");
constexpr int NWAVES = 8;
constexpr int WOUT_MODE = 4;

struct Args { const float* in[24]; float* out; unsigned char* ws; };
struct Frame {
    LAS unsigned char* lds; volatile LAS unsigned* MISC; gu32* ctl; int tid, lane, wave, G;
    const Args* A; float* out; unsigned char* ws;
};

__device__ __forceinline__ int dst_row(int mode, int n) {
    if (mode == 0) return n;
    if (mode == 1) { const int l = n & 255;
        return (n & ~255) + 128 * ((l >> 5) & 1) + 32 * (l >> 6) + 16 * ((l >> 2) & 1) + 4 * ((l >> 3) & 3) + (l & 3); }
    if (mode == 4) { const int l = n & 127;
        return (n & ~127) + 32 * (l >> 5) + 16 * ((l >> 2) & 1) + 4 * ((l >> 3) & 3) + (l & 3); }
    const int fl = n & 127;
    return (n >> 7) * 256 + 128 * (mode - 2) + 32 * (fl >> 5) + 16 * ((fl >> 2) & 1) + 4 * ((fl >> 3) & 3) + (fl & 3);
}
__device__ __forceinline__ void p0_transpose_item(const float* W, int K, int N, bf16* WT, int mode, LAS float* scr, int item, int lane) {
    const int nblk = N / 32, kb = item / nblk, nb = item % nblk, k0 = 64 * kb, n0 = 32 * nb;
#pragma unroll
    for (int i = 0; i < 32; ++i) { const int kk = 2 * i + (lane >> 5); scr[kk * 33 + (lane & 31)] = __builtin_nontemporal_load(W + (size_t)(k0 + kk) * N + n0 + (lane & 31)); }
    LDS_WAIT(); asm volatile("" ::: "memory");
    const int c = lane & 7;
#pragma unroll
    for (int j = 0; j < 4; ++j) { const int n = (lane >> 3) + 8 * j; const LAS float* s = scr + (8 * c) * 33 + n;
        v4u o; o.x = pk2(s[0 * 33], s[1 * 33]); o.y = pk2(s[2 * 33], s[3 * 33]); o.z = pk2(s[4 * 33], s[5 * 33]); o.w = pk2(s[6 * 33], s[7 * 33]);
        *(GAS v4u*)(WT + (size_t)dst_row(mode, n0 + n) * K + k0 + 8 * c) = o; }
    LDS_WAIT(); asm volatile("" ::: "memory");
}
__device__ __forceinline__ float wave_sum(float v) {
#pragma unroll
    for (int o = 1; o < 64; o <<= 1) v += __shfl_xor(v, o);
    return v;
}
__device__ __forceinline__ void gemv20_item(Frame& F, const float* W, int N, int e, bool valid, int kc, float* outp, int ostride, const float* bias) {
    LAS const float* sc = (LAS const float*)F.lds;
    float acc[NBT];
#pragma unroll
    for (int b = 0; b < NBT; ++b) acc[b] = 0.f;
    if (valid) {
#pragma unroll 16
        for (int d = 0; d < 64; ++d) { const float w = __builtin_nontemporal_load(W + (size_t)(kc * 64 + d) * N + e);
#pragma unroll
            for (int b = 0; b < NBT; ++b) acc[b] += sc[b * 64 + d] * w; }
        const float bb = (bias && kc == 0) ? bias[e] : 0.f;
#pragma unroll
        for (int b = 0; b < NBT; ++b) atomicAdd(outp + (size_t)b * ostride + e, acc[b] + bb);
    }
}
__device__ __forceinline__ void p0a(Frame& F, bool gemv = true) {
    const float* cp = F.A->in[2]; const float* cs = F.A->in[3]; const float* w_ada = F.A->in[7]; const float* b_ada = F.A->in[8];
    float* mod = (float*)(F.ws + WS_MOD);
    if (gemv) for (int it = blockIdx.x; it < 256; it += F.G) {
        const int cg = it & 15, kc = it >> 4;
        LAS float* sc = (LAS float*)F.lds;
        for (int idx = F.tid; idx < NBT * 64; idx += 512) { const int b = idx >> 6, d = idx & 63;
            const float c = b < NBP ? cp[b * DM + kc * 64 + d] : cs[(b - NBP) * DM + kc * 64 + d]; sc[idx] = c / (1.f + __expf(-c)); }
        __syncthreads();
        gemv20_item(F, w_ada, 6 * DM, cg * 384 + (F.tid < 384 ? F.tid : 0), F.tid < 384, kc, mod, 6 * DM, b_ada);
        __syncthreads();
    }
    LAS float* scr = (LAS float*)(F.lds + F.wave * 16384);
    const int gw = blockIdx.x * NWAVES + F.wave, NGW = F.G * NWAVES;
    constexpr int I_IN = (DM / 64) * (DIN / 32), I_O = (DM / 64) * (DM / 32), I_G = (DM / 64) * (DFF / 32), I_D = (DFF / 64) * (DM / 32);
    constexpr int NITEMS = I_IN + I_O + 2 * I_G + I_D;
    bf16* win = (bf16*)(F.ws + WS_WIN); bf16* wout = (bf16*)(F.ws + WS_WOUT); bf16* wgu = (bf16*)(F.ws + WS_WGU); bf16* wdn = (bf16*)(F.ws + WS_WDN);
    for (int i = gw; i < NITEMS; i += NGW) {
        int r = i;
        if (r < I_IN) { p0_transpose_item(F.A->in[11], DM, DIN, win, 1, scr, r, F.lane); continue; } r -= I_IN;
        if (r < I_O) { p0_transpose_item(F.A->in[19], DM, DM, wout, WOUT_MODE, scr, r, F.lane); continue; } r -= I_O;
        if (r < I_G) { p0_transpose_item(F.A->in[20], DM, DFF, wgu, 2, scr, r, F.lane); continue; } r -= I_G;
        if (r < I_G) { p0_transpose_item(F.A->in[21], DM, DFF, wgu, 3, scr, r, F.lane); continue; } r -= I_G;
        p0_transpose_item(F.A->in[22], DFF, DM, wdn, WOUT_MODE, scr, r, F.lane);
    }
    float* rot = (float*)(F.ws + WS_ROT);
    for (int idx = blockIdx.x * 512 + F.tid; idx < 8192 * 64; idx += F.G * 512) {
        const int pos = idx >> 6, ip = idx & 63;
        const float inv = 1.0f / exp2f(((float)ip * (1.0f / 63.0f)) * 13.287712379549449f);
        const float ang = (float)pos * inv;
        const double rev = (double)ang * 0.15915494309189535; const float fr = (float)(rev - __builtin_rint(rev));
        float2 o; o.x = __builtin_amdgcn_cosf(fr); o.y = __builtin_amdgcn_sinf(fr);
        ((float2*)rot)[idx] = o;
    }
}
__device__ __forceinline__ void p0b(Frame& F, bool gemv = true) {
    const float* mod = (const float*)(F.ws + WS_MOD);
    const int it = blockIdx.x;
    if (it < 192 && gemv) {
        const int mat = it & 1, rest = it >> 1, cg = rest % 6, kc = rest / 6;
        LAS float* sc = (LAS float*)F.lds;
        for (int idx = F.tid; idx < NBT * 64; idx += 512) { const int b = idx >> 6, d = idx & 63; sc[idx] = mod[(size_t)b * 6 * DM + 3 * DM + kc * 64 + d]; }
        __syncthreads();
        const int f = cg * 512 + F.tid;
        gemv20_item(F, (mat ? F.A->in[21] : F.A->in[20]), DFF, f, f < DFF, kc, (float*)(F.ws + WS_SB2) + (size_t)mat * NBT * DFF, DFF, nullptr);
        __syncthreads();
    }
    { float* gm2 = (float*)(F.ws + WS_GMOD2);
      for (int idx = blockIdx.x * 512 + F.tid; idx < NBT * DM; idx += F.G * 512) { const int b = idx >> 10, c = idx & 1023; gm2[idx] = F.A->in[10][c] * (1.f + mod[(size_t)b * 6 * DM + 4 * DM + c]); } }
    const float* g1 = F.A->in[9]; bf16* xn = (bf16*)(F.ws + WS_XN);
    const int gw = blockIdx.x * NWAVES + F.wave, NGW = F.G * NWAVES;
    for (int m0 = gw; m0 < MT; m0 += 4 * NGW) {
        f32x4 v[4][4];
#pragma unroll
        for (int q = 0; q < 4; ++q) { const int m = m0 + q * NGW; if (m < MT) {
            const GAS f32x4* xr = (const GAS f32x4*)(m < MP ? F.A->in[0] + (size_t)m * DM : F.A->in[1] + (size_t)(m - MP) * DM) + F.lane;
#pragma unroll
            for (int j = 0; j < 4; ++j) v[q][j] = __builtin_nontemporal_load((const f32x4*)(xr + 64 * j)); } }
#pragma unroll
        for (int q = 0; q < 4; ++q) { const int m = m0 + q * NGW; if (m < MT) {
            const float* mb = mod + (size_t)row_batch(m) * 6 * DM; float s = 0.f;
#pragma unroll
            for (int j = 0; j < 4; ++j) s += (v[q][j].x * v[q][j].x + v[q][j].y * v[q][j].y) + (v[q][j].z * v[q][j].z + v[q][j].w * v[q][j].w);
            const float rstd = rsqrtf(wave_sum(s) * (1.f / DM) + EPSN);
            GAS unsigned long long* o8 = (GAS unsigned long long*)(xn + (size_t)m * DM) + F.lane;
#pragma unroll
            for (int j = 0; j < 4; ++j) { const int c = 4 * F.lane + 256 * j;
                const f32x4 g = *(const f32x4*)(g1 + c), sc1 = *(const f32x4*)(mb + DM + c), sh1 = *(const f32x4*)(mb + c);
                const f32x4 h = v[q][j] * rstd * g * (sc1 + 1.f) + sh1;
                o8[64 * j] = (unsigned long long)pk2(h.x, h.y) | ((unsigned long long)pk2(h.z, h.w) << 32); } } }
    }
}


namespace p2 {
typedef short bf16x8 __attribute__((ext_vector_type(8)));
typedef short s16x4 __attribute__((ext_vector_type(4)));
typedef float f32x16 __attribute__((ext_vector_type(16)));
typedef float f32x4 __attribute__((ext_vector_type(4)));
typedef unsigned u32x4 __attribute__((ext_vector_type(4)));
typedef unsigned u32x2 __attribute__((ext_vector_type(2)));
typedef float f32x2_t __attribute__((ext_vector_type(2))); typedef __bf16 bf16x2_t __attribute__((ext_vector_type(2)));
__device__ __forceinline__ unsigned cvtpk(float lo, float hi) { f32x2_t v = {lo, hi}; bf16x2_t b = __builtin_convertvector(v, bf16x2_t); return __builtin_bit_cast(unsigned, b); }
__device__ __forceinline__ int crow(int r, int hi) { return (r & 3) + 8 * (r >> 2) + 4 * hi; }
__device__ __forceinline__ s16x4 vtr(LAS const unsigned char* p) { return __builtin_bit_cast(s16x4, __builtin_amdgcn_ds_read_tr16_b64_v4i16((LAS s16x4*)p)); }
__device__ __forceinline__ bf16x8 cat8(s16x4 l, s16x4 h) { return (bf16x8){l[0], l[1], l[2], l[3], h[0], h[1], h[2], h[3]}; }
__device__ __forceinline__ bf16x8 pack8(f32x4 a, f32x4 b) { u32x4 w = {cvtpk(a[0], a[1]), cvtpk(a[2], a[3]), cvtpk(b[0], b[1]), cvtpk(b[2], b[3])}; return __builtin_bit_cast(bf16x8, w); }
__device__ __forceinline__ int v_st(int k, int c) { const int kk = (k & ~0xC) | ((k & 4) << 1) | ((k & 8) >> 1); return ((kk >> 3) * 4 + (c >> 5)) * 512 + ((kk & 7) * 32 + (c & 31)) * 2; }
__device__ __forceinline__ int v_rd_base(int lane) { return ((lane & 3) << 3) | (((lane >> 2) & 3) << 6) | (((lane >> 4) & 1) << 5) | (((lane >> 5) & 1) << 8); }
#define PK4(P, BASE, OUT) do { unsigned a0_ = cvtpk(P[BASE + 0], P[BASE + 1]), a1_ = cvtpk(P[BASE + 2], P[BASE + 3]);   \
    unsigned b0_ = cvtpk(P[BASE + 4], P[BASE + 5]), b1_ = cvtpk(P[BASE + 6], P[BASE + 7]);                              \
    auto r0_ = __builtin_amdgcn_permlane32_swap(a0_, b0_, false, false); auto r1_ = __builtin_amdgcn_permlane32_swap(a1_, b1_, false, false); \
    u32x4 w_ = {r0_[0], r1_[0], r0_[1], r1_[1]}; OUT = __builtin_bit_cast(bf16x8, w_); } while (0)

__device__ __forceinline__ int t5_bucket(int rel) {
    const int n = rel < 0 ? -rel : rel; const int ret = rel > 0 ? 16 : 0;
    const int large = n < 12 ? 8 : n < 16 ? 9 : n < 23 ? 10 : n < 32 ? 11 : n < 46 ? 12 : n < 64 ? 13 : n < 91 ? 14 : 15;
    return ret + (n < 8 ? n : large);
}
__device__ __forceinline__ void p2_setup(Frame& F) {
    const float* gq = F.A->in[12]; const float* gk = F.A->in[13]; const float* rb = F.A->in[23];
    float gqm = 0.f, gkm = 0.f, s1 = 0.f, s2 = 0.f;
    for (int d = 0; d < 64; ++d) { gqm = fmaxf(gqm, fabsf(gq[d])); gkm = fmaxf(gkm, fabsf(gk[d])); s1 += F.A->in[14][d] * F.A->in[15][d]; s2 += F.A->in[16][d] * F.A->in[17][d]; }
    LAS float* tab = (LAS float*)(F.lds + TAB_OFF); LAS float* cb = (LAS float*)(F.lds + CB_OFF);
    if (F.tid < 256) {
        const int rel = F.tid - 192; const int bk = t5_bucket(rel);
        for (int h = 0; h < 4; ++h) { float bm = -1e30f; for (int k = 0; k < 32; ++k) bm = fmaxf(bm, rb[k * 4 + h]);
            float bn = 1e30f; for (int k = 0; k < 32; ++k) bn = fminf(bn, rb[k * 4 + h]);
            const float bound = (8.f * gqm * gkm * 1.02f + (bm - bn)) * LOG2E;
            const float ch = rb[15 * 4 + h] + fmaxf(0.f, bound - 100.f) / LOG2E;
            tab[h * 256 + F.tid] = (rb[bk * 4 + h] - ch) * LOG2E;
            if (F.tid == 0) cb[h] = (rb[15 * 4 + h] - ch) * LOG2E; }
        if (F.tid == 0) cb[4] = __expf(s1) - __expf(s2) + LAM_INIT;
    }
    __syncthreads();
}

template <bool DVP = false>
__device__ __forceinline__ void attn_finish(LAS unsigned char* lds, f32x16 (&o)[4], const float (&rl)[16], bool active, int mp, int rg, float lam, const float* gs, bf16* orow0, int lane) {
    const int r32 = lane & 31, hi = lane >> 5;
    LAS float* ex = (LAS float*)lds + rg * 4096;
    if (active && mp == 1) {
#pragma unroll
        for (int d0 = 0; d0 < 4; ++d0)
#pragma unroll
            for (int r = 0; r < 16; ++r) ex[(d0 * 16 + r) * 64 + lane] = o[d0][r] * rl[r];
    }
    __syncthreads();
    if (active && mp == 0) {
#pragma unroll
        for (int d0 = 0; d0 < 4; ++d0)
#pragma unroll
            for (int r = 0; r < 16; ++r) o[d0][r] = o[d0][r] * rl[r] - lam * ex[(d0 * 16 + r) * 64 + lane];
        float gsv[4];
#pragma unroll
        for (int d0 = 0; d0 < 4; ++d0) gsv[d0] = gs[DVP ? 4 * r32 + d0 : 32 * d0 + r32] * (1.f - LAM_INIT);
        LAS bf16* st = (LAS bf16*)ex;
#pragma unroll
        for (int r = 0; r < 16; ++r) {
            float s = (o[0][r] * o[0][r] + o[1][r] * o[1][r]) + (o[2][r] * o[2][r] + o[3][r] * o[3][r]);
            s += __shfl_xor(s, 1); s += __shfl_xor(s, 2); s += __shfl_xor(s, 4); s += __shfl_xor(s, 8); s += __shfl_xor(s, 16);
            const float rn = rsqrtf(s * (1.f / 128.f) + EPSN);
#pragma unroll
            for (int d0 = 0; d0 < 4; ++d0) st[crow(r, hi) * 136 + (DVP ? 4 * r32 + d0 : d0 * 32 + r32)] = (bf16)f2bf(o[d0][r] * rn * gsv[d0]);
        }
#pragma unroll
        for (int i = 0; i < 8; ++i) { const int pi = i * 64 + lane, row = pi >> 4, ch = pi & 15;
            const u32x4 v = *(LAS const u32x4*)(st + row * 136 + ch * 8); *(u32x4*)(orow0 + (size_t)row * DM + ch * 8) = v; }
    }
    __syncthreads();
}

#ifndef ATT_VAR
#define ATT_VAR 0
#endif
template <int VAR>
__device__ __forceinline__ void attn_unit(Frame& F, const bf16* QA, const bf16* KA, const bf16* VA, bf16* OB, int b, int h, int qblk, float lam) {
    LAS unsigned char* lds = F.lds; int tid = F.tid; asm volatile("" : "+v"(tid)); const int wid = F.wave, lane = tid & 63;
    const int r32 = lane & 31, hi = lane >> 5, mp = wid >> 2, rg = wid & 3;
    const int q0 = qblk * 128, qw0 = q0 + rg * 32; const size_t rowbase = (size_t)b * SEQ;
    bf16x8 qr[4];
    { const bf16* qp = QA + (rowbase + qw0 + r32) * 512 + h * 128 + mp * 64 + hi * 8;
#pragma unroll
      for (int d0 = 0; d0 < 4; ++d0) qr[d0] = __builtin_nontemporal_load((const bf16x8*)(qp + d0 * 16)); }
    f32x16 o[4];
#pragma unroll
    for (int d0 = 0; d0 < 4; ++d0)
#pragma unroll
        for (int r = 0; r < 16; ++r) o[d0][r] = 0.f;
    float lsum = 0.f;
    const int NTw = (qw0 >> 6) + 1, NTu = (q0 >> 6) + 2, far_max = qw0 - 154;
    const float cbh = ((LAS const float*)(lds + CB_OFF))[h];
    LAS const float* tab = (LAS const float*)(lds + TAB_OFF) + h * 256;
    const bf16* kbu = KA + rowbase * 512 + h * 128; const bf16* vbu = VA + rowbase * 512 + h * 128;
    unsigned kofs[2], vofs[2];
#pragma unroll
    for (int i = 0; i < 2; ++i) { const int d = wid + 8 * i;
        const int key = 4 * d + (lane >> 4);
        kofs[i] = (unsigned)(key * 512 + (((lane & 15) ^ (key & 15)) * 8));
        const int kk = (d >> 1) * 8 + ((lane >> 2) & 7), kv = (kk & ~0xC) | ((kk & 4) << 1) | ((kk & 8) >> 1);
        vofs[i] = (unsigned)(kv * 512 + (2 * (d & 1) + (lane >> 5)) * 32 + (lane & 3) * 8); }
    int ka[4];
#pragma unroll
    for (int d0 = 0; d0 < 4; ++d0) ka[d0] = r32 * 256 + (((mp * 8 + 2 * d0 + hi) ^ (r32 & 15)) * 16);
    const int vrb = v_rd_base(lane);
    constexpr int VRING = 32768;
    const unsigned ldsbase = (unsigned)(size_t)lds;
#ifndef ATT_STAGGER
#define ATT_STAGGER 1
#endif
#ifndef ATT_DMA
#define ATT_DMA 1
#endif
#if ATT_DMA
#define DMA16(ldsa, voff, sbase) asm volatile("s_mov_b32 m0, %0\n\ts_nop 0\n\tglobal_load_lds_dwordx4 %1, %2" :: "s"(ldsa), "v"(voff), "s"(sbase) : "memory", "m0")
#define LOADS(S, t) do { if (VAR & 1) break; const size_t go_ = (size_t)(t) * 64 * 512; const int ko_ = ((t) & 1) * 16384, vo_ = VRING + ((t) & 3) * 16384; \
        const bf16* kb_ = kbu + go_; const bf16* vb2_ = vbu + go_; const unsigned lb_ = ldsbase + wid * 1024; \
        DMA16(lb_ + ko_, kofs[0] * 2u, kb_); DMA16(lb_ + ko_ + 8192, kofs[1] * 2u, kb_); DMA16(lb_ + vo_, vofs[0] * 2u, vb2_); DMA16(lb_ + vo_ + 8192, vofs[1] * 2u, vb2_); } while (0)
#define WRITES(S, ko, vo) do { } while (0)
#define STAGE_WAIT() asm volatile("s_waitcnt vmcnt(0)" ::: "memory")
#else
    u32x4 sa0, sa1, sa2, sa3, sb0, sb1, sb2, sb3;
#define LOADS(S, t) do { if (VAR & 1) break; const size_t go_ = (size_t)(t) * 64 * 512; S##0 = *(const u32x4*)(kbu + go_ + kofs[0]); S##1 = *(const u32x4*)(kbu + go_ + kofs[1]); S##2 = *(const u32x4*)(vbu + go_ + vofs[0]); S##3 = *(const u32x4*)(vbu + go_ + vofs[1]); } while (0)
#define WRITES(S, ko, vo) do { if (VAR & 1) break; *(LAS u32x4*)(lds + (ko) + wid * 1024 + lane * 16) = S##0; *(LAS u32x4*)(lds + (ko) + 8192 + wid * 1024 + lane * 16) = S##1; \
        *(LAS u32x4*)(lds + (vo) + wid * 1024 + lane * 16) = S##2; *(LAS u32x4*)(lds + (vo) + 8192 + wid * 1024 + lane * 16) = S##3; } while (0)
#define STAGE_WAIT() do { } while (0)
#endif
    bf16x8 pa0, pa1, pa2, pa3;
    { const u32x4 z4 = {0u, 0u, 0u, 0u}; pa0 = __builtin_bit_cast(bf16x8, z4); pa1 = pa0; pa2 = pa0; pa3 = pa0; }
    f32x16 p0, p1, lacc;
#pragma unroll
    for (int r = 0; r < 16; ++r) { p0[r] = 0.f; p1[r] = 0.f; lacc[r] = 0.f; }
    const bf16x8 ones = {(short)0x3F80, (short)0x3F80, (short)0x3F80, (short)0x3F80, (short)0x3F80, (short)0x3F80, (short)0x3F80, (short)0x3F80};
#define SBAR() __builtin_amdgcn_sched_barrier(0)
#define QK(ko, t) do { \
        f32x16 z_; _Pragma("unroll") for (int r = 0; r < 16; ++r) z_[r] = 0.f; \
        if (VAR & 8) { p0 = z_; p1 = z_; asm volatile("" : "+v"(p0), "+v"(p1)); } else { \
        bf16x8 kb_[8];                                        \
        _Pragma("unroll") for (int d0 = 0; d0 < 4; ++d0) { kb_[2 * d0] = (VAR & 32) ? pa0 : *(LAS const bf16x8*)(lds + (ko) + ka[d0]); kb_[2 * d0 + 1] = (VAR & 32) ? pa1 : *(LAS const bf16x8*)(lds + (ko) + ka[d0] + 8192); } \
        SBAR(); \
        _Pragma("unroll") for (int d0 = 0; d0 < 4; ++d0) { const bf16x8 qf = qr[d0]; \
            p0 = __builtin_amdgcn_mfma_f32_32x32x16_bf16(kb_[2 * d0], qf, d0 == 0 ? z_ : p0, 0, 0, 0); \
            p1 = __builtin_amdgcn_mfma_f32_32x32x16_bf16(kb_[2 * d0 + 1], qf, d0 == 0 ? z_ : p1, 0, 0, 0); } } \
        if (64 * (t) > far_max || cbh != 0.f) {        \
            const int bi_ = 64 * (t) - qw0 - r32 + 4 * hi + 192; \
            _Pragma("unroll") for (int r = 0; r < 16; ++r) { const int i0_ = bi_ + (r & 3) + 8 * (r >> 2), i1_ = i0_ + 32; \
                p0[r] += tab[i0_ < 0 ? 0 : i0_]; p1[r] += tab[i1_ < 0 ? 0 : i1_]; } \
        } } while (0)
#define EX2(P, B) do { if (!(VAR & 2)) { P[B] = __builtin_amdgcn_exp2f(P[B]); P[B + 1] = __builtin_amdgcn_exp2f(P[B + 1]); } asm volatile("" : "+v"(P)); } while (0)
#define EXG(g) do { if ((g) < 8) EX2(p0, 2 * (g)); else EX2(p1, 2 * ((g) - 8)); } while (0)
#define VFR(d0, ks) ((VAR & 32) ? pa0 : cat8(vtr(vb_ + (d0) * 512 + (ks) * 4096), vtr(vb_ + (d0) * 512 + (ks) * 4096 + 2048)))
#define PAK(k_) ((k_) == 0 ? pa0 : (k_) == 1 ? pa1 : (k_) == 2 ? pa2 : pa3)
#define PVX(vo, DOEXP) do { if (VAR & 4) { if (DOEXP) { _Pragma("unroll") for (int g_ = 0; g_ < 16; ++g_) EXG(g_); } break; } \
        LAS const unsigned char* vb_ = lds + (vo) + vrb; \
        bf16x8 vf_[5];                                        \
        vf_[0] = VFR(0, 0); vf_[1] = VFR(0, 1); vf_[2] = VFR(0, 2); vf_[3] = VFR(0, 3); \
        SBAR(); \
        _Pragma("unroll") for (int n_ = 0; n_ < 16; ++n_) { \
            o[n_ >> 2] = __builtin_amdgcn_mfma_f32_32x32x16_bf16(PAK(n_ & 3), vf_[n_ % 5], o[n_ >> 2], 0, 0, 0); \
            if (n_ >= 12) lacc = __builtin_amdgcn_mfma_f32_32x32x16_bf16(PAK(n_ & 3), ones, lacc, 0, 0, 0); \
            if (n_ + 4 < 16) vf_[(n_ + 4) % 5] = VFR((n_ + 4) >> 2, (n_ + 4) & 3); \
            if (DOEXP) EXG(n_); SBAR(); } } while (0)
    LOADS(sa, 0); WRITES(sa, 0, VRING); STAGE_WAIT();
    asm volatile("" :: "v"(qr[0]), "v"(qr[1]), "v"(qr[2]), "v"(qr[3]));
    __syncthreads();
#if !ATT_DMA
    if (1 < NTu) LOADS(sa, 1);
#endif
#ifndef ATT_LAG
#define ATT_LAG 0
#endif
    const int NSTEP = NTu + 1 + ATT_LAG;
#define PVPART(jt) do { const int j_ = (jt); \
        PVX(VRING + ((j_ > 0 ? j_ : 0) & 3) * 16384, 1); \
        if (j_ + 1 >= 0 && j_ + 1 < NTw) { PK4(p0, 0, pa0); PK4(p0, 8, pa1); PK4(p1, 0, pa2); PK4(p1, 8, pa3); } } while (0)
#define STEP(tt, LS, WS) do { const int kcur = ((tt) & 1) * 16384; \
        if (ATT_DMA) { if ((tt) + 1 < NTu) LOADS(LS, (tt) + 1); } else { if ((tt) + 2 < NTu) LOADS(LS, (tt) + 2); } \
        if (ATT_LAG && mp == 1 && (tt) >= 1 && (tt) <= NTw + 1) PVPART((tt) - 2);            \
        if ((tt) < NTw) QK(kcur, (tt)); \
        if ((tt) + 1 < NTu) WRITES(WS, kcur ^ 16384, VRING + (((tt) + 1) & 3) * 16384); \
        if ((!ATT_LAG || mp == 0) && (tt) <= NTw) PVPART((tt) - 1); \
        STAGE_WAIT(); \
        if (!(VAR & 16)) __syncthreads(); } while (0)
    for (int t = 0; t < NSTEP; t += 2) {
        STEP(t, sb, sa);
        if (t + 1 >= NSTEP) break;
        STEP(t + 1, sa, sb);
    }
#undef PVPART
#undef STEP
#undef LOADS
#undef WRITES
#undef STAGE_WAIT
#undef QK
#undef EX2
#undef EXG
#undef VFR
#undef PVX
#undef PAK
#undef SBAR
    float rl[16];
#pragma unroll
    for (int r = 0; r < 16; ++r) rl[r] = 1.f / lacc[r];
    attn_finish(lds, o, rl, true, mp, rg, lam, F.A->in[18], OB + (rowbase + qw0) * DM + h * 128, lane);
}

__device__ __forceinline__ void sattn_unit(Frame& F, const bf16* QA, bf16* OB, int bs, int h, float lam) {
    LAS unsigned char* lds = F.lds; int tid = F.tid; asm volatile("" : "+v"(tid)); const int wid = F.wave, lane = tid & 63;
    const int r32 = lane & 31, hi = lane >> 5, mp = wid >> 2, sp = wid & 3;
    const size_t row0 = (size_t)MP + (size_t)bs * LS;
    bf16x8 qr[4];
    { const bf16* qp = QA + (row0 + r32) * 512 + h * 128 + mp * 64 + hi * 8;
#pragma unroll
      for (int d0 = 0; d0 < 4; ++d0) qr[d0] = *(const bf16x8*)(qp + d0 * 16); }
    f32x16 o[4];
#pragma unroll
    for (int d0 = 0; d0 < 4; ++d0)
#pragma unroll
        for (int r = 0; r < 16; ++r) o[d0][r] = 0.f;
    float lsum = 0.f;
    LAS const float* tab = (LAS const float*)(lds + TAB_OFF) + h * 256;
    f32x4 kl[8], vl[16];
    LAS unsigned char* kst = lds + wid * 8192; const int kkey = lane >> 4, kpc = lane & 15;
#define SA_BASE(tt_, kp_, vp_) const float* kp_; const float* vp_; \
        if ((tt_) < 64) { const size_t off_ = ((size_t)(bs * PAST + (tt_) * 32) * 4 + h) * 128; kp_ = F.A->in[4] + off_; vp_ = F.A->in[5] + off_; } \
        else { const size_t off_ = ((size_t)(bs * LS) * 4 + h) * 128; kp_ = F.out + OFF_KS + off_; vp_ = F.out + OFF_VS + off_; }
#define SA_KLOAD(tt_) do { SA_BASE(tt_, kp_, vp_) (void)vp_; const float* a_ = kp_ + (size_t)kkey * 512 + mp * 64 + kpc * 4; \
        _Pragma("unroll") for (int i_ = 0; i_ < 8; ++i_) kl[i_] = __builtin_nontemporal_load((const f32x4*)(a_ + (size_t)i_ * 4 * 512)); } while (0)
#define SA_VLOAD(tt_) do { SA_BASE(tt_, kp_, vp_) (void)kp_; const float* v0p_ = vp_ + (size_t)(8 * hi) * 512 + 4 * r32; \
        _Pragma("unroll") for (int j = 0; j < 8; ++j) { vl[j] = __builtin_nontemporal_load((const f32x4*)(v0p_ + j * 512)); vl[8 + j] = __builtin_nontemporal_load((const f32x4*)(v0p_ + (16 + j) * 512)); } } while (0)
    SA_KLOAD(sp); SA_VLOAD(sp);
    for (int tt = sp; tt < 65; tt += 4) {
#pragma unroll
        for (int i = 0; i < 8; ++i) { u32x2 wv; wv.x = cvtpk(kl[i][0], kl[i][1]); wv.y = cvtpk(kl[i][2], kl[i][3]); *(LAS u32x2*)(kst + (4 * i + kkey) * 144 + kpc * 8) = wv; }
        if (tt + 4 < 65) SA_KLOAD(tt + 4);
        bf16x8 kf[4];
#pragma unroll
        for (int d0 = 0; d0 < 4; ++d0) kf[d0] = *(LAS const bf16x8*)(kst + r32 * 144 + d0 * 32 + hi * 16);
        f32x16 p;
#pragma unroll
        for (int r = 0; r < 16; ++r) p[r] = 0.f;
#pragma unroll
        for (int d0 = 0; d0 < 4; ++d0) p = __builtin_amdgcn_mfma_f32_32x32x16_bf16(kf[d0], qr[d0], p, 0, 0, 0);
        const int relb = tt * 32 - PAST - r32 + 4 * hi;
        float ps = 0.f;
#pragma unroll
        for (int r = 0; r < 16; ++r) { int rel = relb + (r & 3) + 8 * (r >> 2); rel = rel < -192 ? -192 : rel; p[r] = __builtin_amdgcn_exp2f(p[r] + tab[rel + 192]); ps += p[r]; }
        lsum += ps;
        bf16x8 pa0, pa1;
        PK4(p, 0, pa0); PK4(p, 8, pa1);
#pragma unroll
        for (int d0 = 0; d0 < 4; ++d0) {
            f32x4 a, c, e, g;
            a[0] = vl[0][d0]; a[1] = vl[1][d0]; a[2] = vl[2][d0]; a[3] = vl[3][d0]; c[0] = vl[4][d0]; c[1] = vl[5][d0]; c[2] = vl[6][d0]; c[3] = vl[7][d0];
            e[0] = vl[8][d0]; e[1] = vl[9][d0]; e[2] = vl[10][d0]; e[3] = vl[11][d0]; g[0] = vl[12][d0]; g[1] = vl[13][d0]; g[2] = vl[14][d0]; g[3] = vl[15][d0];
            o[d0] = __builtin_amdgcn_mfma_f32_32x32x16_bf16(pa0, pack8(a, c), o[d0], 0, 0, 0);
            o[d0] = __builtin_amdgcn_mfma_f32_32x32x16_bf16(pa1, pack8(e, g), o[d0], 0, 0, 0);
        }
        if (tt + 4 < 65) SA_VLOAD(tt + 4);
    }
#undef SA_BASE
#undef SA_KLOAD
#undef SA_VLOAD
    __syncthreads();
    { auto rr = __builtin_amdgcn_permlane32_swap(__float_as_uint(lsum), __float_as_uint(lsum), false, false); lsum = __uint_as_float(rr[0]) + __uint_as_float(rr[1]); }
    LAS float* exb = (LAS float*)lds; LAS float* wsc = (LAS float*)(lds + WSC_OFF);
    if (hi == 0) wsc[wid * 64 + r32] = lsum;
    if (sp > 0) { LAS float* e = exb + (mp * 3 + sp - 1) * 4096;
#pragma unroll
        for (int d0 = 0; d0 < 4; ++d0)
#pragma unroll
            for (int r = 0; r < 16; ++r) e[(d0 * 16 + r) * 64 + lane] = o[d0][r]; }
    __syncthreads();
    float rl[16];
    if (sp == 0) {
#pragma unroll
        for (int k = 0; k < 3; ++k) { LAS const float* e = exb + (mp * 3 + k) * 4096;
#pragma unroll
            for (int d0 = 0; d0 < 4; ++d0)
#pragma unroll
                for (int r = 0; r < 16; ++r) o[d0][r] += e[(d0 * 16 + r) * 64 + lane]; }
#pragma unroll
        for (int r = 0; r < 16; ++r) { const int q = crow(r, hi); rl[r] = 1.f / ((wsc[(mp * 4 + 0) * 64 + q] + wsc[(mp * 4 + 1) * 64 + q]) + (wsc[(mp * 4 + 2) * 64 + q] + wsc[(mp * 4 + 3) * 64 + q])); }
    } else {
#pragma unroll
        for (int r = 0; r < 16; ++r) rl[r] = 0.f;
    }
    __syncthreads();
    attn_finish<true>(lds, o, rl, sp == 0, mp, 0, lam, F.A->in[18], OB + row0 * DM + h * 128, lane);
}

#define RSB() __builtin_amdgcn_sched_barrier(0)
constexpr int RT_ROW = 288, RT_TILE = 64 * RT_ROW, RT_BUF = 3 * RT_TILE, RT_P = 2 * RT_BUF, RT_PROW = 144, RT_RED = RT_P + 64 * RT_PROW;
static_assert(RT_RED + 8 * 64 * 4 <= RING_BYTES, "retention LDS");
__device__ __forceinline__ bf16x8 rt_qfrag(LAS const unsigned char* Qt, int it, int s, int fr, int g) {
    LAS const unsigned char* qa = Qt + (16 * it + fr) * RT_ROW + (32 * s + 4 * g) * 2; return cat8(*(LAS const s16x4*)qa, *(LAS const s16x4*)(qa + 32)); }
__device__ __forceinline__ bf16x8 rt_kfrag(LAS const unsigned char* Kt, int kt, int ks, int g, int q4, int p4) {
    LAS const unsigned char* ka_ = Kt + (32 * ks + 8 * g + q4) * RT_ROW + (16 * kt + 4 * p4) * 2; return cat8(vtr(ka_), vtr(ka_ + 4 * RT_ROW)); }
constexpr int RG_CH = 16, RG_N = (SEQ / 64) / RG_CH;
__device__ __forceinline__ void ret_groupA(Frame& F, const bf16* KR, const bf16* VR, float* E, int b, int h, int grp) {
    LAS unsigned char* lds = F.lds; int tid = F.tid; asm volatile("" : "+v"(tid)); const int w = F.wave, lane = tid & 63;
    const int fr = lane & 15, g = lane >> 4, q4 = fr >> 2, p4 = fr & 3;
    const float l2g = __log2f(1.f - exp2f(-5.f - (float)h)); const float g64 = exp2f(64.f * l2g);
    f32x4 S[8];
#pragma unroll
    for (int kt = 0; kt < 8; ++kt) S[kt] = (f32x4){0.f, 0.f, 0.f, 0.f};
    const size_t rowbase = (size_t)b * SEQ + (size_t)grp * RG_CH * 64;
    const int srow = tid >> 4, sc16 = tid & 15;
    const size_t gofs = (rowbase + srow) * 512 + h * 128 + sc16 * 8;
    const int lofs = srow * RT_ROW + sc16 * 16;
    u32x4 st[4];
#define ALOAD(c) do { const size_t go_ = gofs + (size_t)(c) * 64 * 512; st[0] = *(const u32x4*)(KR + go_); st[1] = *(const u32x4*)(KR + go_ + 32 * 512); st[2] = *(const u32x4*)(VR + go_); st[3] = *(const u32x4*)(VR + go_ + 32 * 512); } while (0)
#define AWRITE(bo) do { _Pragma("unroll") for (int j_ = 0; j_ < 4; ++j_) *(LAS u32x4*)(lds + (bo) + (1 + (j_ >> 1)) * RT_TILE + (j_ & 1) * 32 * RT_ROW + lofs) = st[j_]; } while (0)
    ALOAD(0); AWRITE(0); __syncthreads();
    for (int c = 0; c < RG_CH; ++c) {
        const int cur = (c & 1) * RT_BUF;
        LAS const unsigned char* Kt = lds + cur + RT_TILE; LAS const unsigned char* Vt = lds + cur + 2 * RT_TILE;
        if (c + 1 < RG_CH) ALOAD(c + 1);
        bf16x8 vf[2];
#pragma unroll
        for (int ks = 0; ks < 2; ++ks) { LAS const unsigned char* va = Vt + (32 * ks + 8 * g + q4) * RT_ROW + (16 * w + 4 * p4) * 2; vf[ks] = cat8(vtr(va), vtr(va + 4 * RT_ROW)); }
#pragma unroll
        for (int kt = 0; kt < 8; ++kt) S[kt] = S[kt] * g64;
        { bf16x8 fg[4];
          fg[0] = rt_kfrag(Kt, 0, 0, g, q4, p4); fg[1] = rt_kfrag(Kt, 0, 1, g, q4, p4); fg[2] = rt_kfrag(Kt, 1, 0, g, q4, p4); RSB();
#pragma unroll
          for (int n = 0; n < 16; ++n) { if (n + 3 < 16) fg[(n + 3) & 3] = rt_kfrag(Kt, (n + 3) >> 1, (n + 3) & 1, g, q4, p4);
              S[n >> 1] = __builtin_amdgcn_mfma_f32_16x16x32_bf16(fg[n & 3], vf[n & 1], S[n >> 1], 0, 0, 0); RSB(); } }
        if (c + 1 < RG_CH) AWRITE(cur ^ RT_BUF);
        __syncthreads();
    }
#undef ALOAD
#undef AWRITE
    float* ep = E + ((size_t)((b * 4 + h) * RG_N + grp) * 128) * 128;
#pragma unroll
    for (int kt = 0; kt < 8; ++kt)
#pragma unroll
        for (int r = 0; r < 4; ++r) ep[(size_t)(16 * kt + 4 * g + r) * 128 + 16 * w + fr] = S[kt][r];
    asm volatile("s_waitcnt vmcnt(0)" ::: "memory");
    __syncthreads();
    if (tid == 0) { __builtin_amdgcn_fence(__ATOMIC_RELEASE, "agent"); asm volatile("s_waitcnt vmcnt(0)" ::: "memory");
        __hip_atomic_fetch_add((unsigned*)(F.ctl + CW_CNTA + 64 * (b * 4 + h)), 1u, __ATOMIC_RELAXED, __HIP_MEMORY_SCOPE_AGENT); }
    __syncthreads();
}
__device__ __forceinline__ void ret_groupB(Frame& F, const bf16* QR, const bf16* KR, const bf16* VR, const bf16* GR, bf16* OB, const float* E, int b, int h, int grp) {
    LAS unsigned char* lds = F.lds; int tid = F.tid; asm volatile("" : "+v"(tid)); const int w = F.wave, lane = tid & 63;
    const int fr = lane & 15, g = lane >> 4, q4 = fr >> 2, p4 = fr & 3;
    const float l2g = __log2f(1.f - exp2f(-5.f - (float)h)); const float g64 = exp2f(64.f * l2g);
    float cs[4];
#pragma unroll
    for (int it = 0; it < 4; ++it) { const int i = 16 * it + fr; cs[it] = exp2f((float)(i + 1) * l2g); }
    const size_t rowbase = (size_t)b * SEQ + (size_t)grp * RG_CH * 64;
    const int srow = tid >> 4, sc16 = tid & 15;
    const size_t gofs = (rowbase + srow) * 512 + h * 128 + sc16 * 8;
    const int lofs = srow * RT_ROW + sc16 * 16;
    u32x4 st[6]; u32x2 gpre[4];
    const size_t grow0 = (rowbase + fr) * 512 + h * 128 + 16 * w + 4 * g;
#define NTL_(p) __builtin_nontemporal_load((const u32x4*)(p))
#define RLOAD(c) do { const size_t go_ = gofs + (size_t)(c) * 64 * 512; st[0] = NTL_(QR + go_); st[1] = NTL_(QR + go_ + 32 * 512); \
        st[2] = NTL_(KR + go_); st[3] = NTL_(KR + go_ + 32 * 512); st[4] = NTL_(VR + go_); st[5] = NTL_(VR + go_ + 32 * 512); } while (0)
#define RWRITE(bo) do { _Pragma("unroll") for (int j_ = 0; j_ < 6; ++j_) *(LAS u32x4*)(lds + (bo) + (j_ >> 1) * RT_TILE + (j_ & 1) * 32 * RT_ROW + lofs) = st[j_]; } while (0)
    RLOAD(0);
    if (tid == 0) { unsigned sp_ = 0; gu32* cp = F.ctl + CW_CNTA + 64 * (b * 4 + h);
        while (__hip_atomic_load(cp, __ATOMIC_RELAXED, __HIP_MEMORY_SCOPE_AGENT) < (unsigned)RG_N) { __builtin_amdgcn_s_sleep(4); if (++sp_ > (1u << 22)) break; }
        __builtin_amdgcn_fence(__ATOMIC_ACQUIRE, "agent"); asm volatile("s_waitcnt vmcnt(0)" ::: "memory"); }
    RWRITE(0);
    __syncthreads();
    f32x4 S[8];
#pragma unroll
    for (int kt = 0; kt < 8; ++kt) S[kt] = (f32x4){0.f, 0.f, 0.f, 0.f};
    for (int gp = 0; gp < grp; ++gp) {
        const float wgt = exp2f((float)(1024 * (grp - 1 - gp)) * l2g);
        const float* ep = E + ((size_t)((b * 4 + h) * RG_N + gp) * 128) * 128;
#pragma unroll
        for (int kt = 0; kt < 8; ++kt)
#pragma unroll
            for (int r = 0; r < 4; ++r) S[kt][r] += wgt * ep[(size_t)(16 * kt + 4 * g + r) * 128 + 16 * w + fr];
    }
    LAS float* red = (LAS float*)(lds + RT_RED);
    for (int c = 0; c < RG_CH; ++c) {
        const int cur = (c & 1) * RT_BUF;
        LAS const unsigned char* Qt = lds + cur; LAS const unsigned char* Kt = lds + cur + RT_TILE; LAS const unsigned char* Vt = lds + cur + 2 * RT_TILE;
        if (c + 1 < RG_CH) RLOAD(c + 1);
#pragma unroll
        for (int it = 0; it < 4; ++it) gpre[it] = __builtin_nontemporal_load((const u32x2*)(GR + grow0 + (size_t)(c * 64 + 16 * it) * 512));
        { const int it = w >> 1; const int i = 16 * it + fr; const float ps_ = exp2f((float)(i - 63) * l2g);
#pragma unroll
          for (int jj = 0; jj < 2; ++jj) { const int jt = 2 * (w & 1) + jj;
            f32x4 acc = (f32x4){0.f, 0.f, 0.f, 0.f};
            if (jt <= it) {
                bf16x8 ka_[4], qb_[4];
#pragma unroll
                for (int ks = 0; ks < 4; ++ks) { ka_[ks] = *(LAS const bf16x8*)(Kt + (16 * jt + fr) * RT_ROW + (32 * ks + 8 * g) * 2); qb_[ks] = *(LAS const bf16x8*)(Qt + (16 * it + fr) * RT_ROW + (32 * ks + 8 * g) * 2); }
                RSB();
#pragma unroll
                for (int ks = 0; ks < 4; ++ks) acc = __builtin_amdgcn_mfma_f32_16x16x32_bf16(ka_[ks], qb_[ks], acc, 0, 0, 0);
            }
            const int j0 = 16 * jt + 4 * g; u32x2 wv;
            wv.x = cvtpk(j0 + 0 <= i ? acc[0] * ps_ : 0.f, j0 + 1 <= i ? acc[1] * ps_ : 0.f); wv.y = cvtpk(j0 + 2 <= i ? acc[2] * ps_ : 0.f, j0 + 3 <= i ? acc[3] * ps_ : 0.f);
            *(LAS u32x2*)(lds + RT_P + i * RT_PROW + j0 * 2) = wv; } }
        f32x4 X[4];
        { bf16x8 af[4], qf[4];
#pragma unroll
          for (int s = 0; s < 4; ++s) af[s] = pack8(S[2 * s], S[2 * s + 1]);
#pragma unroll
          for (int it = 0; it < 4; ++it) X[it] = (f32x4){0.f, 0.f, 0.f, 0.f};
          qf[0] = rt_qfrag(Qt, 0, 0, fr, g); qf[1] = rt_qfrag(Qt, 0, 1, fr, g); qf[2] = rt_qfrag(Qt, 0, 2, fr, g); RSB();
#pragma unroll
          for (int n = 0; n < 16; ++n) { if (n + 3 < 16) qf[(n + 3) & 3] = rt_qfrag(Qt, (n + 3) >> 2, (n + 3) & 3, fr, g);
              X[n >> 2] = __builtin_amdgcn_mfma_f32_16x16x32_bf16(af[n & 3], qf[n & 3], X[n >> 2], 0, 0, 0); RSB(); } }
        __syncthreads();
        bf16x8 vf[2];
#pragma unroll
        for (int ks = 0; ks < 2; ++ks) { LAS const unsigned char* va = Vt + (32 * ks + 8 * g + q4) * RT_ROW + (16 * w + 4 * p4) * 2; vf[ks] = cat8(vtr(va), vtr(va + 4 * RT_ROW)); }
        f32x4 Y[4];
#pragma unroll
        for (int it = 0; it < 4; ++it) Y[it] = (f32x4){0.f, 0.f, 0.f, 0.f};
#pragma unroll
        for (int kt = 0; kt < 8; ++kt) S[kt] = S[kt] * g64;
        { bf16x8 fg[4];
#define BFRAG(n_) ((n_) < 8 ? *(LAS const bf16x8*)(lds + RT_P + (16 * ((n_) >> 1) + fr) * RT_PROW + (32 * ((n_) & 1) + 8 * g) * 2) : rt_kfrag(Kt, ((n_) - 8) >> 1, (n_) & 1, g, q4, p4))
          fg[0] = BFRAG(0); fg[1] = BFRAG(1); fg[2] = BFRAG(2); RSB();
#pragma unroll
          for (int n = 0; n < 24; ++n) { if (n + 3 < 24) fg[(n + 3) & 3] = BFRAG(n + 3);
              if (n < 8) Y[n >> 1] = __builtin_amdgcn_mfma_f32_16x16x32_bf16(vf[n & 1], fg[n & 3], Y[n >> 1], 0, 0, 0);
              else S[(n - 8) >> 1] = __builtin_amdgcn_mfma_f32_16x16x32_bf16(fg[n & 3], vf[n & 1], S[(n - 8) >> 1], 0, 0, 0);
              RSB(); }
#undef BFRAG
        }
        f32x4 ov[4];
#pragma unroll
        for (int it = 0; it < 4; ++it) { ov[it] = Y[it] + X[it] * cs[it];
            float sq = (ov[it][0] * ov[it][0] + ov[it][1] * ov[it][1]) + (ov[it][2] * ov[it][2] + ov[it][3] * ov[it][3]);
            sq += __shfl_xor(sq, 16); sq += __shfl_xor(sq, 32);
            if (g == 0) red[w * 64 + 16 * it + fr] = sq; }
        if (c + 1 < RG_CH) RWRITE(cur ^ RT_BUF);
        __syncthreads();
#pragma unroll
        for (int it = 0; it < 4; ++it) { const int i = 16 * it + fr; float tot = 0.f;
#pragma unroll
            for (int ww = 0; ww < 8; ++ww) tot += red[ww * 64 + i];
            const float rstd = rsqrtf(tot * (1.f / 128.f) + EPSN);
            const size_t row = rowbase + (size_t)c * 64 + i;
            const u32x2 gv = gpre[it];
            const float g0 = __uint_as_float(gv.x << 16), g1 = __uint_as_float(gv.x & 0xffff0000u), g2 = __uint_as_float(gv.y << 16), g3 = __uint_as_float(gv.y & 0xffff0000u);
            u32x2 ow; ow.x = cvtpk(ov[it][0] * rstd * g0, ov[it][1] * rstd * g1); ow.y = cvtpk(ov[it][2] * rstd * g2, ov[it][3] * rstd * g3);
            *(u32x2*)(OB + row * DM + 512 + h * 128 + 16 * w + 4 * g) = ow; }
    }
#undef RLOAD
#undef RWRITE
#undef NTL_
    if (grp == RG_N - 1) {
        float* rp = F.out + OFF_RP + ((size_t)(b * 4 + h) * 128) * 128;
#pragma unroll
        for (int kt = 0; kt < 8; ++kt)
#pragma unroll
            for (int r = 0; r < 4; ++r) rp[(size_t)(16 * kt + 4 * g + r) * 128 + 16 * w + fr] = S[kt][r];
    }
    __syncthreads();
}

__device__ __forceinline__ void ret_sample(Frame& F, const bf16* QR, const bf16* KR, const bf16* VR, const bf16* GR, bf16* OB, int bs, int h) {
    LAS unsigned char* lds = F.lds; int tid = F.tid; asm volatile("" : "+v"(tid)); const int w = F.wave, lane = tid & 63;
    const int fr = lane & 15, g = lane >> 4, q4 = fr >> 2, p4 = fr & 3;
    const float l2g = __log2f(1.f - exp2f(-5.f - (float)h)); const float g32 = exp2f(32.f * l2g);
    const size_t row0 = (size_t)MP + (size_t)bs * LS;
    LAS const unsigned char* Qt = lds; LAS const unsigned char* Kt = lds + RT_TILE; LAS const unsigned char* Vt = lds + 2 * RT_TILE;
    { const int srow = tid >> 4, sc16 = tid & 15; const size_t go_ = (row0 + srow) * 512 + h * 128 + sc16 * 8; const int lofs = srow * RT_ROW + sc16 * 16;
      const u32x4 a = *(const u32x4*)(QR + go_), b = *(const u32x4*)(KR + go_), c = *(const u32x4*)(VR + go_);
      *(LAS u32x4*)(lds + lofs) = a; *(LAS u32x4*)(lds + RT_TILE + lofs) = b; *(LAS u32x4*)(lds + 2 * RT_TILE + lofs) = c; }
    const float* S0 = F.A->in[6] + ((size_t)(bs * 4 + h) * 128) * 128;
    f32x4 S[8];
#pragma unroll
    for (int kt = 0; kt < 8; ++kt)
#pragma unroll
        for (int r = 0; r < 4; ++r) S[kt][r] = __builtin_nontemporal_load(S0 + (size_t)(16 * kt + 4 * g + r) * 128 + 16 * w + fr);
    u32x2 gpre[2];
#pragma unroll
    for (int it = 0; it < 2; ++it) gpre[it] = __builtin_nontemporal_load((const u32x2*)(GR + (row0 + 16 * it + fr) * 512 + h * 128 + 16 * w + 4 * g));
    __syncthreads();
    if (w < 4) { const int it = w >> 1, jt = w & 1; const int i = 16 * it + fr; const float ps_ = exp2f((float)(i - 31) * l2g);
        f32x4 acc = (f32x4){0.f, 0.f, 0.f, 0.f};
        if (jt <= it) {
#pragma unroll
            for (int ks = 0; ks < 4; ++ks) { const bf16x8 a = *(LAS const bf16x8*)(Kt + (16 * jt + fr) * RT_ROW + (32 * ks + 8 * g) * 2);
                const bf16x8 bq = *(LAS const bf16x8*)(Qt + (16 * it + fr) * RT_ROW + (32 * ks + 8 * g) * 2);
                acc = __builtin_amdgcn_mfma_f32_16x16x32_bf16(a, bq, acc, 0, 0, 0); }
        }
        const int j0 = 16 * jt + 4 * g; u32x2 wv;
        wv.x = cvtpk(j0 + 0 <= i ? acc[0] * ps_ : 0.f, j0 + 1 <= i ? acc[1] * ps_ : 0.f); wv.y = cvtpk(j0 + 2 <= i ? acc[2] * ps_ : 0.f, j0 + 3 <= i ? acc[3] * ps_ : 0.f);
        *(LAS u32x2*)(lds + RT_P + i * RT_PROW + j0 * 2) = wv; }
    f32x4 X[2];
    { bf16x8 af[4];
#pragma unroll
      for (int s = 0; s < 4; ++s) af[s] = pack8(S[2 * s], S[2 * s + 1]);
#pragma unroll
      for (int it = 0; it < 2; ++it) { X[it] = (f32x4){0.f, 0.f, 0.f, 0.f};
#pragma unroll
        for (int s = 0; s < 4; ++s) { LAS const unsigned char* qa = Qt + (16 * it + fr) * RT_ROW + (32 * s + 4 * g) * 2;
            const s16x4 lo = *(LAS const s16x4*)qa, hi4 = *(LAS const s16x4*)(qa + 32);
            X[it] = __builtin_amdgcn_mfma_f32_16x16x32_bf16(af[s], cat8(lo, hi4), X[it], 0, 0, 0); } } }
    __syncthreads();
    bf16x8 vf;
    { LAS const unsigned char* va = Vt + (8 * g + q4) * RT_ROW + (16 * w + 4 * p4) * 2; vf = cat8(vtr(va), vtr(va + 4 * RT_ROW)); }
    f32x4 Y[2];
#pragma unroll
    for (int it = 0; it < 2; ++it) { const bf16x8 pb = *(LAS const bf16x8*)(lds + RT_P + (16 * it + fr) * RT_PROW + (8 * g) * 2);
        Y[it] = __builtin_amdgcn_mfma_f32_16x16x32_bf16(vf, pb, (f32x4){0.f, 0.f, 0.f, 0.f}, 0, 0, 0); }
#pragma unroll
    for (int kt = 0; kt < 8; ++kt) { S[kt] = S[kt] * g32;
        LAS const unsigned char* ka_ = Kt + (8 * g + q4) * RT_ROW + (16 * kt + 4 * p4) * 2;
        S[kt] = __builtin_amdgcn_mfma_f32_16x16x32_bf16(cat8(vtr(ka_), vtr(ka_ + 4 * RT_ROW)), vf, S[kt], 0, 0, 0); }
    { float* rp = F.out + OFF_RS + ((size_t)(bs * 4 + h) * 128) * 128;
#pragma unroll
      for (int kt = 0; kt < 8; ++kt)
#pragma unroll
        for (int r = 0; r < 4; ++r) rp[(size_t)(16 * kt + 4 * g + r) * 128 + 16 * w + fr] = S[kt][r]; }
    LAS float* red = (LAS float*)(lds + RT_RED);
    f32x4 ov[2];
#pragma unroll
    for (int it = 0; it < 2; ++it) { const float cs_ = exp2f((float)(16 * it + fr + 1) * l2g); ov[it] = Y[it] + X[it] * cs_;
        float sq = (ov[it][0] * ov[it][0] + ov[it][1] * ov[it][1]) + (ov[it][2] * ov[it][2] + ov[it][3] * ov[it][3]);
        sq += __shfl_xor(sq, 16); sq += __shfl_xor(sq, 32);
        if (g == 0) red[w * 64 + 16 * it + fr] = sq; }
    __syncthreads();
#pragma unroll
    for (int it = 0; it < 2; ++it) { const int i = 16 * it + fr; float tot = 0.f;
#pragma unroll
        for (int ww = 0; ww < 8; ++ww) tot += red[ww * 64 + i];
        const float rstd = rsqrtf(tot * (1.f / 128.f) + EPSN);
        const u32x2 gv = gpre[it];
        const float g0 = __uint_as_float(gv.x << 16), g1 = __uint_as_float(gv.x & 0xffff0000u), g2 = __uint_as_float(gv.y << 16), g3 = __uint_as_float(gv.y & 0xffff0000u);
        u32x2 ow; ow.x = cvtpk(ov[it][0] * rstd * g0, ov[it][1] * rstd * g1); ow.y = cvtpk(ov[it][2] * rstd * g2, ov[it][3] * rstd * g3);
        *(u32x2*)(OB + (row0 + i) * DM + 512 + h * 128 + 16 * w + 4 * g) = ow; }
    __syncthreads();
}

__device__ __forceinline__ int q_next(Frame& F, int q, int rep = 0) {
    volatile LAS int* slot = (volatile LAS int*)(F.lds + QSLOT_OFF);
    if (F.tid == 0) *slot = (int)__hip_atomic_fetch_add((unsigned*)(F.ctl + CW_QUEUE + 64 * (q + 8 * rep)), 1u, __ATOMIC_RELAXED, __HIP_MEMORY_SCOPE_AGENT);
    __syncthreads();
    const int v = *slot;
    __syncthreads();
    return v;
}
#ifndef P2M
#define P2M 31
#endif
constexpr int Q_ITEMS = 16 + 128 + 16 + 8 + 8;
__device__ __forceinline__ void phase2(Frame& F, int rep = 0, int mask = 31) {
    p2_setup(F);
    const float lam = ((LAS const float*)(F.lds + CB_OFF))[4];
    bf16* act = (bf16*)(F.ws + WS_ACT);
    const bf16* QA = act, *KA = act + ACT_STRIDE, *VA = act + 2 * ACT_STRIDE, *QR = act + 3 * ACT_STRIDE, *KR = act + 4 * ACT_STRIDE, *VR = act + 5 * ACT_STRIDE, *GR = act + 6 * ACT_STRIDE;
    bf16* OB = (bf16*)(F.ws + WS_OB); float* E = (float*)(F.ws + WS_E);
    const int xcc = (int)(xb_xcc_id() & 7u);
    for (int k = 0; k < 8; ++k) {
        const int q = (xcc + k) & 7;
        for (;;) {
            const int i = q_next(F, q, rep);
            if (i >= Q_ITEMS) break;
            if (i < 16) { if (mask & P2M & 1) { const int bh = 2 * q + (i >> 3); ret_groupA(F, KR, VR, E, bh >> 2, bh & 3, i & 7); } }
            else if (i >= 48 && i < 64) { if (mask & P2M & 16) { const int bh = 2 * q + ((i - 48) >> 3); ret_groupB(F, QR, KR, VR, GR, OB, E, bh >> 2, bh & 3, (i - 48) & 7); } }
            else if (i >= 64 && i < 72) { if (mask & P2M & 4) { const int id = 8 * q + (i - 64); sattn_unit(F, QA, OB, id >> 2, id & 3, lam); } }
            else if (i >= 72 && i < 80) { if (mask & P2M & 8) { const int id = 8 * q + (i - 72); ret_sample(F, QR, KR, VR, GR, OB, id >> 2, id & 3); } }
            else { if (mask & P2M & 2) { const int j = i < 48 ? i - 16 : i - 48, bh = 2 * q + (j & 1); if (rep == 0) attn_unit<0>(F, QA, KA, VA, OB, bh >> 2, bh & 3, 63 - (j >> 1), lam); else attn_unit<ATT_VAR>(F, QA, KA, VA, (bf16*)(F.ws + WS_XN), bh >> 2, bh & 3, 63 - (j >> 1), lam); } }
        }
    }
}
}


namespace sg {
using p2::bf16x8; using p2::f32x16; using p2::crow;
template <int NB>
__device__ __forceinline__ void wave_mm(f32x16 (&acc)[NB], LAS unsigned char* wl, const bf16* A, int lda, const bf16* Bm, int ldb, const int (&brow)[NB][4], int k0, int k1, int lane) {
#pragma unroll
    for (int nb = 0; nb < NB; ++nb)
#pragma unroll
        for (int r = 0; r < 16; ++r) acc[nb][r] = 0.f;
    const int r32 = lane & 31, hi = lane >> 5, lrow = lane >> 3, lpc = lane & 7;
    p2::u32x4 st[1 + NB][4];
#define SG_LOAD(ks) do { _Pragma("unroll") for (int i = 0; i < 4; ++i) { st[0][i] = *(const p2::u32x4*)(A + (size_t)(8 * i + lrow) * lda + (ks) + lpc * 8); \
        _Pragma("unroll") for (int nb = 0; nb < NB; ++nb) st[1 + nb][i] = *(const p2::u32x4*)(Bm + (size_t)brow[nb][i] * ldb + (ks) + lpc * 8); } } while (0)
    SG_LOAD(k0);
    for (int ks = k0; ks < k1; ks += 64) {
#pragma unroll
        for (int t = 0; t < 1 + NB; ++t)
#pragma unroll
            for (int i = 0; i < 4; ++i) { const int row = 8 * i + lrow; *(LAS p2::u32x4*)(wl + t * 4096 + row * 128 + ((lpc ^ ((row >> 1) & 7)) * 16)) = st[t][i]; }
        if (ks + 64 < k1) SG_LOAD(ks + 64);
#pragma unroll
        for (int u = 0; u < 4; ++u) { const int po = ((2 * u + hi) ^ ((r32 >> 1) & 7)) * 16;
            const bf16x8 a = *(LAS const bf16x8*)(wl + r32 * 128 + po);
#pragma unroll
            for (int nb = 0; nb < NB; ++nb) { const bf16x8 b = *(LAS const bf16x8*)(wl + (1 + nb) * 4096 + r32 * 128 + po); acc[nb] = __builtin_amdgcn_mfma_f32_32x32x16_bf16(a, b, acc[nb], 0, 0, 0); } }
    }
#undef SG_LOAD
}
__device__ __forceinline__ float half_sum(float s) { s += __shfl_xor(s, 1); s += __shfl_xor(s, 2); s += __shfl_xor(s, 4); s += __shfl_xor(s, 8); s += __shfl_xor(s, 16); return s; }
__device__ __forceinline__ float bf2f(bf16 v) { return __uint_as_float((unsigned)v << 16); }

__device__ __forceinline__ void p1_sample(Frame& F, const bf16* XN, const bf16* Win, bf16* act) {
    int tid = F.tid; asm volatile("" : "+v"(tid)); const int lane = tid & 63, r32 = lane & 31, hi = lane >> 5;
    const int gw = blockIdx.x + F.G * F.wave, NGW = F.G * NWAVES;
    const float* rot = (const float*)(F.ws + WS_ROT);
    for (int id = gw; id < 16 * (DIN / 64); id += NGW) {
        const int cg = id >> 4, rt = id & 15, m0 = MP + 32 * rt, n0 = 64 * cg;
        f32x16 acc[2];
        int brow[2][4];
#pragma unroll
        for (int nb = 0; nb < 2; ++nb)
#pragma unroll
            for (int i = 0; i < 4; ++i) brow[nb][i] = dst_row(1, n0 + 32 * nb + 8 * i + (lane >> 3));
        wave_mm<2>(acc, F.lds + F.wave * 12288, XN + (size_t)m0 * DM, DM, Win, DM, brow, 0, DM, lane);
        const int type = n0 >> 9, lc = (n0 & 511) + r32;
        bf16* dst = act + (size_t)type * ACT_STRIDE;
        if (type <= 1) {
            const float* g = type == 0 ? F.A->in[12] : F.A->in[13]; const float g0 = g[r32], g1 = g[32 + r32], osc = type == 0 ? QSCALE : 1.f;
#pragma unroll
            for (int r = 0; r < 16; ++r) { const int m = m0 + crow(r, hi);
                const float rinv = rsqrtf(half_sum(acc[0][r] * acc[0][r] + acc[1][r] * acc[1][r]) * (1.f / 64.f) + EPSN);
                const float y0 = acc[0][r] * rinv * g0, y1 = acc[1][r] * rinv * g1;
                if (type == 1) { float* ko = F.out + OFF_KS + (size_t)(m - MP) * 512 + lc; ko[0] = y0; ko[32] = y1; }
                dst[(size_t)m * 512 + lc] = (bf16)f2bf(y0 * osc); dst[(size_t)m * 512 + lc + 32] = (bf16)f2bf(y1 * osc); }
        } else if (type == 3 || type == 4) {
            const int h = (n0 & 511) >> 7; const float l2g = __log2f(1.f - exp2f(-5.f - (float)h));
            float2 cs[16][2];
#pragma unroll
            for (int r = 0; r < 16; ++r) { const int ts = crow(r, hi);
#pragma unroll
                for (int nb = 0; nb < 2; ++nb) cs[r][nb] = *(const float2*)(rot + (size_t)(PAST + ts) * 128 + (((lc + 32 * nb) & 127) & ~1)); }
#pragma unroll
            for (int r = 0; r < 16; ++r) { const int m = m0 + crow(r, hi), ts = crow(r, hi);
                const float ksc = type == 4 ? 0.08838834764831845f * exp2f((float)(31 - ts) * l2g) : 1.f;
#pragma unroll
                for (int nb = 0; nb < 2; ++nb) { const float v = acc[nb][r], pv = __shfl_xor(v, 1);
                    const float c = cs[r][nb].x, sn = cs[r][nb].y;
                    const float y = (lane & 1) ? (pv * sn + v * c) : (v * c - pv * sn);
                    dst[(size_t)m * 512 + lc + 32 * nb] = (bf16)f2bf(y * ksc); } }
        } else {
#pragma unroll
            for (int r = 0; r < 16; ++r) { const int m = m0 + crow(r, hi);
#pragma unroll
                for (int nb = 0; nb < 2; ++nb) { float y = acc[nb][r];
                    if (type == 2) F.out[OFF_VS + (size_t)(m - MP) * 512 + lc + 32 * nb] = y;
                    if (type == 6) y = pg8::silu_f(y);
                    dst[(size_t)m * 512 + lc + 32 * nb] = (bf16)f2bf(y); } }
        }
    }
}
__device__ __forceinline__ void p3_sample(Frame& F, const bf16* OB, const bf16* Wout, bf16* XN2, const float* mod, float* rowss) {
    int tid = F.tid; asm volatile("" : "+v"(tid)); const int lane = tid & 63, r32 = lane & 31, hi = lane >> 5;
    const int gw = blockIdx.x + F.G * F.wave, NGW = F.G * NWAVES;
    for (int id = gw; id < 16 * (DM / 64); id += NGW) {
        const int cg = id >> 4, rt = id & 15, m0 = MP + 32 * rt, n0 = 64 * cg;
        f32x16 acc[2];
        int brow[2][4];
#pragma unroll
        for (int nb = 0; nb < 2; ++nb)
#pragma unroll
            for (int i = 0; i < 4; ++i) brow[nb][i] = dst_row(WOUT_MODE, n0 + 32 * nb + 8 * i + (lane >> 3));
        wave_mm<2>(acc, F.lds + F.wave * 12288, OB + (size_t)m0 * DM, DM, Wout, DM, brow, 0, DM, lane);
        const float* mb = mod + (size_t)(NBP + rt) * 6 * DM;
        float gt[2], gm[2];
#pragma unroll
        for (int nb = 0; nb < 2; ++nb) { const int col = n0 + 32 * nb + r32; gt[nb] = mb[2 * DM + col]; gm[nb] = F.A->in[10][col] * (1.f + mb[4 * DM + col]); }
        float xin[16][2];
#pragma unroll
        for (int r = 0; r < 16; ++r)
#pragma unroll
            for (int nb = 0; nb < 2; ++nb) xin[r][nb] = F.A->in[1][(size_t)(m0 + crow(r, hi) - MP) * DM + n0 + 32 * nb + r32];
#pragma unroll
        for (int r = 0; r < 16; ++r) { const int m = m0 + crow(r, hi); float ss = 0.f;
#pragma unroll
            for (int nb = 0; nb < 2; ++nb) { const int col = n0 + 32 * nb + r32;
                const float x1 = xin[r][nb] + gt[nb] * acc[nb][r];
                F.out[OFF_Y + (size_t)m * DM + col] = x1; XN2[(size_t)m * DM + col] = (bf16)f2bf(x1 * gm[nb]); ss += x1 * x1; }
            ss = half_sum(ss);
            if (r32 == 0) atomicAdd(rowss + m, ss); }
    }
}
__device__ __forceinline__ void p4_sample(Frame& F, const bf16* XN2, const bf16* Wgu, const float* rowss, const float* sbg, const float* sbu, bf16* H) {
    int tid = F.tid; asm volatile("" : "+v"(tid)); const int lane = tid & 63, r32 = lane & 31, hi = lane >> 5;
    const int gw = blockIdx.x + F.G * F.wave, NGW = F.G * NWAVES;
    for (int id = gw; id < 16 * (DFF / 32); id += NGW) {
        const int fg = id >> 4, rt = id & 15, m0 = MP + 32 * rt, f = 32 * fg + r32;
        f32x16 acc[2];
        int brow[2][4];
#pragma unroll
        for (int nb = 0; nb < 2; ++nb)
#pragma unroll
            for (int i = 0; i < 4; ++i) brow[nb][i] = dst_row(2 + nb, 32 * fg + 8 * i + (lane >> 3));
        wave_mm<2>(acc, F.lds + F.wave * 12288, XN2 + (size_t)m0 * DM, DM, Wgu, DM, brow, 0, DM, lane);
        const float bg = sbg[(size_t)(NBP + rt) * DFF + f], bu = sbu[(size_t)(NBP + rt) * DFF + f];
        float rsv[16];
#pragma unroll
        for (int r = 0; r < 16; ++r) rsv[r] = rowss[m0 + crow(r, hi)];
#pragma unroll
        for (int r = 0; r < 16; ++r) { const int m = m0 + crow(r, hi); const float rstd = rsqrtf(rsv[r] * (1.f / (float)DM) + EPSN);
            H[(size_t)m * DFF + f] = (bf16)f2bf(pg8::silu_f(acc[0][r] * rstd + bg) * (acc[1][r] * rstd + bu)); }
    }
}
__device__ __forceinline__ void p5_sample(Frame& F, const bf16* H, const bf16* Wdn, const float* mod) {
    int tid = F.tid; asm volatile("" : "+v"(tid)); const int lane = tid & 63, r32 = lane & 31, hi = lane >> 5;
    const int gw = blockIdx.x + F.G * F.wave, NGW = F.G * NWAVES;
    for (int id = gw; id < 16 * 4 * (DM / 64); id += NGW) {
        const int rt = id & 15, ksp = (id >> 4) & 3, cg = id >> 6, m0 = MP + 32 * rt, n0 = 64 * cg;
        f32x16 acc[2];
        int brow[2][4];
#pragma unroll
        for (int nb = 0; nb < 2; ++nb)
#pragma unroll
            for (int i = 0; i < 4; ++i) brow[nb][i] = dst_row(WOUT_MODE, n0 + 32 * nb + 8 * i + (lane >> 3));
        wave_mm<2>(acc, F.lds + F.wave * 12288, H + (size_t)m0 * DFF, DFF, Wdn, DFF, brow, ksp * (DFF / 4), (ksp + 1) * (DFF / 4), lane);
        const float* mb = mod + (size_t)(NBP + rt) * 6 * DM + 5 * DM;
#pragma unroll
        for (int nb = 0; nb < 2; ++nb) { const int col = n0 + 32 * nb + r32; const float gt = mb[col];
#pragma unroll
            for (int r = 0; r < 16; ++r) atomicAdd(F.out + OFF_Y + (size_t)(m0 + crow(r, hi)) * DM + col, gt * acc[nb][r]); }
    }
}
}

__global__ void __launch_bounds__(NWAVES * 64, 2) fwd_megakernel(Args args) {
    extern __shared__ __attribute__((aligned(16))) unsigned char lds[];
    Frame F;
    F.lds = (LAS unsigned char*)lds; F.MISC = (volatile LAS unsigned*)(F.lds + MISC_OFF);
    F.tid = threadIdx.x; F.lane = F.tid & 63; F.wave = __builtin_amdgcn_readfirstlane(F.tid >> 6); F.G = gridDim.x;
    F.A = &args;
    F.out = args.out; F.ws = args.ws; F.ctl = (gu32*)(args.ws + WS_CTL);
    for (int u = F.tid; u < (LDS_BYTES - LDSCTL_OFF) / 4; u += NWAVES * 64) ((LAS unsigned*)(F.lds + LDSCTL_OFF))[u] = 0u;
    __syncthreads();
    XcdBarrier bar = xcd_barrier_post((unsigned*)(F.ctl + CW_BAR), F.MISC + 8);

    bf16* act = (bf16*)(F.ws + WS_ACT); bf16* XN = (bf16*)(F.ws + WS_XN); bf16* OB = (bf16*)(F.ws + WS_OB); bf16* HB = (bf16*)(F.ws + WS_H);
    float* mod = (float*)(F.ws + WS_MOD); float* rowss = (float*)(F.ws + WS_ROWSS); float* sb2 = (float*)(F.ws + WS_SB2);

#ifndef PHM
#define PHM 127
#endif
    if (PHM & 1) p0a(F);
#ifdef PROBE_P0A
    xcd_barrier(bar); p0a(F, false);
#endif
    xcd_barrier(bar);
    if (PHM & 2) p0b(F);
#ifdef PROBE_P0B
    xcd_barrier(bar); p0b(F, false);
#endif
    xcd_barrier(bar);
    if (PHM & 4) {
        pg8::Gemm g{XN, (const bf16*)(F.ws + WS_WIN), MP, DIN, DM}; pg8::StaticOrder S; S.init(MP, DIN, F.G, (int)blockIdx.x);
        pg8::EpiIn E{act, F.out, F.A->in[12], F.A->in[13], (const float*)(F.ws + WS_ROT)};
        if (blockIdx.x & 1) { sg::p1_sample(F, XN, (const bf16*)(F.ws + WS_WIN), act); __syncthreads(); }
        pg8::gemm_phase<pg8::EpiIn, pg8::StaticOrder, true, true>(F.lds, g, S, E);
        if (!(blockIdx.x & 1)) sg::p1_sample(F, XN, (const bf16*)(F.ws + WS_WIN), act);
#ifdef PROBE_S
        __syncthreads(); sg::p1_sample(F, XN, (const bf16*)(F.ws + WS_WIN), act);
#endif
#ifdef PROBE_P1
        xcd_barrier(bar);
        pg8::gemm_phase<pg8::EpiIn, pg8::StaticOrder, true, true>(F.lds, g, S, E);
#endif
#ifdef PROBE_P1N
        xcd_barrier(bar);
        { pg8::EpiNull EN; pg8::gemm_phase<pg8::EpiNull, pg8::StaticOrder, true, true>(F.lds, g, S, EN); }
#endif
    }
    xcd_barrier(bar);
    if (PHM & 8) p2::phase2(F);
#ifdef PROBE_P2
    xcd_barrier(bar);
    p2::phase2(F, 1, PROBE_P2);
#endif
    xcd_barrier(bar);
    if (PHM & 16) {
        pg8::Gemm g{OB, (const bf16*)(F.ws + WS_WOUT), MP, DM, DM}; pg8::StaticOrder S; S.init(MP, DM, F.G, (int)blockIdx.x);
        pg8::EpiOut E{F.A->in[0], F.A->in[1], (bf16*)(F.ws + WS_X1B), XN, mod, (const float*)(F.ws + WS_GMOD2), rowss, 1.f};
        if (blockIdx.x & 1) { sg::p3_sample(F, OB, (const bf16*)(F.ws + WS_WOUT), XN, mod, rowss); __syncthreads(); }
        pg8::gemm_phase<pg8::EpiOut, pg8::StaticOrder, false, true>(F.lds, g, S, E);
#ifdef PROBE_P3
        xcd_barrier(bar);
        { pg8::EpiOut E2{F.A->in[0], F.A->in[1], (bf16*)(F.ws + WS_X1B), XN, mod, (const float*)(F.ws + WS_GMOD2), rowss, 0.f}; pg8::gemm_phase<pg8::EpiOut, pg8::StaticOrder, true, true>(F.lds, g, S, E2); }
#endif
        if (!(blockIdx.x & 1)) sg::p3_sample(F, OB, (const bf16*)(F.ws + WS_WOUT), XN, mod, rowss);
    }
    xcd_barrier(bar);
    if (PHM & 32) {
        pg8::Gemm g{XN, (const bf16*)(F.ws + WS_WGU), MP, NGU, DM}; pg8::StaticOrder S; S.init(MP, NGU, F.G, (int)blockIdx.x);
        pg8::EpiFF1 E{rowss, sb2, sb2 + (size_t)NBT * DFF, HB};
        if (blockIdx.x & 1) { sg::p4_sample(F, XN, (const bf16*)(F.ws + WS_WGU), rowss, sb2, sb2 + (size_t)NBT * DFF, HB); __syncthreads(); }
        pg8::gemm_phase<pg8::EpiFF1, pg8::StaticOrder, true, true>(F.lds, g, S, E);
        if (!(blockIdx.x & 1)) sg::p4_sample(F, XN, (const bf16*)(F.ws + WS_WGU), rowss, sb2, sb2 + (size_t)NBT * DFF, HB);
#ifdef PROBE_S
        __syncthreads(); sg::p4_sample(F, XN, (const bf16*)(F.ws + WS_WGU), rowss, sb2, sb2 + (size_t)NBT * DFF, HB);
#endif
#ifdef PROBE_P4
        xcd_barrier(bar);
        pg8::gemm_phase<pg8::EpiFF1, pg8::StaticOrder, true, true>(F.lds, g, S, E);
#endif
    }
    xcd_barrier(bar);
    if (PHM & 64) {
        pg8::Gemm g{HB, (const bf16*)(F.ws + WS_WDN), MP, DM, DFF}; pg8::StaticOrder S; S.init(MP, DM, F.G, (int)blockIdx.x);
        pg8::EpiFF2 E{F.out + OFF_Y, (const bf16*)(F.ws + WS_X1B), mod, 1.f};
        if (blockIdx.x & 1) { sg::p5_sample(F, HB, (const bf16*)(F.ws + WS_WDN), mod); __syncthreads(); }
        pg8::gemm_phase<pg8::EpiFF2, pg8::StaticOrder, false, true>(F.lds, g, S, E);
#ifdef PROBE_P5
        xcd_barrier(bar);
        { pg8::EpiFF2 E2{F.out + OFF_Y, (const bf16*)(F.ws + WS_X1B), mod, 1.f}; pg8::gemm_phase<pg8::EpiFF2, pg8::StaticOrder, true, true>(F.lds, g, S, E2); }
#endif
        if (!(blockIdx.x & 1)) sg::p5_sample(F, HB, (const bf16*)(F.ws + WS_WDN), mod);
    }
}

extern "C" void kernel_launch(void* const* d_in, const int* in_sizes, int n_in, void* d_out, int out_size, void* d_ws, size_t ws_size, hipStream_t stream) {
    static int grid = 0;
    if (grid == 0) {
        if (n_in != 24 || in_sizes[0] != MP * DM || (size_t)out_size != OUT_TOTAL || ws_size < WS_END) {
            fprintf(stderr, "kernel_launch: unexpected shapes: n_in %d in0 %d out %d ws %zu (need >= %zu)\n", n_in, n_in > 0 ? in_sizes[0] : -1, out_size, ws_size, (size_t)WS_END); grid = -1; return; }
        int dev = 0, cus = 0, per_cu = 0;
        if (hipGetDevice(&dev) != hipSuccess || hipDeviceGetAttribute(&cus, hipDeviceAttributeMultiprocessorCount, dev) != hipSuccess) { fprintf(stderr, "kernel_launch: device query failed\n"); grid = -1; return; }
        if (hipFuncSetAttribute((const void*)fwd_megakernel, hipFuncAttributeMaxDynamicSharedMemorySize, LDS_BYTES) != hipSuccess) { fprintf(stderr, "kernel_launch: hipFuncSetAttribute failed\n"); grid = -1; return; }
        if (hipOccupancyMaxActiveBlocksPerMultiprocessor(&per_cu, (const void*)fwd_megakernel, NWAVES * 64, LDS_BYTES) != hipSuccess || per_cu < 1) { fprintf(stderr, "kernel_launch: occupancy query says %d blocks/CU\n", per_cu); per_cu = 1; }
        (void)hipGetLastError();
        grid = cus;
    }
    if (grid < 0) return;
    if (hipMemsetAsync((char*)d_ws + WS_CTL, 0, CTL_ZERO_BYTES, stream) != hipSuccess) { fprintf(stderr, "kernel_launch: memset failed\n"); return; }
    Args a{};
    for (int i = 0; i < 24; ++i) a.in[i] = (const float*)d_in[i];
    a.out = (float*)d_out; a.ws = (unsigned char*)d_ws;
    void* kargs[] = {&a};
    hipError_t e = hipLaunchCooperativeKernel((const void*)fwd_megakernel, dim3(grid), dim3(NWAVES * 64), kargs, LDS_BYTES, stream);
    if (e != hipSuccess) fprintf(stderr, "kernel_launch: cooperative launch failed: %s (grid %d)\n", hipGetErrorString(e), grid);
}
```
